# Optimizing an MI355X kernel written in HIP

```python
import jax, jax.numpy as jnp
from jax import lax
import numpy as np

D_MODEL = 1024
BATCH = 4
SEQ = 4096
DEPTH = 1

MEM_LEN = 256
N_HEADS_A = 8
HEAD_DIM_A = 64
WIDTH_A = N_HEADS_A * HEAD_DIM_A
N_IDX_HEADS = 8
IDX_DIM = 64
TOPK_MAX = 256
Q_BLOCK = 128
WIDTH_B = 512
CONV_WIDTH = 3
N_HEADS_M = 4
HEAD_DIM_M = 128
WIDTH_M = N_HEADS_M * HEAD_DIM_M
N_BRANCHES = 3
RMS_EPS = 1e-6

IN_SIZES = (WIDTH_A, WIDTH_A, WIDTH_A, WIDTH_A,
            N_IDX_HEADS * IDX_DIM, IDX_DIM, N_IDX_HEADS,
            WIDTH_B, WIDTH_B, WIDTH_B, WIDTH_B,
            WIDTH_M, WIDTH_M,
            N_BRANCHES * D_MODEL)
IN_SPLIT_POINTS = tuple(int(v) for v in np.cumsum(IN_SIZES)[:-1])
D_IN = int(sum(IN_SIZES))

kernel_name = "hybrid_dsa_shortconv_memxattn_gated_merge"


def rmsnorm(x, g):
    xf = x.astype(jnp.float32)
    y = xf * lax.rsqrt(jnp.mean(xf * xf, axis=-1, keepdims=True) + RMS_EPS)
    return (y * g.astype(jnp.float32)).astype(x.dtype)


def alibi_slopes(n_heads):
    return 2.0 ** (-8.0 * jnp.arange(1, n_heads + 1, dtype=jnp.float32) / n_heads)


def dsa_attention(q, k, v, q_idx, k_idx, w_idx):
    B, S, H, Dh = q.shape
    topk = min(TOPK_MAX, S // 4)
    n_blk = S // Q_BLOCK
    slopes = alibi_slopes(H)
    key_pos = jnp.arange(S)
    scale = HEAD_DIM_A ** -0.5
    idx_scale = (IDX_DIM ** -0.5) * (N_IDX_HEADS ** -0.5)
    k_idx_f = k_idx.astype(jnp.float32)

    def block(i):
        start = i * Q_BLOCK
        qb = lax.dynamic_slice_in_dim(q, start, Q_BLOCK, axis=1)
        qib = lax.dynamic_slice_in_dim(q_idx, start, Q_BLOCK, axis=1)
        wb = lax.dynamic_slice_in_dim(w_idx, start, Q_BLOCK, axis=1)
        t = start + jnp.arange(Q_BLOCK)
        dots = jnp.einsum('bthd,bsd->bths', qib.astype(jnp.float32), k_idx_f)
        score = jnp.einsum('bths,bth->bts', jax.nn.relu(dots), wb.astype(jnp.float32)) * idx_scale
        causal = key_pos[None, :] <= t[:, None]
        score = jnp.where(causal[None], score, -jnp.inf)
        _, sel = lax.top_k(score, topk)
        k_sel = jax.vmap(lambda kb, ib: kb[ib])(k, sel)
        v_sel = jax.vmap(lambda vb, ib: vb[ib])(v, sel)
        logits = jnp.einsum('bthd,btkhd->bhtk', qb, k_sel).astype(jnp.float32) * scale
        dist = (t[None, :, None] - sel).astype(jnp.float32)
        logits = logits - slopes[None, :, None, None] * dist[:, None]
        valid = sel <= t[None, :, None]
        logits = jnp.where(valid[:, None], logits, -jnp.inf)
        p = jax.nn.softmax(logits, axis=-1).astype(v.dtype)
        return jnp.einsum('bhtk,btkhd->bthd', p, v_sel)

    out = lax.map(block, jnp.arange(n_blk))
    return out.transpose(1, 0, 2, 3, 4).reshape(B, S, H * Dh)


def memory_attention(q, mk, mv):
    B, S = q.shape[:2]
    logits = jnp.einsum('bthd,bmhd->bhtm', q, mk).astype(jnp.float32) * (HEAD_DIM_M ** -0.5)
    p = jax.nn.softmax(logits, axis=-1).astype(mv.dtype)
    return jnp.einsum('bhtm,bmhd->bthd', p, mv).reshape(B, S, WIDTH_M)


def short_conv(u, w):
    S = u.shape[1]
    up = jnp.pad(u, ((0, 0), (CONV_WIDTH - 1, 0), (0, 0)))
    y = w[0] * up[:, 0:S]
    for j in range(1, CONV_WIDTH):
        y = y + w[j] * up[:, j:j + S]
    return y


def setup_inputs(seed: int = 0) -> dict:
    key = jax.random.key(seed)
    ks = jax.random.split(key, 16)
    f32 = jnp.float32
    nrm = lambda k, shape, s: jax.random.normal(k, shape, f32) * s
    return {
        "x": nrm(ks[0], (BATCH, SEQ, D_MODEL), 1.0),
        "mem": nrm(ks[1], (BATCH, MEM_LEN, D_MODEL), 1.0),
        "norm_g": 1.0 + nrm(ks[2], (DEPTH, D_MODEL), 0.02),
        "mem_norm_g": 1.0 + nrm(ks[3], (DEPTH, D_MODEL), 0.02),
        "w_in": nrm(ks[4], (DEPTH, D_MODEL, D_IN), D_MODEL ** -0.5),
        "b_gate": nrm(ks[5], (DEPTH, N_BRANCHES * D_MODEL), 0.01),
        "w_mem_kv": nrm(ks[6], (DEPTH, D_MODEL, 2 * WIDTH_M), D_MODEL ** -0.5),
        "q_norm_a": 1.0 + nrm(ks[7], (DEPTH, HEAD_DIM_A), 0.02),
        "k_norm_a": 1.0 + nrm(ks[8], (DEPTH, HEAD_DIM_A), 0.02),
        "q_norm_m": 1.0 + nrm(ks[9], (DEPTH, HEAD_DIM_M), 0.02),
        "k_norm_m": 1.0 + nrm(ks[10], (DEPTH, HEAD_DIM_M), 0.02),
        "conv_w": nrm(ks[11], (DEPTH, CONV_WIDTH, WIDTH_B), CONV_WIDTH ** -0.5),
        "w_out_a": nrm(ks[12], (DEPTH, WIDTH_A, D_MODEL), WIDTH_A ** -0.5),
        "w_out_b": nrm(ks[13], (DEPTH, WIDTH_B, D_MODEL), WIDTH_B ** -0.5),
        "w_out_m": nrm(ks[14], (DEPTH, WIDTH_M, D_MODEL), WIDTH_M ** -0.5),
        "w_o": nrm(ks[15], (DEPTH, D_MODEL, D_MODEL), D_MODEL ** -0.5),
    }


def reference(x, mem, norm_g, mem_norm_g, w_in, b_gate, w_mem_kv, q_norm_a, k_norm_a,
              q_norm_m, k_norm_m, conv_w, w_out_a, w_out_b, w_out_m, w_o):
    B, S, D = x.shape
    M = mem.shape[1]
    h = x
    for l in range(DEPTH):
        xn = rmsnorm(h, norm_g[l])
        proj = xn @ w_in[l]
        (qa, ka, va, za, qi, ki, wi, bg, cg, hb, zb, qm, zm, g) = jnp.split(
            proj, IN_SPLIT_POINTS, axis=-1)

        qa = rmsnorm(qa.reshape(B, S, N_HEADS_A, HEAD_DIM_A), q_norm_a[l])
        ka = rmsnorm(ka.reshape(B, S, N_HEADS_A, HEAD_DIM_A), k_norm_a[l])
        va = va.reshape(B, S, N_HEADS_A, HEAD_DIM_A)
        qi = qi.reshape(B, S, N_IDX_HEADS, IDX_DIM)
        attn_a = dsa_attention(qa, ka, va, qi, ki, wi)
        ya = (attn_a * jax.nn.silu(za)) @ w_out_a[l]

        conv_out = bg * short_conv(cg * hb, conv_w[l])
        yb = (conv_out * jax.nn.silu(zb)) @ w_out_b[l]

        memn = rmsnorm(mem, mem_norm_g[l])
        mk, mv = jnp.split(memn @ w_mem_kv[l], 2, axis=-1)
        mk = rmsnorm(mk.reshape(B, M, N_HEADS_M, HEAD_DIM_M), k_norm_m[l])
        mv = mv.reshape(B, M, N_HEADS_M, HEAD_DIM_M)
        qm = rmsnorm(qm.reshape(B, S, N_HEADS_M, HEAD_DIM_M), q_norm_m[l])
        attn_m = memory_attention(qm, mk, mv)
        ym = (attn_m * jax.nn.silu(zm)) @ w_out_m[l]

        gates = jax.nn.sigmoid((g + b_gate[l]).astype(jnp.float32)).astype(h.dtype)
        gates = gates.reshape(B, S, N_BRANCHES, D)
        merged = gates[:, :, 0] * ya + gates[:, :, 1] * yb + gates[:, :, 2] * ym
        h = h + merged @ w_o[l]
    return h
```

```cpp
#include <hip/hip_runtime.h>
#include <hip/hip_cooperative_groups.h>
#include <cstdio>
#include <cstdint>
namespace cg = cooperative_groups;

#ifndef FUSED
#define FUSED 0
#endif
#ifndef SKIP_TOPK
#define SKIP_TOPK 0
#endif
#ifndef SKIP_FA
#define SKIP_FA 0
#endif
#ifndef SKIP_FM
#define SKIP_FM 0
#endif

namespace pg8 {
#define PG8_LAS __attribute__((address_space(3)))
typedef unsigned short bf16_t;
typedef short bf16x8 __attribute__((ext_vector_type(8)));
typedef float f32x4 __attribute__((ext_vector_type(4)));
typedef unsigned u32x4 __attribute__((ext_vector_type(4)));
constexpr int BM = 256, BK = 64, HALF = 128, HTB = HALF * BK * 2  , STAGE_BYTES = 8 * HTB, NXCD = 8, WGM = 8;

__host__ __device__ __forceinline__ int lds_byte(int r, int c) { const int st = (r >> 4) * 2 + (c >> 5), rr = r & 15, cc = c & 31, ob = rr * 64 + cc * 2; return st * 1024 + (ob ^ (((ob >> 9) & 1) << 5)); }
__host__ __device__ __forceinline__ void stage_rc(int b, int& R, int& C) { const int st = b / 1024, sb = b % 1024, swz = sb ^ (((sb >> 9) & 1) << 5); R = (st >> 1) * 16 + swz / 64; C = (st & 1) * 32 + (swz % 64) / 2; }
__host__ __device__ __forceinline__ int perm32(int rho) { const int n = rho >> 4, i = rho & 15; return 8 * (i >> 2) + 4 * n + (i & 3); }

struct Unit { int pm, pn, br; };
struct Gemm { const bf16_t* A; const bf16_t* Bt; int M, N, K; long strideA, strideB;
    __device__ __forceinline__ const bf16_t* a(int br) const { return A + (long)br * strideA; }
    __device__ __forceinline__ const bf16_t* b(int br) const { return Bt + (long)br * strideB; } };

__host__ __device__ __forceinline__ void tile_of(int L, int nM, int nN, int& pm, int& pn) {
    const int nwg = nM * nN; int wgid = L; { const int q = nwg / NXCD, r = nwg % NXCD, xcd = wgid % NXCD, off = wgid / NXCD; wgid = (xcd < r ? xcd * (q + 1) : r * (q + 1) + (xcd - r) * q) + off; }
    const int nig = WGM * nN, gid = wgid / nig, fm = gid * WGM, gsz = (nM - fm) < WGM ? (nM - fm) : WGM;
    pm = fm + ((wgid % nig) % gsz); pn = (wgid % nig) / gsz;
}
struct StaticOrder {
    int nM, nN, nwg, G, c, nsub, nM2, nN2;
    __host__ __device__ void init(int M, int N, int G_, int c_, int nsub_ = 1, int M2 = 0, int N2 = 0) { nM = M / BM; nN = N / BM; nwg = nM * nN; G = G_; c = c_; nsub = nsub_; nM2 = M2 / BM; nN2 = N2 / BM; }
    __host__ __device__ bool next(int i, Unit& u) const {
        const int ti = i / nsub; const long L = (long)ti * G + c; if (L >= nwg + nM2 * nN2) return false;
        if (L < nwg) { tile_of((int)L, nM, nN, u.pm, u.pn); u.br = i - ti * nsub; }
        else { tile_of((int)L - nwg, nM2, nN2, u.pm, u.pn); u.br = 1; }
        return true;
    }
    __device__ __forceinline__ void a_ready(const Unit&) const {}
    __device__ __forceinline__ void done(const Unit&) const {}
};

typedef float f32x2_t __attribute__((ext_vector_type(2))); typedef __bf16 bf16x2_t __attribute__((ext_vector_type(2)));
__device__ __forceinline__ unsigned cvt_pk_bf16(float lo, float hi) { f32x2_t v = {lo, hi}; bf16x2_t b = __builtin_convertvector(v, bf16x2_t); return __builtin_bit_cast(unsigned, b); }
__device__ __forceinline__ float bf_lo(unsigned w) { return __uint_as_float(w << 16); }
__device__ __forceinline__ float bf_hi(unsigned w) { return __uint_as_float(w & 0xffff0000u); }


struct EpiProjA {
    static constexpr bool PERM = true, AFTER_DRAIN = false;
    unsigned char* ws; bf16_t* brb; const float* rstd;
    __device__ __forceinline__ bool keep(const Unit&) const { return false; }
    __device__ __forceinline__ void operator()(f32x4 (&acc)[2][2][4][2], const Unit& u, int wr, int wc, int fr, int fq) const {
        bf16_t* base; int ldc, colt; const int pn = u.pn; const float* rs = rstd;
        if (u.br == 1) { base = (bf16_t*)(ws + ((size_t)53 << 19)); ldc = 1024; colt = pn * 256; rs = rstd + 16384; }
        else if (pn < 10) { base = (bf16_t*)(ws + ((size_t)(80 + 16 * (pn >> 1)) << 20)); ldc = 512; colt = (pn & 1) * 256; }
        else if (pn == 10) { base = (bf16_t*)(ws + ((size_t)37 << 20)); ldc = 256; colt = 0; }
        else if (pn < 19) { base = brb; ldc = 2048; colt = (pn - 11) * 256; }
        else { base = (bf16_t*)(ws + ((size_t)(160 + 16 * ((pn - 19) >> 1)) << 20)); ldc = 512; colt = ((pn - 19) & 1) * 256; }
        const int row0 = u.pm * BM + wr * 64 + fr, col0 = colt + wc * 32 + 8 * fq;
#pragma unroll
        for (int ai = 0; ai < 2; ++ai)
#pragma unroll
            for (int m = 0; m < 4; ++m) { const int row = row0 + ai * HALF + m * 16; const float sc = rs[row]; bf16_t* rowp = base + (size_t)row * ldc + col0;
#pragma unroll
                for (int bj = 0; bj < 2; ++bj) { const f32x4 v0 = acc[ai][bj][m][0] * sc, v1 = acc[ai][bj][m][1] * sc;
                    u32x4 w; w.x = cvt_pk_bf16(v0[0], v0[1]); w.y = cvt_pk_bf16(v0[2], v0[3]); w.z = cvt_pk_bf16(v1[0], v1[1]); w.w = cvt_pk_bf16(v1[2], v1[3]);
                    *(u32x4*)(rowp + bj * HALF) = w; } }
    }
};
struct EpiScale {
    static constexpr bool PERM = true, AFTER_DRAIN = false;
    bf16_t* O; int ldc; const float* rstd;
    __device__ __forceinline__ bool keep(const Unit&) const { return false; }
    __device__ __forceinline__ void operator()(f32x4 (&acc)[2][2][4][2], const Unit& u, int wr, int wc, int fr, int fq) const {
        const int row0 = u.pm * BM + wr * 64 + fr, col0 = u.pn * BM + wc * 32 + 8 * fq;
#pragma unroll
        for (int ai = 0; ai < 2; ++ai)
#pragma unroll
            for (int m = 0; m < 4; ++m) { const int row = row0 + ai * HALF + m * 16; const float sc = rstd[row]; bf16_t* rowp = O + (size_t)row * ldc + col0;
#pragma unroll
                for (int bj = 0; bj < 2; ++bj) { const f32x4 v0 = acc[ai][bj][m][0] * sc, v1 = acc[ai][bj][m][1] * sc;
                    u32x4 w; w.x = cvt_pk_bf16(v0[0], v0[1]); w.y = cvt_pk_bf16(v0[2], v0[3]); w.z = cvt_pk_bf16(v1[0], v1[1]); w.w = cvt_pk_bf16(v1[2], v1[3]);
                    *(u32x4*)(rowp + bj * HALF) = w; } }
    }
};
__device__ __forceinline__ float sigmoidf_(float x) { return __builtin_amdgcn_rcpf(1.0f + __builtin_amdgcn_exp2f(-1.4426950408889634f * x)); }
struct EpiGate {
    static constexpr bool PERM = true, AFTER_DRAIN = false;
    bf16_t* g01; bf16_t* g2; const float* rstd; const float* bgate;
    __device__ __forceinline__ bool keep(const Unit&) const { return false; }
    __device__ __forceinline__ void operator()(f32x4 (&acc)[2][2][4][2], const Unit& u, int wr, int wc, int fr, int fq) const {
        bf16_t* base; int ldc, colt;
        if (u.pn < 8) { base = g01; ldc = 2048; colt = u.pn * 256; } else { base = g2; ldc = 1024; colt = (u.pn - 8) * 256; }
        const int row0 = u.pm * BM + wr * 64 + fr, col0 = colt + wc * 32 + 8 * fq, bcol0 = u.pn * BM + wc * 32 + 8 * fq;
        f32x4 bv[2][2];
#pragma unroll
        for (int bj = 0; bj < 2; ++bj)
#pragma unroll
            for (int n = 0; n < 2; ++n) bv[bj][n] = *(const f32x4*)(bgate + bcol0 + bj * HALF + 4 * n);
#pragma unroll
        for (int ai = 0; ai < 2; ++ai)
#pragma unroll
            for (int m = 0; m < 4; ++m) { const int row = row0 + ai * HALF + m * 16; const float sc = rstd[row]; bf16_t* rowp = base + (size_t)row * ldc + col0;
#pragma unroll
                for (int bj = 0; bj < 2; ++bj) { f32x4 v0 = acc[ai][bj][m][0] * sc + bv[bj][0], v1 = acc[ai][bj][m][1] * sc + bv[bj][1];
#pragma unroll
                    for (int e = 0; e < 4; ++e) { v0[e] = sigmoidf_(v0[e]); v1[e] = sigmoidf_(v1[e]); }
                    u32x4 w; w.x = cvt_pk_bf16(v0[0], v0[1]); w.y = cvt_pk_bf16(v0[2], v0[3]); w.z = cvt_pk_bf16(v1[0], v1[1]); w.w = cvt_pk_bf16(v1[2], v1[3]);
                    *(u32x4*)(rowp + bj * HALF) = w; } }
    }
};
struct EpiMerge {
    static constexpr bool PERM = true, AFTER_DRAIN = false;
    const bf16_t* g01; const bf16_t* g2; bf16_t* O;
    __device__ __forceinline__ bool keep(const Unit& u) const { return u.br != 2; }
    __device__ __forceinline__ void operator()(f32x4 (&acc)[2][2][4][2], const Unit& u, int wr, int wc, int fr, int fq) const {
        const int row0 = u.pm * BM + wr * 64 + fr, col0 = u.pn * BM + wc * 32 + 8 * fq; const int br = u.br;
        const bf16_t* nb = g01; int nld = 2048; const bf16_t* db = g2; int dld = 1024;
        if (br == 1) { nb = g2; nld = 1024; db = g01 + 1024; dld = 2048; }
        if (br == 2) { nb = g01 + 1024; db = nb; dld = 2048; }
#pragma unroll
        for (int ai = 0; ai < 2; ++ai)
#pragma unroll
            for (int m = 0; m < 4; ++m) { const int row = row0 + ai * HALF + m * 16;
#pragma unroll
                for (int bj = 0; bj < 2; ++bj) { const int col = col0 + bj * HALF;
                    const u32x4 num = *(const u32x4*)(nb + (size_t)row * nld + col);
                    const u32x4 den = *(const u32x4*)(db + (size_t)row * dld + col);
                    float f[8];
#pragma unroll
                    for (int e = 0; e < 4; ++e) { const unsigned nw = num[e], dw = den[e];
                        f[2 * e] = (br == 2) ? bf_lo(nw) : bf_lo(nw) * __builtin_amdgcn_rcpf(bf_lo(dw)); f[2 * e + 1] = (br == 2) ? bf_hi(nw) : bf_hi(nw) * __builtin_amdgcn_rcpf(bf_hi(dw)); }
                    f32x4 v0 = acc[ai][bj][m][0], v1 = acc[ai][bj][m][1];
                    v0[0] *= f[0]; v0[1] *= f[1]; v0[2] *= f[2]; v0[3] *= f[3]; v1[0] *= f[4]; v1[1] *= f[5]; v1[2] *= f[6]; v1[3] *= f[7];
                    acc[ai][bj][m][0] = v0; acc[ai][bj][m][1] = v1;
                    if (br == 2) { u32x4 w; w.x = cvt_pk_bf16(v0[0], v0[1]); w.y = cvt_pk_bf16(v0[2], v0[3]); w.z = cvt_pk_bf16(v1[0], v1[1]); w.w = cvt_pk_bf16(v1[2], v1[3]);
                        *(u32x4*)(O + (size_t)row * 1024 + col) = w; } }
                asm volatile("" ::: "memory"); }
    }
};
struct EpiResF32 {
    static constexpr bool PERM = false, AFTER_DRAIN = false;
    const float* base; float* out; int ldc;
    __device__ __forceinline__ bool keep(const Unit&) const { return false; }
    __device__ __forceinline__ void operator()(f32x4 (&acc)[2][2][4][2], const Unit& u, int wr, int wc, int fr, int fq) const {
        const int row0 = u.pm * BM + wr * 64 + fr, col0 = u.pn * BM + wc * 32 + 4 * fq;
#pragma unroll
        for (int ai = 0; ai < 2; ++ai)
#pragma unroll
            for (int m = 0; m < 4; ++m) { const size_t off = (size_t)(row0 + ai * HALF + m * 16) * ldc + col0;
#pragma unroll
                for (int bj = 0; bj < 2; ++bj)
#pragma unroll
                    for (int n = 0; n < 2; ++n) { const f32x4 bs = *(const f32x4*)(base + off + bj * HALF + n * 16); *(f32x4*)(out + off + bj * HALF + n * 16) = bs + acc[ai][bj][m][n]; } }
    }
};

template <class Epi, class Sched, bool ALIGN_EPI = false, bool SP2 = false>
__device__ __forceinline__ void gemm_phase(PG8_LAS unsigned char* lds, const Gemm g, const Sched& S, const Epi& E) {
    const int tid = threadIdx.x, wid = __builtin_amdgcn_readfirstlane(tid >> 6), lane = tid & 63, wr = wid >> 2, wc = wid & 3, fr = lane & 15, fq = lane >> 4;
    const int K = g.K, nt = K / BK;
    unsigned voffA[2], voffB[2];
#pragma unroll
    for (int i = 0; i < 2; ++i) { int R, C; stage_rc(tid * 16 + i * 8192, R, C); const int Rb = Epi::PERM ? ((R & ~31) + perm32(R & 31)) : R;
        voffA[i] = (unsigned)(R * K + C) * 2u; voffB[i] = (unsigned)(Rb * K + C) * 2u; }
    const size_t kstep = (size_t)(BK * 2);
    const size_t hstep = (size_t)HALF * K * 2;
    const size_t tstep = 2 * hstep;
    const unsigned ldsw = (unsigned)wid * 1024u;
    const int aoff = lds_byte(wr * 64 + fr, fq * 8), boff = lds_byte(wc * 32 + fr, fq * 8);
#define PG8_SA(b, h) (((b) * 2 + (h)) * HTB)
#define PG8_SB(b, h) ((4 + (b) * 2 + (h)) * HTB)
#define PG8_STAGE(bufoff, gbase, voff) do { _Pragma("unroll") for (int _i = 0; _i < 2; ++_i) \
        __builtin_amdgcn_global_load_lds((const unsigned*)((const char*)(gbase) + (voff)[_i]), (PG8_LAS unsigned*)(lds + (bufoff) + ldsw + _i * 8192), 16, 0, 0); } while (0)
#define PG8_LDA(dst, b, h) do { _Pragma("unroll") for (int m = 0; m < 4; ++m) _Pragma("unroll") for (int k = 0; k < 2; ++k) dst[m][k] = *(const PG8_LAS bf16x8*)(lds + PG8_SA(b, h) + aoff + m * 2048 + k * 1024); } while (0)
#define PG8_LDB(dst, b, h) do { _Pragma("unroll") for (int n = 0; n < 2; ++n) _Pragma("unroll") for (int k = 0; k < 2; ++k) dst[n][k] = *(const PG8_LAS bf16x8*)(lds + PG8_SB(b, h) + boff + n * 2048 + k * 1024); } while (0)
#define PG8_MMA(ai, bj, At, Bt) do { __builtin_amdgcn_s_setprio(1); _Pragma("unroll") for (int m = 0; m < 4; ++m) _Pragma("unroll") for (int n = 0; n < 2; ++n) _Pragma("unroll") for (int k = 0; k < 2; ++k) \
        acc[ai][bj][m][n] = __builtin_amdgcn_mfma_f32_16x16x32_bf16(Bt[n][k], At[m][k], acc[ai][bj][m][n], 0, 0, 0); __builtin_amdgcn_s_setprio(0); } while (0)
#define PG8_WAIT_V(n) asm volatile("s_waitcnt vmcnt(" #n ")" ::: "memory")
#define PG8_WAIT_L(n) asm volatile("s_waitcnt lgkmcnt(" #n ")" ::: "memory")
#define PG8_BAR __builtin_amdgcn_s_barrier()
#define PG8_SCHED __builtin_amdgcn_sched_barrier(0)
    Unit cur, nxt; int ui = 0;
    if (!S.next(0, cur)) return;
    f32x4 acc[2][2][4][2];
#pragma unroll
    for (int a = 0; a < 2; ++a)
#pragma unroll
        for (int b = 0; b < 2; ++b)
#pragma unroll
            for (int m = 0; m < 4; ++m)
#pragma unroll
                for (int n = 0; n < 2; ++n) acc[a][b][m][n] = (f32x4){0.f, 0.f, 0.f, 0.f};
    bf16x8 At[4][2], B0[2][2], B1[2][2];
    const char* cA = (const char*)g.a(cur.br) + (size_t)cur.pm * tstep; const char* cB = (const char*)g.b(cur.br) + (size_t)cur.pn * tstep;
    S.a_ready(cur);
    if constexpr (SP2) {
        PG8_STAGE(PG8_SB(0, 0), cB, voffB); PG8_STAGE(PG8_SB(0, 1), cB + hstep, voffB); PG8_STAGE(PG8_SA(0, 0), cA, voffA); PG8_STAGE(PG8_SA(0, 1), cA + hstep, voffA);
        if (wr == 1) PG8_BAR;
        PG8_WAIT_V(2); PG8_BAR;
        PG8_STAGE(PG8_SB(1, 0), cB + kstep, voffB); PG8_STAGE(PG8_SA(1, 0), cA + kstep, voffA); PG8_STAGE(PG8_SB(1, 1), cB + hstep + kstep, voffB);
        PG8_WAIT_V(6); PG8_BAR;
    } else {
        PG8_STAGE(PG8_SB(0, 0), cB, voffB); PG8_STAGE(PG8_SA(0, 0), cA, voffA); PG8_STAGE(PG8_SB(0, 1), cB + hstep, voffB); PG8_STAGE(PG8_SA(0, 1), cA + hstep, voffA);
        if (wr == 1) PG8_BAR;
        PG8_WAIT_V(4); PG8_BAR;
        PG8_STAGE(PG8_SB(1, 0), cB + kstep, voffB); PG8_STAGE(PG8_SA(1, 0), cA + kstep, voffA); PG8_STAGE(PG8_SB(1, 1), cB + hstep + kstep, voffB);
        PG8_WAIT_V(6); PG8_BAR;
    }
    for (;;) {
        const bool has_next = S.next(ui + 1, nxt);
        const char* nA = has_next ? (const char*)g.a(nxt.br) + (size_t)nxt.pm * tstep : cA; const char* nB = has_next ? (const char*)g.b(nxt.br) + (size_t)nxt.pn * tstep : cB;
        for (int t = 0; t < nt; t += 2) {
            const bool last = (t == nt - 2);
            const char* a1 = cA + (size_t)(t + 1) * kstep;
            const char* a2 = last ? nA : cA + (size_t)(t + 2) * kstep; const char* b2 = last ? nB : cB + (size_t)(t + 2) * kstep;
            const char* a3 = a2 + kstep; const char* b3 = b2 + kstep;
            if (last && has_next) S.a_ready(nxt);
            if constexpr (SP2) {
            PG8_LDB(B0, 0, 0); PG8_LDB(B1, 0, 1); PG8_SCHED; PG8_LDA(At, 0, 0); PG8_STAGE(PG8_SA(1, 1), a1 + hstep, voffA);
            PG8_WAIT_V(8); PG8_WAIT_L(0); PG8_BAR; PG8_MMA(0, 0, At, B0); PG8_MMA(0, 1, At, B1); PG8_BAR; PG8_SCHED;
            PG8_LDA(At, 0, 1); PG8_STAGE(PG8_SB(0, 0), b2, voffB); PG8_STAGE(PG8_SB(0, 1), b2 + hstep, voffB); PG8_STAGE(PG8_SA(0, 0), a2, voffA);
            PG8_WAIT_V(8); PG8_WAIT_L(0); PG8_BAR; PG8_MMA(1, 0, At, B0); PG8_MMA(1, 1, At, B1); PG8_BAR; PG8_SCHED;
            PG8_LDB(B0, 1, 0); PG8_LDB(B1, 1, 1); PG8_SCHED; PG8_LDA(At, 1, 0); PG8_STAGE(PG8_SA(0, 1), a2 + hstep, voffA);
            PG8_WAIT_V(8); PG8_WAIT_L(0); PG8_BAR; PG8_MMA(0, 0, At, B0); PG8_MMA(0, 1, At, B1); PG8_BAR; PG8_SCHED;
            PG8_LDA(At, 1, 1); PG8_STAGE(PG8_SB(1, 0), b3, voffB); PG8_STAGE(PG8_SB(1, 1), b3 + hstep, voffB); PG8_STAGE(PG8_SA(1, 0), a3, voffA);
            PG8_WAIT_V(8); PG8_WAIT_L(0); PG8_BAR; PG8_MMA(1, 0, At, B0); PG8_MMA(1, 1, At, B1); PG8_BAR; PG8_SCHED;
            } else {
            PG8_LDB(B0, 0, 0); PG8_SCHED; PG8_LDA(At, 0, 0); PG8_STAGE(PG8_SA(1, 1), a1 + hstep, voffA);
            PG8_WAIT_L(8); PG8_BAR; PG8_WAIT_L(0); PG8_MMA(0, 0, At, B0); PG8_BAR; PG8_SCHED;
            PG8_LDB(B1, 0, 1); PG8_STAGE(PG8_SB(0, 0), b2, voffB);
            PG8_BAR; PG8_WAIT_L(0); PG8_MMA(0, 1, At, B1); PG8_BAR;
            PG8_LDA(At, 0, 1); PG8_STAGE(PG8_SA(0, 0), a2, voffA);
            PG8_BAR; PG8_WAIT_L(0); PG8_MMA(1, 0, At, B0); PG8_BAR; PG8_SCHED;
            PG8_STAGE(PG8_SB(0, 1), b2 + hstep, voffB);
            PG8_WAIT_V(6); PG8_BAR; PG8_MMA(1, 1, At, B1); PG8_BAR;
            PG8_LDB(B0, 1, 0); PG8_SCHED; PG8_LDA(At, 1, 0); PG8_STAGE(PG8_SA(0, 1), a2 + hstep, voffA);
            PG8_WAIT_L(8); PG8_BAR; PG8_WAIT_L(0); PG8_MMA(0, 0, At, B0); PG8_BAR; PG8_SCHED;
            PG8_LDB(B1, 1, 1); PG8_STAGE(PG8_SB(1, 0), b3, voffB);
            PG8_BAR; PG8_WAIT_L(0); PG8_MMA(0, 1, At, B1); PG8_BAR;
            PG8_LDA(At, 1, 1); PG8_STAGE(PG8_SA(1, 0), a3, voffA);
            PG8_BAR; PG8_WAIT_L(0); PG8_MMA(1, 0, At, B0); PG8_BAR; PG8_SCHED;
            PG8_STAGE(PG8_SB(1, 1), b3 + hstep, voffB);
            PG8_WAIT_V(6); PG8_BAR; PG8_MMA(1, 1, At, B1); PG8_BAR;
            }
        }
        if constexpr (ALIGN_EPI) { if (wr == 0) PG8_BAR; }
        if constexpr (!Epi::AFTER_DRAIN) { E(acc, cur, wr, wc, fr, fq); S.done(cur); }
        if (!has_next) break;
        if (!E.keep(cur)) {
#pragma unroll
        for (int a = 0; a < 2; ++a)
#pragma unroll
            for (int b = 0; b < 2; ++b)
#pragma unroll
                for (int m = 0; m < 4; ++m)
#pragma unroll
                    for (int n = 0; n < 2; ++n) acc[a][b][m][n] = (f32x4){0.f, 0.f, 0.f, 0.f};
        }
        cur = nxt; cA = nA; cB = nB; ++ui;
        if constexpr (ALIGN_EPI) { if (wr == 1) PG8_BAR; }
    }
    PG8_WAIT_V(0);
    if constexpr (!ALIGN_EPI) { if (wr == 0) PG8_BAR; }
    PG8_BAR;
    if constexpr (Epi::AFTER_DRAIN) { E.fused(acc, cur, wr, wc, fr, fq, lds, wid, lane); S.done(cur); }
#undef PG8_SA
#undef PG8_SB
#undef PG8_STAGE
#undef PG8_LDA
#undef PG8_LDB
#undef PG8_MMA
#undef PG8_WAIT_V
#undef PG8_WAIT_L
#undef PG8_BAR
#undef PG8_SCHED
}
}

#define LAS __attribute__((address_space(3)))
typedef unsigned short bf16;
typedef short bf16x8 __attribute__((ext_vector_type(8)));
typedef short s16x4 __attribute__((ext_vector_type(4)));
typedef float f32x4 __attribute__((ext_vector_type(4)));
typedef float f32x16 __attribute__((ext_vector_type(16)));
typedef unsigned u32x4 __attribute__((ext_vector_type(4)));
typedef unsigned u32x2 __attribute__((ext_vector_type(2)));
typedef unsigned long long u64;

constexpr int NB = 4, SEQ = 4096, DM = 1024, T = NB * SEQ, MEML = 256, MT = NB * MEML;
constexpr int NIN_SRC = 8776, N1A = 5888, N1B = 3072, NIN = N1A + N1B;
constexpr int GAP0 = 2632, GAPLEN = 184;
constexpr float RMS_EPS = 1e-6f, LOG2E = 1.4426950408889634f;
constexpr int NWAVES = 8, NTHR = 512;
constexpr int LDS_BYTES = 147456;

constexpr size_t MiB = (size_t)1 << 20;
constexpr size_t WS_WIN = 0, WS_WMKV = 35 * MiB / 2, WS_WOA = 39 * MiB / 2, WS_WOM = 41 * MiB / 2, WS_WOB = 43 * MiB / 2, WS_WO = 45 * MiB / 2, WS_MEMB = 49 * MiB / 2, WS_MKV = 53 * MiB / 2;
constexpr size_t WS_RSTDX = 57 * MiB / 2, WS_RSTDM = WS_RSTDX + 65536;
constexpr size_t WS_MASK = 29 * MiB, WS_KIWI = 37 * MiB, WS_XB = 48 * MiB;
constexpr size_t WS_QA = 80 * MiB, WS_KA = 96 * MiB, WS_VA = 112 * MiB, WS_ZA = 128 * MiB, WS_QI = 144 * MiB, WS_QM = 160 * MiB, WS_ZM = 176 * MiB, WS_XBR = 240 * MiB;
static_assert(WS_XBR - WS_QM == WS_QM - WS_QA && WS_WOB - WS_WOM == WS_WOM - WS_WOA, "uniform strides of the three out-projection operands");
constexpr size_t WS_G2 = WS_KA  , WS_MERGED = WS_ZA  ;
static_assert((size_t)NIN * DM * 2 == 35 * MiB / 2, "w_in copy size");

struct Params {
    const float *x, *mem, *norm_g, *mem_norm_g, *w_in, *b_gate, *w_mem_kv, *q_norm_a, *k_norm_a, *q_norm_m, *k_norm_m, *conv_w, *w_out_a, *w_out_b, *w_out_m, *w_o;
    float* out; unsigned char* ws;
};

__device__ __forceinline__ unsigned f2bf(float f) { unsigned u = __builtin_bit_cast(unsigned, f); return (u + 0x7fffu + ((u >> 16) & 1u)) >> 16; }
__device__ __forceinline__ unsigned pk2(float lo, float hi) { return f2bf(lo) | (f2bf(hi) << 16); }
__device__ __forceinline__ float bflo(unsigned w) { return __uint_as_float(w << 16); }
__device__ __forceinline__ float bfhi(unsigned w) { return __uint_as_float(w & 0xffff0000u); }
__device__ __forceinline__ float bf2f(bf16 h) { return __uint_as_float((unsigned)h << 16); }
__device__ __forceinline__ float wave_sum(float v) {
#pragma unroll
    for (int o = 1; o < 64; o <<= 1) v += __shfl_xor(v, o);
    return v;
}
__device__ __forceinline__ float siluf_(float z) { return z * __builtin_amdgcn_rcpf(1.0f + __builtin_amdgcn_exp2f(-LOG2E * z)); }

__device__ __forceinline__ void p0_transpose_item(const float* W, int K, int Nsrc, int Ndst, const float* gain, int gap0, int gaplen, bf16* WT, LAS float* scr, int item, int lane) {
    const int nblk = Ndst / 32, kb = item / nblk, nb = item % nblk, k0 = 64 * kb, n0 = 32 * nb;
    const int nd = n0 + (lane & 31); const bool valid = (nd < gap0) || (nd >= gap0 + gaplen); const int ns = nd < gap0 ? nd : nd - gaplen;
#pragma unroll 8
    for (int i = 0; i < 32; ++i) { const int kk = 2 * i + (lane >> 5); float v = 0.f; if (valid) { v = W[(size_t)(k0 + kk) * Nsrc + ns]; if (gain) v *= gain[k0 + kk]; } scr[kk * 33 + (lane & 31)] = v; }
    asm volatile("s_waitcnt lgkmcnt(0)" ::: "memory");
    const int c = lane & 7;
#pragma unroll
    for (int j = 0; j < 4; ++j) { const int n = (lane >> 3) + 8 * j; const LAS float* s = scr + (8 * c) * 33 + n;
        u32x4 o; o.x = pk2(s[0 * 33], s[1 * 33]); o.y = pk2(s[2 * 33], s[3 * 33]); o.z = pk2(s[4 * 33], s[5 * 33]); o.w = pk2(s[6 * 33], s[7 * 33]);
        *(u32x4*)(WT + (size_t)(n0 + n) * K + k0 + 8 * c) = o; }
    asm volatile("s_waitcnt lgkmcnt(0)" ::: "memory");
}
__device__ __forceinline__ void row_to_bf16(const float* xrow, bf16* orow, float* rstd_out, int lane) {
    const f32x4* xr = (const f32x4*)xrow + lane; f32x4 v[4]; float s = 0.f;
#pragma unroll
    for (int j = 0; j < 4; ++j) { v[j] = xr[64 * j]; s += (v[j].x * v[j].x + v[j].y * v[j].y) + (v[j].z * v[j].z + v[j].w * v[j].w); }
    s = wave_sum(s);
    if (lane == 0) *rstd_out = 1.0f / sqrtf(s * (1.0f / DM) + RMS_EPS);
    u32x2* o8 = (u32x2*)orow + lane;
#pragma unroll
    for (int j = 0; j < 4; ++j) { u32x2 w; w.x = pk2(v[j].x, v[j].y); w.y = pk2(v[j].z, v[j].w); o8[64 * j] = w; }
}
__device__ __forceinline__ void phase0(const Params& p, LAS unsigned char* lds, int vcu, int G) {
    const int tid = threadIdx.x, lane = tid & 63, wave = tid >> 6;
    LAS float* scr = (LAS float*)(lds + wave * 16384);
    const int gw = vcu * NWAVES + wave, NGW = G * NWAVES;
    unsigned char* ws = p.ws;
    constexpr int I_IN = (DM / 64) * (NIN / 32), I_MKV = (DM / 64) * (1024 / 32), I_OX = (512 / 64) * (1024 / 32), I_O = (DM / 64) * (1024 / 32);
    constexpr int NITEMS = I_IN + I_MKV + 3 * I_OX + I_O;
    for (int it = gw; it < NITEMS; it += NGW) {
        int r = it;
        if (r < I_IN) { p0_transpose_item(p.w_in, DM, NIN_SRC, NIN, p.norm_g, GAP0, GAPLEN, (bf16*)(ws + WS_WIN), scr, r, lane); continue; } r -= I_IN;
        if (r < I_MKV) { p0_transpose_item(p.w_mem_kv, DM, 1024, 1024, p.mem_norm_g, 1 << 30, 0, (bf16*)(ws + WS_WMKV), scr, r, lane); continue; } r -= I_MKV;
        if (r < I_OX) { p0_transpose_item(p.w_out_a, 512, 1024, 1024, nullptr, 1 << 30, 0, (bf16*)(ws + WS_WOA), scr, r, lane); continue; } r -= I_OX;
        if (r < I_OX) { p0_transpose_item(p.w_out_b, 512, 1024, 1024, nullptr, 1 << 30, 0, (bf16*)(ws + WS_WOB), scr, r, lane); continue; } r -= I_OX;
        if (r < I_OX) { p0_transpose_item(p.w_out_m, 512, 1024, 1024, nullptr, 1 << 30, 0, (bf16*)(ws + WS_WOM), scr, r, lane); continue; } r -= I_OX;
        p0_transpose_item(p.w_o, DM, 1024, 1024, nullptr, 1 << 30, 0, (bf16*)(ws + WS_WO), scr, r, lane);
    }
    for (int m = gw; m < T + MT; m += NGW) {
        if (m < T) row_to_bf16(p.x + (size_t)m * DM, (bf16*)(ws + WS_XB) + (size_t)m * DM, (float*)(ws + WS_RSTDX) + m, lane);
        else { const int mm = m - T; row_to_bf16(p.mem + (size_t)mm * DM, (bf16*)(ws + WS_MEMB) + (size_t)mm * DM, (float*)(ws + WS_RSTDM) + mm, lane); }
    }
}

template <int HD>
__device__ __forceinline__ void headnorm(bf16* X, int ld, int R, int NH, const float* gain, float oscale, int gtid, int gthreads) {
    constexpr int TPH = HD / 8;
    const long total = (long)R * NH * TPH;
    for (long i = gtid; i < total; i += gthreads) {
        const int part = (int)(i % TPH); const long rh = i / TPH; const int head = (int)(rh % NH); const long row = rh / NH;
        bf16* ptr = X + row * ld + head * HD + part * 8;
        const u32x4 w = *(const u32x4*)ptr; float f[8];
#pragma unroll
        for (int e = 0; e < 4; ++e) { f[2 * e] = bflo(w[e]); f[2 * e + 1] = bfhi(w[e]); }
        float s = 0.f;
#pragma unroll
        for (int e = 0; e < 8; ++e) s += f[e] * f[e];
#pragma unroll
        for (int o = 1; o < TPH; o <<= 1) s += __shfl_xor(s, o);
        const float r = oscale / sqrtf(s * (1.0f / HD) + RMS_EPS);
        const f32x4 g0 = *(const f32x4*)(gain + part * 8), g1 = *(const f32x4*)(gain + part * 8 + 4);
        u32x4 o; o.x = pk2(f[0] * r * g0.x, f[1] * r * g0.y); o.y = pk2(f[2] * r * g0.z, f[3] * r * g0.w); o.z = pk2(f[4] * r * g1.x, f[5] * r * g1.y); o.w = pk2(f[6] * r * g1.z, f[7] * r * g1.w);
        *(u32x4*)ptr = o;
    }
}
__device__ __forceinline__ void conv_branch(const bf16* BR, const float* cw, bf16* XO, int gtid, int gthreads) {
    const long total = (long)T * 64;
    for (long i = gtid; i < total; i += gthreads) {
        const int c8 = (int)(i & 63) * 8; const long row = i >> 6; const int tl = (int)(row & (SEQ - 1));
        const bf16* rp = BR + row * 2048 + c8;
        float y[8];
#pragma unroll
        for (int e = 0; e < 8; ++e) y[e] = 0.f;
#pragma unroll
        for (int k = 0; k < 3; ++k) {
            const int back = 2 - k;
            if (tl - back >= 0) {
                const u32x4 cgw = *(const u32x4*)(rp - (long)back * 2048 + 512), hbw = *(const u32x4*)(rp - (long)back * 2048 + 1024);
                const f32x4 w0 = *(const f32x4*)(cw + k * 512 + c8), w1 = *(const f32x4*)(cw + k * 512 + c8 + 4);
                const float wk[8] = {w0.x, w0.y, w0.z, w0.w, w1.x, w1.y, w1.z, w1.w};
#pragma unroll
                for (int e = 0; e < 4; ++e) { y[2 * e] += wk[2 * e] * (bflo(cgw[e]) * bflo(hbw[e])); y[2 * e + 1] += wk[2 * e + 1] * (bfhi(cgw[e]) * bfhi(hbw[e])); }
            }
        }
        const u32x4 bgw = *(const u32x4*)(rp), zbw = *(const u32x4*)(rp + 1536);
        u32x4 o;
#pragma unroll
        for (int e = 0; e < 4; ++e) { const float a = bflo(bgw[e]) * y[2 * e] * siluf_(bflo(zbw[e])), b = bfhi(bgw[e]) * y[2 * e + 1] * siluf_(bfhi(zbw[e])); o[e] = pk2(a, b); }
        *(u32x4*)(XO + row * 512 + c8) = o;
    }
}

__device__ __forceinline__ int count_ge(const unsigned (&v)[64], unsigned cand, int nj) {
    int cnt = 0;
#pragma unroll
    for (int c4 = 0; c4 < 4; ++c4) {
        if (16 * c4 < nj) {
#pragma unroll
            for (int jj = 0; jj < 16; ++jj) cnt += (v[16 * c4 + jj] >= cand) ? 1 : 0;
        }
    }
#pragma unroll
    for (int o = 1; o < 64; o <<= 1) cnt += __shfl_xor(cnt, o);
    return __builtin_amdgcn_readfirstlane(cnt);
}
__device__ __forceinline__ void topk_unit(LAS unsigned char* lds, const bf16* QI, const bf16* KIWI, u64* MASK, int b, int tb) {
    const int tid = threadIdx.x, lane = tid & 63, wid = __builtin_amdgcn_readfirstlane(tid >> 6), r32 = lane & 31, hi = lane >> 5;
    const int t0 = tb * 8; const size_t rowb = (size_t)b * SEQ;
    LAS unsigned* SC = (LAS unsigned*)lds;
    const int ntile = ((t0 + 8 + 63) >> 6) << 1;
    const float idx_scale = 0.125f * 0.35355339059327373f;
    bf16x8 af[2][4]; float wv[2][16];
    {
        const int rho = r32, qq = 2 * ((rho >> 2) & 1) + (rho >> 4), head = (rho & 3) + 4 * ((rho >> 3) & 1);
#pragma unroll
        for (int m = 0; m < 2; ++m) { const bf16* pq = QI + (rowb + t0 + 4 * m + qq) * 512 + head * 64 + 8 * hi;
#pragma unroll
            for (int ks = 0; ks < 4; ++ks) af[m][ks] = *(const bf16x8*)(pq + 16 * ks); }
#pragma unroll
        for (int m = 0; m < 2; ++m)
#pragma unroll
            for (int r = 0; r < 16; ++r) wv[m][r] = bf2f(KIWI[(rowb + t0 + 4 * m + 2 * hi + (r >> 3)) * 256 + 64 + (r & 7)]) * idx_scale;
    }
    for (int j = wid; j < ntile; j += NWAVES) {
        const int key = 32 * j + r32;
        const bf16* kp = KIWI + (rowb + key) * 256 + 8 * hi;
        bf16x8 bfr[4];
#pragma unroll
        for (int ks = 0; ks < 4; ++ks) bfr[ks] = *(const bf16x8*)(kp + 16 * ks);
        f32x16 c[2];
#pragma unroll
        for (int m = 0; m < 2; ++m) {
#pragma unroll
            for (int r = 0; r < 16; ++r) c[m][r] = 0.f;
#pragma unroll
            for (int ks = 0; ks < 4; ++ks) c[m] = __builtin_amdgcn_mfma_f32_32x32x16_bf16(af[m][ks], bfr[ks], c[m], 0, 0, 0);
        }
#pragma unroll
        for (int m = 0; m < 2; ++m)
#pragma unroll
            for (int ql = 0; ql < 2; ++ql) {
                float sc = 0.f;
#pragma unroll
                for (int h = 0; h < 8; ++h) sc += wv[m][8 * ql + h] * fmaxf(c[m][8 * ql + h], 0.f);
                const int q = 4 * m + 2 * hi + ql;
                const unsigned u = __float_as_uint(sc); unsigned k = (u & 0x80000000u) ? ~u : (u | 0x80000000u);
                if (key > t0 + q) k = 0u;
                SC[q * 4096 + key] = k;
            }
    }
    __syncthreads();
    {
        const int q = wid, t = t0 + q, n = t + 1, nj = (n + 63) >> 6;
        unsigned wlo = 0u, whi = 0u;
        if (n <= 256) {
            const int lo = 64 * lane; u64 w;
            if (lo + 63 <= t) w = ~0ull; else if (lo > t) w = 0ull; else w = (1ull << (t - lo + 1)) - 1ull;
            wlo = (unsigned)w; whi = (unsigned)(w >> 32);
        } else {
            unsigned v[64];
#pragma unroll
            for (int j = 0; j < 64; ++j) v[j] = 0u;
#pragma unroll
            for (int c4 = 0; c4 < 4; ++c4) {
                if (16 * c4 < nj) {
#pragma unroll
                    for (int jj = 0; jj < 16; ++jj) { const int j = 16 * c4 + jj; if (j < nj) v[j] = SC[q * 4096 + 64 * j + lane]; }
                }
            }
            unsigned tau = 0u; int cge = 0;
            for (int bit = 31; bit >= 0; --bit) {
                const unsigned cand = tau | (1u << bit);
                const int cnt = count_ge(v, cand, nj);
                if (cnt >= 256) { tau = cand; cge = cnt; if (cnt == 256) break; }
            }
            if (cge == 256) {
#pragma unroll
                for (int j = 0; j < 64; ++j) { const u64 bal = __ballot(v[j] >= tau); if (lane == j) { wlo = (unsigned)bal; whi = (unsigned)(bal >> 32); } }
            } else {
                const int cgt = count_ge(v, tau + 1u, nj); int need = 256 - cgt;
#pragma unroll
                for (int j = 0; j < 64; ++j) {
                    const u64 gtb = __ballot(v[j] > tau); u64 eqb = __ballot(v[j] == tau); u64 takeb = 0ull;
                    const int pc = __popcll(eqb);
                    if (pc <= need) { takeb = eqb; need -= pc; }
                    else { while (need > 0) { const u64 low = eqb & (0ull - eqb); takeb |= low; eqb ^= low; --need; } }
                    const u64 bal = gtb | takeb;
                    if (lane == j) { wlo = (unsigned)bal; whi = (unsigned)(bal >> 32); }
                }
            }
        }
        u32x2 w2; w2.x = wlo; w2.y = whi;
        *(u32x2*)(MASK + (rowb + t) * 64 + lane) = w2;
    }
    __syncthreads();
}

__device__ __forceinline__ s16x4 vtr(const LAS unsigned char* p) { typedef short v4i16_t __attribute__((ext_vector_type(4))); return __builtin_bit_cast(s16x4, __builtin_amdgcn_ds_read_tr16_b64_v4i16((LAS v4i16_t*)p)); }
__device__ __forceinline__ int crow(int r, int hi) { return (r & 3) + 8 * (r >> 2) + 4 * hi; }
template <int D, bool MASKED>
__device__ __forceinline__ void flash_unit(LAS unsigned char* lds, const bf16* Q, int ldq, const bf16* K, int ldk, const bf16* V, int ldv, bf16* O, int ldo, const bf16* Z, int ldz,
                                           int nt, const u64* mask, float slope2) {
    constexpr int KS = D / 16, DB = D / 32, KR = D / 64;
    constexpr int KBYTES = D * 128, BUFB = 2 * KBYTES;
    const int tid = threadIdx.x, lane = tid & 63, wid = __builtin_amdgcn_readfirstlane(tid >> 6), r32 = lane & 31, hi = lane >> 5;
    const float NEG = -1.0e30f;
    bf16x8 qf[KS];
    { const bf16* qp = Q + (size_t)(wid * 32 + r32) * ldq + 8 * hi;
#pragma unroll
      for (int ks = 0; ks < KS; ++ks) qf[ks] = *(const bf16x8*)(qp + 16 * ks); }
    f32x16 o[DB];
#pragma unroll
    for (int d = 0; d < DB; ++d)
#pragma unroll
        for (int r = 0; r < 16; ++r) o[d][r] = 0.f;
    float m_run = NEG, l_run = 0.f;
    u32x4 kreg[KR], vreg[KR];
    const bf16* ksrc = K + (size_t)lane * ldk + wid * 8;
    const bf16* vsrc = V + (size_t)(16 * (wid & 3) + (lane >> 2)) * ldv + (wid >> 2) * 32 + (lane & 3) * 8;
    const int kdst = wid * 1024 + lane * 16, vdst = KBYTES + (wid >> 2) * 4096 + (16 * (wid & 3) + (lane >> 2)) * 64 + (lane & 3) * 16;
#pragma unroll
    for (int i = 0; i < KR; ++i) { kreg[i] = *(const u32x4*)(ksrc + i * 64); vreg[i] = *(const u32x4*)(vsrc + i * 64); }
    u64 mw = 0ull;
    const u64* mrow = mask + (size_t)(wid * 32 + r32) * 64;
    if (MASKED) mw = mrow[0];
    const int kfb = hi * 1024 + r32 * 16;
    const int vfb = KBYTES + (4 * hi + ((lane & 15) >> 2)) * 64 + ((lane >> 4) & 1) * 32 + (lane & 3) * 8;
    for (int t = 0; t < nt; ++t) {
        LAS unsigned char* buf = lds + (t & 1) * BUFB;
#pragma unroll
        for (int i = 0; i < KR; ++i) { *(LAS u32x4*)(buf + kdst + i * 8192) = kreg[i]; *(LAS u32x4*)(buf + vdst + i * 8192) = vreg[i]; }
        __syncthreads();
        const u64 mcur = mw;
        if (t + 1 < nt) {
#pragma unroll
            for (int i = 0; i < KR; ++i) { kreg[i] = *(const u32x4*)(ksrc + (size_t)(t + 1) * 64 * ldk + i * 64); vreg[i] = *(const u32x4*)(vsrc + (size_t)(t + 1) * 64 * ldv + i * 64); }
            if (MASKED) mw = mrow[t + 1];
        }
        f32x16 c0, c1;
#pragma unroll
        for (int r = 0; r < 16; ++r) { c0[r] = 0.f; c1[r] = 0.f; }
#pragma unroll
        for (int ks = 0; ks < KS; ++ks) {
            const bf16x8 a0 = *(const LAS bf16x8*)(buf + kfb + ks * 2048), a1 = *(const LAS bf16x8*)(buf + kfb + ks * 2048 + 512);
            c0 = __builtin_amdgcn_mfma_f32_32x32x16_bf16(a0, qf[ks], c0, 0, 0, 0);
            c1 = __builtin_amdgcn_mfma_f32_32x32x16_bf16(a1, qf[ks], c1, 0, 0, 0);
        }
        if (MASKED) {
            const unsigned mlo = (unsigned)mcur >> (4 * hi), mhi = (unsigned)(mcur >> 32) >> (4 * hi);
            const float kvb = (float)(t * 64 + 4 * hi);
#pragma unroll
            for (int r = 0; r < 16; ++r) { const int bpos = (r & 3) + 8 * (r >> 2);
                c0[r] = ((mlo >> bpos) & 1u) ? c0[r] + slope2 * (kvb + (float)bpos) : NEG;
                c1[r] = ((mhi >> bpos) & 1u) ? c1[r] + slope2 * (kvb + (float)(bpos + 32)) : NEG; }
        }
        float mx = fmaxf(c0[0], c1[0]);
#pragma unroll
        for (int r = 1; r < 16; ++r) mx = fmaxf(mx, fmaxf(c0[r], c1[r]));
        mx = fmaxf(mx, __shfl_xor(mx, 32));
        const float m_new = fmaxf(m_run, mx), alpha = __builtin_amdgcn_exp2f(m_run - m_new);
        m_run = m_new;
        float ps = 0.f;
#pragma unroll
        for (int r = 0; r < 16; ++r) { c0[r] = __builtin_amdgcn_exp2f(c0[r] - m_new); c1[r] = __builtin_amdgcn_exp2f(c1[r] - m_new); ps += c0[r] + c1[r]; }
        l_run = l_run * alpha + ps;
#pragma unroll
        for (int d = 0; d < DB; ++d)
#pragma unroll
            for (int r = 0; r < 16; ++r) o[d][r] *= alpha;
        bf16x8 pf[4];
#pragma unroll
        for (int s = 0; s < 4; ++s) { u32x4 w;
#pragma unroll
            for (int e = 0; e < 4; ++e) { const int r = (s & 1) * 8 + 2 * e; w[e] = (s < 2) ? pg8::cvt_pk_bf16(c0[r], c0[r + 1]) : pg8::cvt_pk_bf16(c1[r], c1[r + 1]); }
            pf[s] = __builtin_bit_cast(bf16x8, w); }
#pragma unroll
        for (int d = 0; d < DB; ++d)
#pragma unroll
            for (int s = 0; s < 4; ++s) {
                const s16x4 lo4 = vtr(buf + vfb + d * 4096 + (16 * s) * 64), hi4 = vtr(buf + vfb + d * 4096 + (16 * s + 8) * 64);
                const bf16x8 vf = (bf16x8){lo4[0], lo4[1], lo4[2], lo4[3], hi4[0], hi4[1], hi4[2], hi4[3]};
                o[d] = __builtin_amdgcn_mfma_f32_32x32x16_bf16(vf, pf[s], o[d], 0, 0, 0);
            }
    }
    const float l_tot = l_run + __shfl_xor(l_run, 32), inv = 1.0f / l_tot;
    bf16* orow = O + (size_t)(wid * 32 + r32) * ldo; const bf16* zrow = Z + (size_t)(wid * 32 + r32) * ldz;
#pragma unroll
    for (int d = 0; d < DB; ++d)
#pragma unroll
        for (int rg = 0; rg < 4; ++rg) { const int d0 = d * 32 + 8 * rg + 4 * hi;
            const u32x2 zw = *(const u32x2*)(zrow + d0);
            u32x2 ow; ow.x = pk2(o[d][4 * rg] * inv * siluf_(bflo(zw.x)), o[d][4 * rg + 1] * inv * siluf_(bfhi(zw.x))); ow.y = pk2(o[d][4 * rg + 2] * inv * siluf_(bflo(zw.y)), o[d][4 * rg + 3] * inv * siluf_(bfhi(zw.y)));
            *(u32x2*)(orow + d0) = ow; }
    __syncthreads();
}

__device__ __forceinline__ void phase1(const Params& p, LAS unsigned char* lds, int G) {
    unsigned char* ws = p.ws; const int c = (int)blockIdx.x;
    pg8::Gemm g{(const bf16*)(ws + WS_XB), (const bf16*)(ws + WS_WIN), T, N1A, DM, ((long)WS_MEMB - (long)WS_XB) / 2, ((long)WS_WMKV - (long)WS_WIN) / 2};
    pg8::StaticOrder S; S.init(T, N1A, G, c, 1, MT, 1024);
    pg8::EpiProjA E{ws, (bf16*)p.out, (const float*)(ws + WS_RSTDX)};
    pg8::gemm_phase<pg8::EpiProjA, pg8::StaticOrder, true, true>(lds, g, S, E);
}
__device__ __forceinline__ void phase2(const Params& p, LAS unsigned char* lds, int G) {
    unsigned char* ws = p.ws; const int c = (int)blockIdx.x;
    const int gtid = c * NTHR + (int)threadIdx.x, gthreads = G * NTHR;
    headnorm<64>((bf16*)(ws + WS_QA), 512, T, 8, p.q_norm_a, 0.125f * LOG2E, gtid, gthreads);
    headnorm<64>((bf16*)(ws + WS_KA), 512, T, 8, p.k_norm_a, 1.0f, gtid, gthreads);
    headnorm<128>((bf16*)(ws + WS_QM), 512, T, 4, p.q_norm_m, 0.08838834764831845f * LOG2E, gtid, gthreads);
    headnorm<128>((bf16*)(ws + WS_MKV), 1024, MT, 4, p.k_norm_m, 1.0f, gtid, gthreads);
    conv_branch((const bf16*)p.out, p.conv_w, (bf16*)(ws + WS_XBR), gtid, gthreads);
    const int nunits = NB * (SEQ / 8);
    for (int r = 0; r * G < nunits; ++r) {
        const int u = r * G + ((r & 1) ? (G - 1 - c) : c);
        if (!SKIP_TOPK && u < nunits) topk_unit(lds, (const bf16*)(ws + WS_QI), (const bf16*)(ws + WS_KIWI), (u64*)(ws + WS_MASK), u & 3, u >> 2);
    }
}
__device__ __forceinline__ void phase3(const Params& p, LAS unsigned char* lds, int G) {
    unsigned char* ws = p.ws; const int c = (int)blockIdx.x;
    for (int v = c; v < 256; v += G) {
        const int bh = v >> 3, s = v & 7, b = bh >> 3, h = bh & 7;
        const float slope2 = exp2f(-(float)(h + 1)) * LOG2E;
#pragma unroll 1
        for (int k = 0; k < 2; ++k) {
            const int qb = k == 0 ? 15 - s : s; const size_t row0 = (size_t)b * SEQ + qb * 256;
            bf16* q = (bf16*)(ws + WS_QA) + row0 * 512 + h * 64;
            if (!SKIP_FA) flash_unit<64, true>(lds, q, 512, (const bf16*)(ws + WS_KA) + (size_t)b * SEQ * 512 + h * 64, 512, (const bf16*)(ws + WS_VA) + (size_t)b * SEQ * 512 + h * 64, 512,
                                 q, 512, (const bf16*)(ws + WS_ZA) + row0 * 512 + h * 64, 512, 4 * (qb + 1), (const u64*)(ws + WS_MASK) + row0 * 64, slope2);
        }
        {
            const int b2 = v >> 6, hm = (v >> 4) & 3, qb = v & 15; const size_t row0 = (size_t)b2 * SEQ + qb * 256;
            bf16* q = (bf16*)(ws + WS_QM) + row0 * 512 + hm * 128;
            const bf16* kv = (const bf16*)(ws + WS_MKV) + (size_t)b2 * MEML * 1024 + hm * 128;
            if (!SKIP_FM) flash_unit<128, false>(lds, q, 512, kv, 1024, kv + 512, 1024, q, 512, (const bf16*)(ws + WS_ZM) + row0 * 512 + hm * 128, 512, MEML / 64, nullptr, 0.f);
        }
    }
}
__device__ __forceinline__ void phase4(const Params& p, LAS unsigned char* lds, int G) {
    unsigned char* ws = p.ws; const int c = (int)blockIdx.x;
    pg8::Gemm g{(const bf16*)(ws + WS_XB), (const bf16*)(ws + WS_WIN) + (size_t)N1A * DM, T, N1B, DM, 0, 0};
    pg8::StaticOrder S; S.init(T, N1B, G, c);
    pg8::EpiGate E{(bf16*)p.out, (bf16*)(ws + WS_G2), (const float*)(ws + WS_RSTDX), p.b_gate};
    pg8::gemm_phase<pg8::EpiGate, pg8::StaticOrder, true, true>(lds, g, S, E);
}
__device__ __forceinline__ void phase5(const Params& p, LAS unsigned char* lds, int G) {
    unsigned char* ws = p.ws; const int c = (int)blockIdx.x;
    pg8::Gemm g{(const bf16*)(ws + WS_QA), (const bf16*)(ws + WS_WOA), T, 1024, 512, (WS_QM - WS_QA) / 2, (WS_WOM - WS_WOA) / 2};
    pg8::StaticOrder S; S.init(T, 1024, G, c, 3);
    pg8::EpiMerge E{(const bf16*)p.out, (const bf16*)(ws + WS_G2), (bf16*)(ws + WS_MERGED)};
    pg8::gemm_phase<pg8::EpiMerge, pg8::StaticOrder, false, true>(lds, g, S, E);
}
__device__ __forceinline__ void phase6(const Params& p, LAS unsigned char* lds, int G) {
    unsigned char* ws = p.ws; const int c = (int)blockIdx.x;
    pg8::Gemm g{(const bf16*)(ws + WS_MERGED), (const bf16*)(ws + WS_WO), T, 1024, DM, 0, 0};
    pg8::StaticOrder S; S.init(T, 1024, G, c);
    pg8::EpiResF32 E{p.x, p.out, 1024};
    pg8::gemm_phase<pg8::EpiResF32, pg8::StaticOrder, false, true>(lds, g, S, E);
}

template <int PH> __device__ __forceinline__ void run_phase(const Params& p, LAS unsigned char* lds, int G) {
    if (PH == 0) { const int bx = blockIdx.x; const int vcu = (G % 8 == 0) ? (bx % 8) * (G / 8) + bx / 8 : bx; phase0(p, lds, vcu, G); }
    if (PH == 1) phase1(p, lds, G);
    if (PH == 2) phase2(p, lds, G);
    if (PH == 3) phase3(p, lds, G);
    if (PH == 4) phase4(p, lds, G);
    if (PH == 5) phase5(p, lds, G);
    if (PH == 6) phase6(p, lds, G);
}

template <int PH> __global__ void __launch_bounds__(NTHR, 2) phase_kernel(Params p) {
    extern __shared__ __attribute__((aligned(16))) unsigned char lds_raw[];
    run_phase<PH>(p, (LAS unsigned char*)lds_raw, (int)gridDim.x);
}
#if FUSED
__global__ void __launch_bounds__(NTHR, 2) mega_kernel(Params p) {
    extern __shared__ __attribute__((aligned(16))) unsigned char lds_raw[];
    cg::grid_group grid = cg::this_grid();
    LAS unsigned char* lds = (LAS unsigned char*)lds_raw; const int G = (int)gridDim.x;
    run_phase<0>(p, lds, G); grid.sync();
    run_phase<1>(p, lds, G); grid.sync();
    run_phase<2>(p, lds, G); grid.sync();
    run_phase<3>(p, lds, G); grid.sync();
    run_phase<4>(p, lds, G); grid.sync();
    run_phase<5>(p, lds, G); grid.sync();
    run_phase<6>(p, lds, G);
}
#endif

template <int PH> static void launch_phase(const Params& p, int grid, hipStream_t stream) {
    static bool attr = false;
    if (!attr) { (void)hipFuncSetAttribute((const void*)phase_kernel<PH>, hipFuncAttributeMaxDynamicSharedMemorySize, LDS_BYTES); attr = true; }
    hipLaunchKernelGGL(phase_kernel<PH>, dim3(grid), dim3(NTHR), LDS_BYTES, stream, p);
}

extern "C" void kernel_launch(void* const* d_in, const int* in_sizes, int n_in, void* d_out, int out_size, void* d_ws, size_t ws_size, hipStream_t stream) {
    static int grid = 0;
    if (grid == 0) {
        int dev = 0, cus = 0;
        if (hipGetDevice(&dev) != hipSuccess || hipDeviceGetAttribute(&cus, hipDeviceAttributeMultiprocessorCount, dev) != hipSuccess) { fprintf(stderr, "kernel_launch: device query failed\n"); grid = -1; return; }
        if (n_in != 16 || out_size != T * DM || ws_size < 256 * MiB) { fprintf(stderr, "kernel_launch: unexpected shapes (n_in %d out %d ws %zu)\n", n_in, out_size, ws_size); grid = -1; return; }
#if FUSED
        int per_cu = 0;
        (void)hipFuncSetAttribute((const void*)mega_kernel, hipFuncAttributeMaxDynamicSharedMemorySize, LDS_BYTES);
        if (hipOccupancyMaxActiveBlocksPerMultiprocessor(&per_cu, (const void*)mega_kernel, NTHR, LDS_BYTES) != hipSuccess || per_cu < 1) { fprintf(stderr, "kernel_launch: occupancy query says %d\n", per_cu); grid = -1; return; }
        (void)hipGetLastError();
#endif
        grid = cus;
    }
    if (grid < 0) return;
    Params p{};
    p.x = (const float*)d_in[0]; p.mem = (const float*)d_in[1]; p.norm_g = (const float*)d_in[2]; p.mem_norm_g = (const float*)d_in[3]; p.w_in = (const float*)d_in[4]; p.b_gate = (const float*)d_in[5];
    p.w_mem_kv = (const float*)d_in[6]; p.q_norm_a = (const float*)d_in[7]; p.k_norm_a = (const float*)d_in[8]; p.q_norm_m = (const float*)d_in[9]; p.k_norm_m = (const float*)d_in[10]; p.conv_w = (const float*)d_in[11];
    p.w_out_a = (const float*)d_in[12]; p.w_out_b = (const float*)d_in[13]; p.w_out_m = (const float*)d_in[14]; p.w_o = (const float*)d_in[15];
    p.out = (float*)d_out; p.ws = (unsigned char*)d_ws;
#if FUSED
    void* args[] = {&p};
    hipError_t e = hipLaunchCooperativeKernel((const void*)mega_kernel, dim3(grid), dim3(NTHR), args, LDS_BYTES, stream);
    if (e != hipSuccess) fprintf(stderr, "cooperative launch failed: %s (grid %d)\n", hipGetErrorString(e), grid);
#else
    launch_phase<0>(p, grid, stream); launch_phase<1>(p, grid, stream); launch_phase<2>(p, grid, stream); launch_phase<3>(p, grid, stream);
    launch_phase<4>(p, grid, stream); launch_phase<5>(p, grid, stream); launch_phase<6>(p, grid, stream);
#endif
}
```

```cpp
#include <hip/hip_runtime.h>
#include <hip/hip_cooperative_groups.h>
#include <cstdio>
#include <cstdint>
namespace cg = cooperative_groups;

#ifndef FUSED
#define FUSED 1
#endif
#ifndef SKIP_TOPK
#define SKIP_TOPK 0
#endif
#ifndef SKIP_FA
#define SKIP_FA 0
#endif
#ifndef SKIP_FM
#define SKIP_FM 0
#endif

namespace pg8 {
#define PG8_LAS __attribute__((address_space(3)))
typedef unsigned short bf16_t;
typedef short bf16x8 __attribute__((ext_vector_type(8)));
typedef float f32x4 __attribute__((ext_vector_type(4)));
typedef unsigned u32x4 __attribute__((ext_vector_type(4)));
constexpr int BM = 256, BK = 64, HALF = 128, HTB = HALF * BK * 2  , STAGE_BYTES = 8 * HTB, NXCD = 8, WGM = 8;

__host__ __device__ __forceinline__ int lds_byte(int r, int c) { const int st = (r >> 4) * 2 + (c >> 5), rr = r & 15, cc = c & 31, ob = rr * 64 + cc * 2; return st * 1024 + (ob ^ (((ob >> 9) & 1) << 5)); }
__host__ __device__ __forceinline__ void stage_rc(int b, int& R, int& C) { const int st = b / 1024, sb = b % 1024, swz = sb ^ (((sb >> 9) & 1) << 5); R = (st >> 1) * 16 + swz / 64; C = (st & 1) * 32 + (swz % 64) / 2; }
__host__ __device__ __forceinline__ int perm32(int rho) { const int n = rho >> 4, i = rho & 15; return 8 * (i >> 2) + 4 * n + (i & 3); }

struct Unit { int pm, pn, br; };
struct Gemm { const bf16_t* A; const bf16_t* Bt; int M, N, K; long strideA, strideB;
    __device__ __forceinline__ const bf16_t* a(int br) const { return A + (long)br * strideA; }
    __device__ __forceinline__ const bf16_t* b(int br) const { return Bt + (long)br * strideB; } };

__host__ __device__ __forceinline__ void tile_of(int L, int nM, int nN, int& pm, int& pn) {
    const int nwg = nM * nN; int wgid = L; { const int q = nwg / NXCD, r = nwg % NXCD, xcd = wgid % NXCD, off = wgid / NXCD; wgid = (xcd < r ? xcd * (q + 1) : r * (q + 1) + (xcd - r) * q) + off; }
    const int nig = WGM * nN, gid = wgid / nig, fm = gid * WGM, gsz = (nM - fm) < WGM ? (nM - fm) : WGM;
    pm = fm + ((wgid % nig) % gsz); pn = (wgid % nig) / gsz;
}
struct StaticOrder {
    int nM, nN, nwg, G, c, nsub, nM2, nN2;
    __host__ __device__ void init(int M, int N, int G_, int c_, int nsub_ = 1, int M2 = 0, int N2 = 0) { nM = M / BM; nN = N / BM; nwg = nM * nN; G = G_; c = c_; nsub = nsub_; nM2 = M2 / BM; nN2 = N2 / BM; }
    __host__ __device__ bool next(int i, Unit& u) const {
        const int ti = i / nsub; const long L = (long)ti * G + c; if (L >= nwg + nM2 * nN2) return false;
        if (L < nwg) { tile_of((int)L, nM, nN, u.pm, u.pn); u.br = i - ti * nsub; }
        else { tile_of((int)L - nwg, nM2, nN2, u.pm, u.pn); u.br = 1; }
        return true;
    }
    __device__ __forceinline__ void a_ready(const Unit&) const {}
    __device__ __forceinline__ void done(const Unit&) const {}
};

typedef float f32x2_t __attribute__((ext_vector_type(2))); typedef __bf16 bf16x2_t __attribute__((ext_vector_type(2)));
__device__ __forceinline__ unsigned cvt_pk_bf16(float lo, float hi) { f32x2_t v = {lo, hi}; bf16x2_t b = __builtin_convertvector(v, bf16x2_t); return __builtin_bit_cast(unsigned, b); }
__device__ __forceinline__ float bf_lo(unsigned w) { return __uint_as_float(w << 16); }
__device__ __forceinline__ float bf_hi(unsigned w) { return __uint_as_float(w & 0xffff0000u); }


struct EpiProjA {
    static constexpr bool PERM = true, AFTER_DRAIN = false;
    unsigned char* ws; bf16_t* brb; const float* rstd;
    __device__ __forceinline__ bool keep(const Unit&) const { return false; }
    __device__ __forceinline__ void operator()(f32x4 (&acc)[2][2][4][2], const Unit& u, int wr, int wc, int fr, int fq) const {
        bf16_t* base; int ldc, colt; const int pn = u.pn; const float* rs = rstd;
        if (u.br == 1) { base = (bf16_t*)(ws + ((size_t)53 << 19)); ldc = 1024; colt = pn * 256; rs = rstd + 16384; }
        else if (pn < 10) { base = (bf16_t*)(ws + ((size_t)(80 + 16 * (pn >> 1)) << 20)); ldc = 512; colt = (pn & 1) * 256; }
        else if (pn == 10) { base = (bf16_t*)(ws + ((size_t)37 << 20)); ldc = 256; colt = 0; }
        else if (pn < 19) { base = brb; ldc = 2048; colt = (pn - 11) * 256; }
        else { base = (bf16_t*)(ws + ((size_t)(160 + 16 * ((pn - 19) >> 1)) << 20)); ldc = 512; colt = ((pn - 19) & 1) * 256; }
        const int row0 = u.pm * BM + wr * 64 + fr, col0 = colt + wc * 32 + 8 * fq;
#pragma unroll
        for (int ai = 0; ai < 2; ++ai)
#pragma unroll
            for (int m = 0; m < 4; ++m) { const int row = row0 + ai * HALF + m * 16; const float sc = rs[row]; bf16_t* rowp = base + (size_t)row * ldc + col0;
#pragma unroll
                for (int bj = 0; bj < 2; ++bj) { const f32x4 v0 = acc[ai][bj][m][0] * sc, v1 = acc[ai][bj][m][1] * sc;
                    u32x4 w; w.x = cvt_pk_bf16(v0[0], v0[1]); w.y = cvt_pk_bf16(v0[2], v0[3]); w.z = cvt_pk_bf16(v1[0], v1[1]); w.w = cvt_pk_bf16(v1[2], v1[3]);
                    *(u32x4*)(rowp + bj * HALF) = w; } }
    }
};
struct EpiScale {
    static constexpr bool PERM = true, AFTER_DRAIN = false;
    bf16_t* O; int ldc; const float* rstd;
    __device__ __forceinline__ bool keep(const Unit&) const { return false; }
    __device__ __forceinline__ void operator()(f32x4 (&acc)[2][2][4][2], const Unit& u, int wr, int wc, int fr, int fq) const {
        const int row0 = u.pm * BM + wr * 64 + fr, col0 = u.pn * BM + wc * 32 + 8 * fq;
#pragma unroll
        for (int ai = 0; ai < 2; ++ai)
#pragma unroll
            for (int m = 0; m < 4; ++m) { const int row = row0 + ai * HALF + m * 16; const float sc = rstd[row]; bf16_t* rowp = O + (size_t)row * ldc + col0;
#pragma unroll
                for (int bj = 0; bj < 2; ++bj) { const f32x4 v0 = acc[ai][bj][m][0] * sc, v1 = acc[ai][bj][m][1] * sc;
                    u32x4 w; w.x = cvt_pk_bf16(v0[0], v0[1]); w.y = cvt_pk_bf16(v0[2], v0[3]); w.z = cvt_pk_bf16(v1[0], v1[1]); w.w = cvt_pk_bf16(v1[2], v1[3]);
                    *(u32x4*)(rowp + bj * HALF) = w; } }
    }
};
__device__ __forceinline__ float sigmoidf_(float x) { return __builtin_amdgcn_rcpf(1.0f + __builtin_amdgcn_exp2f(-1.4426950408889634f * x)); }
struct EpiGate {
    static constexpr bool PERM = true, AFTER_DRAIN = false;
    bf16_t* g01; bf16_t* g2; const float* rstd; const float* bgate;
    __device__ __forceinline__ bool keep(const Unit&) const { return false; }
    __device__ __forceinline__ void operator()(f32x4 (&acc)[2][2][4][2], const Unit& u, int wr, int wc, int fr, int fq) const {
        bf16_t* base; int ldc, colt;
        if (u.pn < 8) { base = g01; ldc = 2048; colt = u.pn * 256; } else { base = g2; ldc = 1024; colt = (u.pn - 8) * 256; }
        const int row0 = u.pm * BM + wr * 64 + fr, col0 = colt + wc * 32 + 8 * fq, bcol0 = u.pn * BM + wc * 32 + 8 * fq;
        f32x4 bv[2][2];
#pragma unroll
        for (int bj = 0; bj < 2; ++bj)
#pragma unroll
            for (int n = 0; n < 2; ++n) bv[bj][n] = *(const f32x4*)(bgate + bcol0 + bj * HALF + 4 * n);
#pragma unroll
        for (int ai = 0; ai < 2; ++ai)
#pragma unroll
            for (int m = 0; m < 4; ++m) { const int row = row0 + ai * HALF + m * 16; const float sc = rstd[row]; bf16_t* rowp = base + (size_t)row * ldc + col0;
#pragma unroll
                for (int bj = 0; bj < 2; ++bj) { f32x4 v0 = acc[ai][bj][m][0] * sc + bv[bj][0], v1 = acc[ai][bj][m][1] * sc + bv[bj][1];
#pragma unroll
                    for (int e = 0; e < 4; ++e) { v0[e] = sigmoidf_(v0[e]); v1[e] = sigmoidf_(v1[e]); }
                    u32x4 w; w.x = cvt_pk_bf16(v0[0], v0[1]); w.y = cvt_pk_bf16(v0[2], v0[3]); w.z = cvt_pk_bf16(v1[0], v1[1]); w.w = cvt_pk_bf16(v1[2], v1[3]);
                    *(u32x4*)(rowp + bj * HALF) = w; } }
    }
};
struct EpiMerge {
    static constexpr bool PERM = true, AFTER_DRAIN = false;
    const bf16_t* g01; const bf16_t* g2; bf16_t* O;
    __device__ __forceinline__ bool keep(const Unit& u) const { return u.br != 2; }
    __device__ __forceinline__ void operator()(f32x4 (&acc)[2][2][4][2], const Unit& u, int wr, int wc, int fr, int fq) const {
        const int row0 = u.pm * BM + wr * 64 + fr, col0 = u.pn * BM + wc * 32 + 8 * fq; const int br = u.br;
        const bf16_t* nb = g01; int nld = 2048; const bf16_t* db = g2; int dld = 1024;
        if (br == 1) { nb = g2; nld = 1024; db = g01 + 1024; dld = 2048; }
        if (br == 2) { nb = g01 + 1024; db = nb; dld = 2048; }
#pragma unroll
        for (int ai = 0; ai < 2; ++ai)
#pragma unroll
            for (int m = 0; m < 4; ++m) { const int row = row0 + ai * HALF + m * 16;
#pragma unroll
                for (int bj = 0; bj < 2; ++bj) { const int col = col0 + bj * HALF;
                    const u32x4 num = *(const u32x4*)(nb + (size_t)row * nld + col);
                    const u32x4 den = *(const u32x4*)(db + (size_t)row * dld + col);
                    float f[8];
#pragma unroll
                    for (int e = 0; e < 4; ++e) { const unsigned nw = num[e], dw = den[e];
                        f[2 * e] = (br == 2) ? bf_lo(nw) : bf_lo(nw) * __builtin_amdgcn_rcpf(bf_lo(dw)); f[2 * e + 1] = (br == 2) ? bf_hi(nw) : bf_hi(nw) * __builtin_amdgcn_rcpf(bf_hi(dw)); }
                    f32x4 v0 = acc[ai][bj][m][0], v1 = acc[ai][bj][m][1];
                    v0[0] *= f[0]; v0[1] *= f[1]; v0[2] *= f[2]; v0[3] *= f[3]; v1[0] *= f[4]; v1[1] *= f[5]; v1[2] *= f[6]; v1[3] *= f[7];
                    acc[ai][bj][m][0] = v0; acc[ai][bj][m][1] = v1;
                    if (br == 2) { u32x4 w; w.x = cvt_pk_bf16(v0[0], v0[1]); w.y = cvt_pk_bf16(v0[2], v0[3]); w.z = cvt_pk_bf16(v1[0], v1[1]); w.w = cvt_pk_bf16(v1[2], v1[3]);
                        *(u32x4*)(O + (size_t)row * 1024 + col) = w; } }
                asm volatile("" ::: "memory"); }
    }
};
struct EpiResF32 {
    static constexpr bool PERM = false, AFTER_DRAIN = false;
    const float* base; float* out; int ldc;
    __device__ __forceinline__ bool keep(const Unit&) const { return false; }
    __device__ __forceinline__ void operator()(f32x4 (&acc)[2][2][4][2], const Unit& u, int wr, int wc, int fr, int fq) const {
        const int row0 = u.pm * BM + wr * 64 + fr, col0 = u.pn * BM + wc * 32 + 4 * fq;
#pragma unroll
        for (int ai = 0; ai < 2; ++ai)
#pragma unroll
            for (int m = 0; m < 4; ++m) { const size_t off = (size_t)(row0 + ai * HALF + m * 16) * ldc + col0;
#pragma unroll
                for (int bj = 0; bj < 2; ++bj)
#pragma unroll
                    for (int n = 0; n < 2; ++n) { const f32x4 bs = *(const f32x4*)(base + off + bj * HALF + n * 16); *(f32x4*)(out + off + bj * HALF + n * 16) = bs + acc[ai][bj][m][n]; } }
    }
};

template <class Epi, class Sched, bool ALIGN_EPI = false, bool SP2 = false>
__device__ __forceinline__ void gemm_phase(PG8_LAS unsigned char* lds, const Gemm g, const Sched& S, const Epi& E) {
    const int tid = threadIdx.x, wid = __builtin_amdgcn_readfirstlane(tid >> 6), lane = tid & 63, wr = wid >> 2, wc = wid & 3, fr = lane & 15, fq = lane >> 4;
    const int K = g.K, nt = K / BK;
    unsigned voffA[2], voffB[2];
#pragma unroll
    for (int i = 0; i < 2; ++i) { int R, C; stage_rc(tid * 16 + i * 8192, R, C); const int Rb = Epi::PERM ? ((R & ~31) + perm32(R & 31)) : R;
        voffA[i] = (unsigned)(R * K + C) * 2u; voffB[i] = (unsigned)(Rb * K + C) * 2u; }
    const size_t kstep = (size_t)(BK * 2);
    const size_t hstep = (size_t)HALF * K * 2;
    const size_t tstep = 2 * hstep;
    const unsigned ldsw = (unsigned)wid * 1024u;
    const int aoff = lds_byte(wr * 64 + fr, fq * 8), boff = lds_byte(wc * 32 + fr, fq * 8);
#define PG8_SA(b, h) (((b) * 2 + (h)) * HTB)
#define PG8_SB(b, h) ((4 + (b) * 2 + (h)) * HTB)
#define PG8_STAGE(bufoff, gbase, voff) do { _Pragma("unroll") for (int _i = 0; _i < 2; ++_i) \
        __builtin_amdgcn_global_load_lds((const unsigned*)((const char*)(gbase) + (voff)[_i]), (PG8_LAS unsigned*)(lds + (bufoff) + ldsw + _i * 8192), 16, 0, 0); } while (0)
#define PG8_LDA(dst, b, h) do { _Pragma("unroll") for (int m = 0; m < 4; ++m) _Pragma("unroll") for (int k = 0; k < 2; ++k) dst[m][k] = *(const PG8_LAS bf16x8*)(lds + PG8_SA(b, h) + aoff + m * 2048 + k * 1024); } while (0)
#define PG8_LDB(dst, b, h) do { _Pragma("unroll") for (int n = 0; n < 2; ++n) _Pragma("unroll") for (int k = 0; k < 2; ++k) dst[n][k] = *(const PG8_LAS bf16x8*)(lds + PG8_SB(b, h) + boff + n * 2048 + k * 1024); } while (0)
#define PG8_MMA(ai, bj, At, Bt) do { __builtin_amdgcn_s_setprio(1); _Pragma("unroll") for (int m = 0; m < 4; ++m) _Pragma("unroll") for (int n = 0; n < 2; ++n) _Pragma("unroll") for (int k = 0; k < 2; ++k) \
        acc[ai][bj][m][n] = __builtin_amdgcn_mfma_f32_16x16x32_bf16(Bt[n][k], At[m][k], acc[ai][bj][m][n], 0, 0, 0); __builtin_amdgcn_s_setprio(0); } while (0)
#define PG8_WAIT_V(n) asm volatile("s_waitcnt vmcnt(" #n ")" ::: "memory")
#define PG8_WAIT_L(n) asm volatile("s_waitcnt lgkmcnt(" #n ")" ::: "memory")
#define PG8_BAR __builtin_amdgcn_s_barrier()
#define PG8_SCHED __builtin_amdgcn_sched_barrier(0)
    Unit cur, nxt; int ui = 0;
    if (!S.next(0, cur)) return;
    f32x4 acc[2][2][4][2];
#pragma unroll
    for (int a = 0; a < 2; ++a)
#pragma unroll
        for (int b = 0; b < 2; ++b)
#pragma unroll
            for (int m = 0; m < 4; ++m)
#pragma unroll
                for (int n = 0; n < 2; ++n) acc[a][b][m][n] = (f32x4){0.f, 0.f, 0.f, 0.f};
    bf16x8 At[4][2], B0[2][2], B1[2][2];
    const char* cA = (const char*)g.a(cur.br) + (size_t)cur.pm * tstep; const char* cB = (const char*)g.b(cur.br) + (size_t)cur.pn * tstep;
    S.a_ready(cur);
    if constexpr (SP2) {
        PG8_STAGE(PG8_SB(0, 0), cB, voffB); PG8_STAGE(PG8_SB(0, 1), cB + hstep, voffB); PG8_STAGE(PG8_SA(0, 0), cA, voffA); PG8_STAGE(PG8_SA(0, 1), cA + hstep, voffA);
        if (wr == 1) PG8_BAR;
        PG8_WAIT_V(2); PG8_BAR;
        PG8_STAGE(PG8_SB(1, 0), cB + kstep, voffB); PG8_STAGE(PG8_SA(1, 0), cA + kstep, voffA); PG8_STAGE(PG8_SB(1, 1), cB + hstep + kstep, voffB);
        PG8_WAIT_V(6); PG8_BAR;
    } else {
        PG8_STAGE(PG8_SB(0, 0), cB, voffB); PG8_STAGE(PG8_SA(0, 0), cA, voffA); PG8_STAGE(PG8_SB(0, 1), cB + hstep, voffB); PG8_STAGE(PG8_SA(0, 1), cA + hstep, voffA);
        if (wr == 1) PG8_BAR;
        PG8_WAIT_V(4); PG8_BAR;
        PG8_STAGE(PG8_SB(1, 0), cB + kstep, voffB); PG8_STAGE(PG8_SA(1, 0), cA + kstep, voffA); PG8_STAGE(PG8_SB(1, 1), cB + hstep + kstep, voffB);
        PG8_WAIT_V(6); PG8_BAR;
    }
    for (;;) {
        const bool has_next = S.next(ui + 1, nxt);
        const char* nA = has_next ? (const char*)g.a(nxt.br) + (size_t)nxt.pm * tstep : cA; const char* nB = has_next ? (const char*)g.b(nxt.br) + (size_t)nxt.pn * tstep : cB;
        for (int t = 0; t < nt; t += 2) {
            const bool last = (t == nt - 2);
            const char* a1 = cA + (size_t)(t + 1) * kstep;
            const char* a2 = last ? nA : cA + (size_t)(t + 2) * kstep; const char* b2 = last ? nB : cB + (size_t)(t + 2) * kstep;
            const char* a3 = a2 + kstep; const char* b3 = b2 + kstep;
            if (last && has_next) S.a_ready(nxt);
            if constexpr (SP2) {
            PG8_LDB(B0, 0, 0); PG8_LDB(B1, 0, 1); PG8_SCHED; PG8_LDA(At, 0, 0); PG8_STAGE(PG8_SA(1, 1), a1 + hstep, voffA);
            PG8_WAIT_V(8); PG8_WAIT_L(0); PG8_BAR; PG8_MMA(0, 0, At, B0); PG8_MMA(0, 1, At, B1); PG8_BAR; PG8_SCHED;
            PG8_LDA(At, 0, 1); PG8_STAGE(PG8_SB(0, 0), b2, voffB); PG8_STAGE(PG8_SB(0, 1), b2 + hstep, voffB); PG8_STAGE(PG8_SA(0, 0), a2, voffA);
            PG8_WAIT_V(8); PG8_WAIT_L(0); PG8_BAR; PG8_MMA(1, 0, At, B0); PG8_MMA(1, 1, At, B1); PG8_BAR; PG8_SCHED;
            PG8_LDB(B0, 1, 0); PG8_LDB(B1, 1, 1); PG8_SCHED; PG8_LDA(At, 1, 0); PG8_STAGE(PG8_SA(0, 1), a2 + hstep, voffA);
            PG8_WAIT_V(8); PG8_WAIT_L(0); PG8_BAR; PG8_MMA(0, 0, At, B0); PG8_MMA(0, 1, At, B1); PG8_BAR; PG8_SCHED;
            PG8_LDA(At, 1, 1); PG8_STAGE(PG8_SB(1, 0), b3, voffB); PG8_STAGE(PG8_SB(1, 1), b3 + hstep, voffB); PG8_STAGE(PG8_SA(1, 0), a3, voffA);
            PG8_WAIT_V(8); PG8_WAIT_L(0); PG8_BAR; PG8_MMA(1, 0, At, B0); PG8_MMA(1, 1, At, B1); PG8_BAR; PG8_SCHED;
            } else {
            PG8_LDB(B0, 0, 0); PG8_SCHED; PG8_LDA(At, 0, 0); PG8_STAGE(PG8_SA(1, 1), a1 + hstep, voffA);
            PG8_WAIT_L(8); PG8_BAR; PG8_WAIT_L(0); PG8_MMA(0, 0, At, B0); PG8_BAR; PG8_SCHED;
            PG8_LDB(B1, 0, 1); PG8_STAGE(PG8_SB(0, 0), b2, voffB);
            PG8_BAR; PG8_WAIT_L(0); PG8_MMA(0, 1, At, B1); PG8_BAR;
            PG8_LDA(At, 0, 1); PG8_STAGE(PG8_SA(0, 0), a2, voffA);
            PG8_BAR; PG8_WAIT_L(0); PG8_MMA(1, 0, At, B0); PG8_BAR; PG8_SCHED;
            PG8_STAGE(PG8_SB(0, 1), b2 + hstep, voffB);
            PG8_WAIT_V(6); PG8_BAR; PG8_MMA(1, 1, At, B1); PG8_BAR;
            PG8_LDB(B0, 1, 0); PG8_SCHED; PG8_LDA(At, 1, 0); PG8_STAGE(PG8_SA(0, 1), a2 + hstep, voffA);
            PG8_WAIT_L(8); PG8_BAR; PG8_WAIT_L(0); PG8_MMA(0, 0, At, B0); PG8_BAR; PG8_SCHED;
            PG8_LDB(B1, 1, 1); PG8_STAGE(PG8_SB(1, 0), b3, voffB);
            PG8_BAR; PG8_WAIT_L(0); PG8_MMA(0, 1, At, B1); PG8_BAR;
            PG8_LDA(At, 1, 1); PG8_STAGE(PG8_SA(1, 0), a3, voffA);
            PG8_BAR; PG8_WAIT_L(0); PG8_MMA(1, 0, At, B0); PG8_BAR; PG8_SCHED;
            PG8_STAGE(PG8_SB(1, 1), b3 + hstep, voffB);
            PG8_WAIT_V(6); PG8_BAR; PG8_MMA(1, 1, At, B1); PG8_BAR;
            }
        }
        if constexpr (ALIGN_EPI) { if (wr == 0) PG8_BAR; }
        if constexpr (!Epi::AFTER_DRAIN) { E(acc, cur, wr, wc, fr, fq); S.done(cur); }
        if (!has_next) break;
        if (!E.keep(cur)) {
#pragma unroll
        for (int a = 0; a < 2; ++a)
#pragma unroll
            for (int b = 0; b < 2; ++b)
#pragma unroll
                for (int m = 0; m < 4; ++m)
#pragma unroll
                    for (int n = 0; n < 2; ++n) acc[a][b][m][n] = (f32x4){0.f, 0.f, 0.f, 0.f};
        }
        cur = nxt; cA = nA; cB = nB; ++ui;
        if constexpr (ALIGN_EPI) { if (wr == 1) PG8_BAR; }
    }
    PG8_WAIT_V(0);
    if constexpr (!ALIGN_EPI) { if (wr == 0) PG8_BAR; }
    PG8_BAR;
    if constexpr (Epi::AFTER_DRAIN) { E.fused(acc, cur, wr, wc, fr, fq, lds, wid, lane); S.done(cur); }
#undef PG8_SA
#undef PG8_SB
#undef PG8_STAGE
#undef PG8_LDA
#undef PG8_LDB
#undef PG8_MMA
#undef PG8_WAIT_V
#undef PG8_WAIT_L
#undef PG8_BAR
#undef PG8_SCHED
}
}

#define LAS __attribute__((address_space(3)))
typedef unsigned short bf16;
typedef short bf16x8 __attribute__((ext_vector_type(8)));
typedef short s16x4 __attribute__((ext_vector_type(4)));
typedef float f32x4 __attribute__((ext_vector_type(4)));
typedef float f32x16 __attribute__((ext_vector_type(16)));
typedef unsigned u32x4 __attribute__((ext_vector_type(4)));
typedef unsigned u32x2 __attribute__((ext_vector_type(2)));
typedef unsigned long long u64;

constexpr int NB = 4, SEQ = 4096, DM = 1024, T = NB * SEQ, MEML = 256, MT = NB * MEML;
constexpr int NIN_SRC = 8776, N1A = 5888, N1B = 3072, NIN = N1A + N1B;
constexpr int GAP0 = 2632, GAPLEN = 184;
constexpr float RMS_EPS = 1e-6f, LOG2E = 1.4426950408889634f;
constexpr int NWAVES = 8, NTHR = 512;
constexpr int LDS_BYTES = 147456;

constexpr size_t MiB = (size_t)1 << 20;
constexpr size_t WS_WIN = 0, WS_WMKV = 35 * MiB / 2, WS_WOA = 39 * MiB / 2, WS_WOM = 41 * MiB / 2, WS_WOB = 43 * MiB / 2, WS_WO = 45 * MiB / 2, WS_MEMB = 49 * MiB / 2, WS_MKV = 53 * MiB / 2;
constexpr size_t WS_RSTDX = 57 * MiB / 2, WS_RSTDM = WS_RSTDX + 65536;
constexpr size_t WS_MASK = 29 * MiB, WS_KIWI = 37 * MiB, WS_XB = 48 * MiB;
constexpr size_t WS_QA = 80 * MiB, WS_KA = 96 * MiB, WS_VA = 112 * MiB, WS_ZA = 128 * MiB, WS_QI = 144 * MiB, WS_QM = 160 * MiB, WS_ZM = 176 * MiB, WS_XBR = 240 * MiB;
static_assert(WS_XBR - WS_QM == WS_QM - WS_QA && WS_WOB - WS_WOM == WS_WOM - WS_WOA, "uniform strides of the three out-projection operands");
constexpr size_t WS_G2 = WS_KA  , WS_MERGED = WS_ZA  ;
static_assert((size_t)NIN * DM * 2 == 35 * MiB / 2, "w_in copy size");

struct Params {
    const float *x, *mem, *norm_g, *mem_norm_g, *w_in, *b_gate, *w_mem_kv, *q_norm_a, *k_norm_a, *q_norm_m, *k_norm_m, *conv_w, *w_out_a, *w_out_b, *w_out_m, *w_o;
    float* out; unsigned char* ws;
};

__device__ __forceinline__ unsigned f2bf(float f) { unsigned u = __builtin_bit_cast(unsigned, f); return (u + 0x7fffu + ((u >> 16) & 1u)) >> 16; }
__device__ __forceinline__ unsigned pk2(float lo, float hi) { return f2bf(lo) | (f2bf(hi) << 16); }
__device__ __forceinline__ float bflo(unsigned w) { return __uint_as_float(w << 16); }
__device__ __forceinline__ float bfhi(unsigned w) { return __uint_as_float(w & 0xffff0000u); }
__device__ __forceinline__ float bf2f(bf16 h) { return __uint_as_float((unsigned)h << 16); }
__device__ __forceinline__ float wave_sum(float v) {
#pragma unroll
    for (int o = 1; o < 64; o <<= 1) v += __shfl_xor(v, o);
    return v;
}
__device__ __forceinline__ float siluf_(float z) { return z * __builtin_amdgcn_rcpf(1.0f + __builtin_amdgcn_exp2f(-LOG2E * z)); }

__device__ __forceinline__ void p0_transpose_item(const float* W, int K, int Nsrc, int Ndst, const float* gain, int gap0, int gaplen, bf16* WT, LAS float* scr, int item, int lane) {
    const int nblk = Ndst / 32, kb = item / nblk, nb = item % nblk, k0 = 64 * kb, n0 = 32 * nb;
    const int nd = n0 + (lane & 31); const bool valid = (nd < gap0) || (nd >= gap0 + gaplen); const int ns = nd < gap0 ? nd : nd - gaplen;
#pragma unroll 8
    for (int i = 0; i < 32; ++i) { const int kk = 2 * i + (lane >> 5); float v = 0.f; if (valid) { v = W[(size_t)(k0 + kk) * Nsrc + ns]; if (gain) v *= gain[k0 + kk]; } scr[kk * 33 + (lane & 31)] = v; }
    asm volatile("s_waitcnt lgkmcnt(0)" ::: "memory");
    const int c = lane & 7;
#pragma unroll
    for (int j = 0; j < 4; ++j) { const int n = (lane >> 3) + 8 * j; const LAS float* s = scr + (8 * c) * 33 + n;
        u32x4 o; o.x = pk2(s[0 * 33], s[1 * 33]); o.y = pk2(s[2 * 33], s[3 * 33]); o.z = pk2(s[4 * 33], s[5 * 33]); o.w = pk2(s[6 * 33], s[7 * 33]);
        *(u32x4*)(WT + (size_t)(n0 + n) * K + k0 + 8 * c) = o; }
    asm volatile("s_waitcnt lgkmcnt(0)" ::: "memory");
}
__device__ __forceinline__ void row_to_bf16(const float* xrow, bf16* orow, float* rstd_out, int lane) {
    const f32x4* xr = (const f32x4*)xrow + lane; f32x4 v[4]; float s = 0.f;
#pragma unroll
    for (int j = 0; j < 4; ++j) { v[j] = xr[64 * j]; s += (v[j].x * v[j].x + v[j].y * v[j].y) + (v[j].z * v[j].z + v[j].w * v[j].w); }
    s = wave_sum(s);
    if (lane == 0) *rstd_out = 1.0f / sqrtf(s * (1.0f / DM) + RMS_EPS);
    u32x2* o8 = (u32x2*)orow + lane;
#pragma unroll
    for (int j = 0; j < 4; ++j) { u32x2 w; w.x = pk2(v[j].x, v[j].y); w.y = pk2(v[j].z, v[j].w); o8[64 * j] = w; }
}
__device__ __forceinline__ void phase0(const Params& p, LAS unsigned char* lds, int vcu, int G) {
    const int tid = threadIdx.x, lane = tid & 63, wave = tid >> 6;
    LAS float* scr = (LAS float*)(lds + wave * 16384);
    const int gw = vcu * NWAVES + wave, NGW = G * NWAVES;
    unsigned char* ws = p.ws;
    constexpr int I_IN = (DM / 64) * (NIN / 32), I_MKV = (DM / 64) * (1024 / 32), I_OX = (512 / 64) * (1024 / 32), I_O = (DM / 64) * (1024 / 32);
    constexpr int NITEMS = I_IN + I_MKV + 3 * I_OX + I_O;
    for (int it = gw; it < NITEMS; it += NGW) {
        int r = it;
        if (r < I_IN) { p0_transpose_item(p.w_in, DM, NIN_SRC, NIN, p.norm_g, GAP0, GAPLEN, (bf16*)(ws + WS_WIN), scr, r, lane); continue; } r -= I_IN;
        if (r < I_MKV) { p0_transpose_item(p.w_mem_kv, DM, 1024, 1024, p.mem_norm_g, 1 << 30, 0, (bf16*)(ws + WS_WMKV), scr, r, lane); continue; } r -= I_MKV;
        if (r < I_OX) { p0_transpose_item(p.w_out_a, 512, 1024, 1024, nullptr, 1 << 30, 0, (bf16*)(ws + WS_WOA), scr, r, lane); continue; } r -= I_OX;
        if (r < I_OX) { p0_transpose_item(p.w_out_b, 512, 1024, 1024, nullptr, 1 << 30, 0, (bf16*)(ws + WS_WOB), scr, r, lane); continue; } r -= I_OX;
        if (r < I_OX) { p0_transpose_item(p.w_out_m, 512, 1024, 1024, nullptr, 1 << 30, 0, (bf16*)(ws + WS_WOM), scr, r, lane); continue; } r -= I_OX;
        p0_transpose_item(p.w_o, DM, 1024, 1024, nullptr, 1 << 30, 0, (bf16*)(ws + WS_WO), scr, r, lane);
    }
    for (int m = gw; m < T + MT; m += NGW) {
        if (m < T) row_to_bf16(p.x + (size_t)m * DM, (bf16*)(ws + WS_XB) + (size_t)m * DM, (float*)(ws + WS_RSTDX) + m, lane);
        else { const int mm = m - T; row_to_bf16(p.mem + (size_t)mm * DM, (bf16*)(ws + WS_MEMB) + (size_t)mm * DM, (float*)(ws + WS_RSTDM) + mm, lane); }
    }
}

template <int HD>
__device__ __forceinline__ void headnorm(bf16* X, int ld, int R, int NH, const float* gain, float oscale, int gtid, int gthreads) {
    constexpr int TPH = HD / 8;
    const long total = (long)R * NH * TPH;
    for (long i = gtid; i < total; i += gthreads) {
        const int part = (int)(i % TPH); const long rh = i / TPH; const int head = (int)(rh % NH); const long row = rh / NH;
        bf16* ptr = X + row * ld + head * HD + part * 8;
        const u32x4 w = *(const u32x4*)ptr; float f[8];
#pragma unroll
        for (int e = 0; e < 4; ++e) { f[2 * e] = bflo(w[e]); f[2 * e + 1] = bfhi(w[e]); }
        float s = 0.f;
#pragma unroll
        for (int e = 0; e < 8; ++e) s += f[e] * f[e];
#pragma unroll
        for (int o = 1; o < TPH; o <<= 1) s += __shfl_xor(s, o);
        const float r = oscale / sqrtf(s * (1.0f / HD) + RMS_EPS);
        const f32x4 g0 = *(const f32x4*)(gain + part * 8), g1 = *(const f32x4*)(gain + part * 8 + 4);
        u32x4 o; o.x = pk2(f[0] * r * g0.x, f[1] * r * g0.y); o.y = pk2(f[2] * r * g0.z, f[3] * r * g0.w); o.z = pk2(f[4] * r * g1.x, f[5] * r * g1.y); o.w = pk2(f[6] * r * g1.z, f[7] * r * g1.w);
        *(u32x4*)ptr = o;
    }
}
__device__ __forceinline__ void conv_branch(const bf16* BR, const float* cw, bf16* XO, int gtid, int gthreads) {
    const long total = (long)T * 64;
    for (long i = gtid; i < total; i += gthreads) {
        const int c8 = (int)(i & 63) * 8; const long row = i >> 6; const int tl = (int)(row & (SEQ - 1));
        const bf16* rp = BR + row * 2048 + c8;
        float y[8];
#pragma unroll
        for (int e = 0; e < 8; ++e) y[e] = 0.f;
#pragma unroll
        for (int k = 0; k < 3; ++k) {
            const int back = 2 - k;
            if (tl - back >= 0) {
                const u32x4 cgw = *(const u32x4*)(rp - (long)back * 2048 + 512), hbw = *(const u32x4*)(rp - (long)back * 2048 + 1024);
                const f32x4 w0 = *(const f32x4*)(cw + k * 512 + c8), w1 = *(const f32x4*)(cw + k * 512 + c8 + 4);
                const float wk[8] = {w0.x, w0.y, w0.z, w0.w, w1.x, w1.y, w1.z, w1.w};
#pragma unroll
                for (int e = 0; e < 4; ++e) { y[2 * e] += wk[2 * e] * (bflo(cgw[e]) * bflo(hbw[e])); y[2 * e + 1] += wk[2 * e + 1] * (bfhi(cgw[e]) * bfhi(hbw[e])); }
            }
        }
        const u32x4 bgw = *(const u32x4*)(rp), zbw = *(const u32x4*)(rp + 1536);
        u32x4 o;
#pragma unroll
        for (int e = 0; e < 4; ++e) { const float a = bflo(bgw[e]) * y[2 * e] * siluf_(bflo(zbw[e])), b = bfhi(bgw[e]) * y[2 * e + 1] * siluf_(bfhi(zbw[e])); o[e] = pk2(a, b); }
        *(u32x4*)(XO + row * 512 + c8) = o;
    }
}

__device__ __forceinline__ int count_ge(const unsigned (&v)[64], unsigned cand, int nj) {
    int cnt = 0;
#pragma unroll
    for (int c4 = 0; c4 < 4; ++c4) {
        if (16 * c4 < nj) {
#pragma unroll
            for (int jj = 0; jj < 16; ++jj) cnt += (v[16 * c4 + jj] >= cand) ? 1 : 0;
        }
    }
#pragma unroll
    for (int o = 1; o < 64; o <<= 1) cnt += __shfl_xor(cnt, o);
    return __builtin_amdgcn_readfirstlane(cnt);
}
__device__ __forceinline__ void topk_unit(LAS unsigned char* lds, const bf16* QI, const bf16* KIWI, u64* MASK, int b, int tb) {
    const int tid = threadIdx.x, lane = tid & 63, wid = __builtin_amdgcn_readfirstlane(tid >> 6), r32 = lane & 31, hi = lane >> 5;
    const int t0 = tb * 8; const size_t rowb = (size_t)b * SEQ;
    LAS unsigned* SC = (LAS unsigned*)lds;
    const int ntile = ((t0 + 8 + 63) >> 6) << 1;
    const float idx_scale = 0.125f * 0.35355339059327373f;
    bf16x8 af[2][4]; float wv[2][16];
    {
        const int rho = r32, qq = 2 * ((rho >> 2) & 1) + (rho >> 4), head = (rho & 3) + 4 * ((rho >> 3) & 1);
#pragma unroll
        for (int m = 0; m < 2; ++m) { const bf16* pq = QI + (rowb + t0 + 4 * m + qq) * 512 + head * 64 + 8 * hi;
#pragma unroll
            for (int ks = 0; ks < 4; ++ks) af[m][ks] = *(const bf16x8*)(pq + 16 * ks); }
#pragma unroll
        for (int m = 0; m < 2; ++m)
#pragma unroll
            for (int r = 0; r < 16; ++r) wv[m][r] = bf2f(KIWI[(rowb + t0 + 4 * m + 2 * hi + (r >> 3)) * 256 + 64 + (r & 7)]) * idx_scale;
    }
    for (int j = wid; j < ntile; j += NWAVES) {
        const int key = 32 * j + r32;
        const bf16* kp = KIWI + (rowb + key) * 256 + 8 * hi;
        bf16x8 bfr[4];
#pragma unroll
        for (int ks = 0; ks < 4; ++ks) bfr[ks] = *(const bf16x8*)(kp + 16 * ks);
        f32x16 c[2];
#pragma unroll
        for (int m = 0; m < 2; ++m) {
#pragma unroll
            for (int r = 0; r < 16; ++r) c[m][r] = 0.f;
#pragma unroll
            for (int ks = 0; ks < 4; ++ks) c[m] = __builtin_amdgcn_mfma_f32_32x32x16_bf16(af[m][ks], bfr[ks], c[m], 0, 0, 0);
        }
#pragma unroll
        for (int m = 0; m < 2; ++m)
#pragma unroll
            for (int ql = 0; ql < 2; ++ql) {
                float sc = 0.f;
#pragma unroll
                for (int h = 0; h < 8; ++h) sc += wv[m][8 * ql + h] * fmaxf(c[m][8 * ql + h], 0.f);
                const int q = 4 * m + 2 * hi + ql;
                const unsigned u = __float_as_uint(sc); unsigned k = (u & 0x80000000u) ? ~u : (u | 0x80000000u);
                if (key > t0 + q) k = 0u;
                SC[q * 4096 + key] = k;
            }
    }
    __syncthreads();
    {
        const int q = wid, t = t0 + q, n = t + 1, nj = (n + 63) >> 6;
        unsigned wlo = 0u, whi = 0u;
        if (n <= 256) {
            const int lo = 64 * lane; u64 w;
            if (lo + 63 <= t) w = ~0ull; else if (lo > t) w = 0ull; else w = (1ull << (t - lo + 1)) - 1ull;
            wlo = (unsigned)w; whi = (unsigned)(w >> 32);
        } else {
            unsigned v[64];
#pragma unroll
            for (int j = 0; j < 64; ++j) v[j] = 0u;
#pragma unroll
            for (int c4 = 0; c4 < 4; ++c4) {
                if (16 * c4 < nj) {
#pragma unroll
                    for (int jj = 0; jj < 16; ++jj) { const int j = 16 * c4 + jj; if (j < nj) v[j] = SC[q * 4096 + 64 * j + lane]; }
                }
            }
            unsigned tau = 0u; int cge = 0;
            for (int bit = 31; bit >= 0; --bit) {
                const unsigned cand = tau | (1u << bit);
                const int cnt = count_ge(v, cand, nj);
                if (cnt >= 256) { tau = cand; cge = cnt; if (cnt == 256) break; }
            }
            if (cge == 256) {
#pragma unroll
                for (int j = 0; j < 64; ++j) { const u64 bal = __ballot(v[j] >= tau); if (lane == j) { wlo = (unsigned)bal; whi = (unsigned)(bal >> 32); } }
            } else {
                const int cgt = count_ge(v, tau + 1u, nj); int need = 256 - cgt;
#pragma unroll
                for (int j = 0; j < 64; ++j) {
                    const u64 gtb = __ballot(v[j] > tau); u64 eqb = __ballot(v[j] == tau); u64 takeb = 0ull;
                    const int pc = __popcll(eqb);
                    if (pc <= need) { takeb = eqb; need -= pc; }
                    else { while (need > 0) { const u64 low = eqb & (0ull - eqb); takeb |= low; eqb ^= low; --need; } }
                    const u64 bal = gtb | takeb;
                    if (lane == j) { wlo = (unsigned)bal; whi = (unsigned)(bal >> 32); }
                }
            }
        }
        u32x2 w2; w2.x = wlo; w2.y = whi;
        *(u32x2*)(MASK + (rowb + t) * 64 + lane) = w2;
    }
    __syncthreads();
}

__device__ __forceinline__ s16x4 vtr(const LAS unsigned char* p) { typedef short v4i16_t __attribute__((ext_vector_type(4))); return __builtin_bit_cast(s16x4, __builtin_amdgcn_ds_read_tr16_b64_v4i16((LAS v4i16_t*)p)); }
__device__ __forceinline__ int crow(int r, int hi) { return (r & 3) + 8 * (r >> 2) + 4 * hi; }
template <int D, bool MASKED>
__device__ __forceinline__ void flash_unit(LAS unsigned char* lds, const bf16* Q, int ldq, const bf16* K, int ldk, const bf16* V, int ldv, bf16* O, int ldo, const bf16* Z, int ldz,
                                           int nt, const u64* mask, float slope2) {
    constexpr int KS = D / 16, DB = D / 32, KR = D / 64;
    constexpr int KBYTES = D * 128, BUFB = 2 * KBYTES;
    const int tid = threadIdx.x, lane = tid & 63, wid = __builtin_amdgcn_readfirstlane(tid >> 6), r32 = lane & 31, hi = lane >> 5;
    const float NEG = -1.0e30f;
    bf16x8 qf[KS];
    { const bf16* qp = Q + (size_t)(wid * 32 + r32) * ldq + 8 * hi;
#pragma unroll
      for (int ks = 0; ks < KS; ++ks) qf[ks] = *(const bf16x8*)(qp + 16 * ks); }
    f32x16 o[DB];
#pragma unroll
    for (int d = 0; d < DB; ++d)
#pragma unroll
        for (int r = 0; r < 16; ++r) o[d][r] = 0.f;
    float m_run = NEG, l_run = 0.f;
    u32x4 kreg[KR], vreg[KR];
    const bf16* ksrc = K + (size_t)lane * ldk + wid * 8;
    const bf16* vsrc = V + (size_t)(16 * (wid & 3) + (lane >> 2)) * ldv + (wid >> 2) * 32 + (lane & 3) * 8;
    const int kdst = wid * 1024 + lane * 16, vdst = KBYTES + (wid >> 2) * 4096 + (16 * (wid & 3) + (lane >> 2)) * 64 + (lane & 3) * 16;
#pragma unroll
    for (int i = 0; i < KR; ++i) { kreg[i] = *(const u32x4*)(ksrc + i * 64); vreg[i] = *(const u32x4*)(vsrc + i * 64); }
    u64 mw = 0ull;
    const u64* mrow = mask + (size_t)(wid * 32 + r32) * 64;
    if (MASKED) mw = mrow[0];
    const int kfb = hi * 1024 + r32 * 16;
    const int vfb = KBYTES + (4 * hi + ((lane & 15) >> 2)) * 64 + ((lane >> 4) & 1) * 32 + (lane & 3) * 8;
    for (int t = 0; t < nt; ++t) {
        LAS unsigned char* buf = lds + (t & 1) * BUFB;
#pragma unroll
        for (int i = 0; i < KR; ++i) { *(LAS u32x4*)(buf + kdst + i * 8192) = kreg[i]; *(LAS u32x4*)(buf + vdst + i * 8192) = vreg[i]; }
        __syncthreads();
        const u64 mcur = mw;
        if (t + 1 < nt) {
#pragma unroll
            for (int i = 0; i < KR; ++i) { kreg[i] = *(const u32x4*)(ksrc + (size_t)(t + 1) * 64 * ldk + i * 64); vreg[i] = *(const u32x4*)(vsrc + (size_t)(t + 1) * 64 * ldv + i * 64); }
            if (MASKED) mw = mrow[t + 1];
        }
        f32x16 c0, c1;
#pragma unroll
        for (int r = 0; r < 16; ++r) { c0[r] = 0.f; c1[r] = 0.f; }
#pragma unroll
        for (int ks = 0; ks < KS; ++ks) {
            const bf16x8 a0 = *(const LAS bf16x8*)(buf + kfb + ks * 2048), a1 = *(const LAS bf16x8*)(buf + kfb + ks * 2048 + 512);
            c0 = __builtin_amdgcn_mfma_f32_32x32x16_bf16(a0, qf[ks], c0, 0, 0, 0);
            c1 = __builtin_amdgcn_mfma_f32_32x32x16_bf16(a1, qf[ks], c1, 0, 0, 0);
        }
        if (MASKED) {
            const unsigned mlo = (unsigned)mcur >> (4 * hi), mhi = (unsigned)(mcur >> 32) >> (4 * hi);
            const float kvb = (float)(t * 64 + 4 * hi);
#pragma unroll
            for (int r = 0; r < 16; ++r) { const int bpos = (r & 3) + 8 * (r >> 2);
                c0[r] = ((mlo >> bpos) & 1u) ? c0[r] + slope2 * (kvb + (float)bpos) : NEG;
                c1[r] = ((mhi >> bpos) & 1u) ? c1[r] + slope2 * (kvb + (float)(bpos + 32)) : NEG; }
        }
        float mx = fmaxf(c0[0], c1[0]);
#pragma unroll
        for (int r = 1; r < 16; ++r) mx = fmaxf(mx, fmaxf(c0[r], c1[r]));
        mx = fmaxf(mx, __shfl_xor(mx, 32));
        const float m_new = fmaxf(m_run, mx), alpha = __builtin_amdgcn_exp2f(m_run - m_new);
        m_run = m_new;
        float ps = 0.f;
#pragma unroll
        for (int r = 0; r < 16; ++r) { c0[r] = __builtin_amdgcn_exp2f(c0[r] - m_new); c1[r] = __builtin_amdgcn_exp2f(c1[r] - m_new); ps += c0[r] + c1[r]; }
        l_run = l_run * alpha + ps;
#pragma unroll
        for (int d = 0; d < DB; ++d)
#pragma unroll
            for (int r = 0; r < 16; ++r) o[d][r] *= alpha;
        bf16x8 pf[4];
#pragma unroll
        for (int s = 0; s < 4; ++s) { u32x4 w;
#pragma unroll
            for (int e = 0; e < 4; ++e) { const int r = (s & 1) * 8 + 2 * e; w[e] = (s < 2) ? pg8::cvt_pk_bf16(c0[r], c0[r + 1]) : pg8::cvt_pk_bf16(c1[r], c1[r + 1]); }
            pf[s] = __builtin_bit_cast(bf16x8, w); }
#pragma unroll
        for (int d = 0; d < DB; ++d)
#pragma unroll
            for (int s = 0; s < 4; ++s) {
                const s16x4 lo4 = vtr(buf + vfb + d * 4096 + (16 * s) * 64), hi4 = vtr(buf + vfb + d * 4096 + (16 * s + 8) * 64);
                const bf16x8 vf = (bf16x8){lo4[0], lo4[1], lo4[2], lo4[3], hi4[0], hi4[1], hi4[2], hi4[3]};
                o[d] = __builtin_amdgcn_mfma_f32_32x32x16_bf16(vf, pf[s], o[d], 0, 0, 0);
            }
    }
    const float l_tot = l_run + __shfl_xor(l_run, 32), inv = 1.0f / l_tot;
    bf16* orow = O + (size_t)(wid * 32 + r32) * ldo; const bf16* zrow = Z + (size_t)(wid * 32 + r32) * ldz;
#pragma unroll
    for (int d = 0; d < DB; ++d)
#pragma unroll
        for (int rg = 0; rg < 4; ++rg) { const int d0 = d * 32 + 8 * rg + 4 * hi;
            const u32x2 zw = *(const u32x2*)(zrow + d0);
            u32x2 ow; ow.x = pk2(o[d][4 * rg] * inv * siluf_(bflo(zw.x)), o[d][4 * rg + 1] * inv * siluf_(bfhi(zw.x))); ow.y = pk2(o[d][4 * rg + 2] * inv * siluf_(bflo(zw.y)), o[d][4 * rg + 3] * inv * siluf_(bfhi(zw.y)));
            *(u32x2*)(orow + d0) = ow; }
    __syncthreads();
}

__device__ __forceinline__ void phase1(const Params& p, LAS unsigned char* lds, int G) {
    unsigned char* ws = p.ws; const int c = (int)blockIdx.x;
    pg8::Gemm g{(const bf16*)(ws + WS_XB), (const bf16*)(ws + WS_WIN), T, N1A, DM, ((long)WS_MEMB - (long)WS_XB) / 2, ((long)WS_WMKV - (long)WS_WIN) / 2};
    pg8::StaticOrder S; S.init(T, N1A, G, c, 1, MT, 1024);
    pg8::EpiProjA E{ws, (bf16*)p.out, (const float*)(ws + WS_RSTDX)};
    pg8::gemm_phase<pg8::EpiProjA, pg8::StaticOrder, true, true>(lds, g, S, E);
}
__device__ __forceinline__ void phase2(const Params& p, LAS unsigned char* lds, int G) {
    unsigned char* ws = p.ws; const int c = (int)blockIdx.x;
    const int gtid = c * NTHR + (int)threadIdx.x, gthreads = G * NTHR;
    headnorm<64>((bf16*)(ws + WS_QA), 512, T, 8, p.q_norm_a, 0.125f * LOG2E, gtid, gthreads);
    headnorm<64>((bf16*)(ws + WS_KA), 512, T, 8, p.k_norm_a, 1.0f, gtid, gthreads);
    headnorm<128>((bf16*)(ws + WS_QM), 512, T, 4, p.q_norm_m, 0.08838834764831845f * LOG2E, gtid, gthreads);
    headnorm<128>((bf16*)(ws + WS_MKV), 1024, MT, 4, p.k_norm_m, 1.0f, gtid, gthreads);
    conv_branch((const bf16*)p.out, p.conv_w, (bf16*)(ws + WS_XBR), gtid, gthreads);
    const int nunits = NB * (SEQ / 8);
    for (int r = 0; r * G < nunits; ++r) {
        const int u = r * G + ((r & 1) ? (G - 1 - c) : c);
        if (!SKIP_TOPK && u < nunits) topk_unit(lds, (const bf16*)(ws + WS_QI), (const bf16*)(ws + WS_KIWI), (u64*)(ws + WS_MASK), u & 3, u >> 2);
    }
}
__device__ __forceinline__ void phase3(const Params& p, LAS unsigned char* lds, int G) {
    unsigned char* ws = p.ws; const int c = (int)blockIdx.x;
    for (int v = c; v < 256; v += G) {
        const int bh = v >> 3, s = v & 7, b = bh >> 3, h = bh & 7;
        const float slope2 = exp2f(-(float)(h + 1)) * LOG2E;
#pragma unroll 1
        for (int k = 0; k < 2; ++k) {
            const int qb = k == 0 ? 15 - s : s; const size_t row0 = (size_t)b * SEQ + qb * 256;
            bf16* q = (bf16*)(ws + WS_QA) + row0 * 512 + h * 64;
            if (!SKIP_FA) flash_unit<64, true>(lds, q, 512, (const bf16*)(ws + WS_KA) + (size_t)b * SEQ * 512 + h * 64, 512, (const bf16*)(ws + WS_VA) + (size_t)b * SEQ * 512 + h * 64, 512,
                                 q, 512, (const bf16*)(ws + WS_ZA) + row0 * 512 + h * 64, 512, 4 * (qb + 1), (const u64*)(ws + WS_MASK) + row0 * 64, slope2);
        }
        {
            const int b2 = v >> 6, hm = (v >> 4) & 3, qb = v & 15; const size_t row0 = (size_t)b2 * SEQ + qb * 256;
            bf16* q = (bf16*)(ws + WS_QM) + row0 * 512 + hm * 128;
            const bf16* kv = (const bf16*)(ws + WS_MKV) + (size_t)b2 * MEML * 1024 + hm * 128;
            if (!SKIP_FM) flash_unit<128, false>(lds, q, 512, kv, 1024, kv + 512, 1024, q, 512, (const bf16*)(ws + WS_ZM) + row0 * 512 + hm * 128, 512, MEML / 64, nullptr, 0.f);
        }
    }
}
__device__ __forceinline__ void phase4(const Params& p, LAS unsigned char* lds, int G) {
    unsigned char* ws = p.ws; const int c = (int)blockIdx.x;
    pg8::Gemm g{(const bf16*)(ws + WS_XB), (const bf16*)(ws + WS_WIN) + (size_t)N1A * DM, T, N1B, DM, 0, 0};
    pg8::StaticOrder S; S.init(T, N1B, G, c);
    pg8::EpiGate E{(bf16*)p.out, (bf16*)(ws + WS_G2), (const float*)(ws + WS_RSTDX), p.b_gate};
    pg8::gemm_phase<pg8::EpiGate, pg8::StaticOrder, true, true>(lds, g, S, E);
}
__device__ __forceinline__ void phase5(const Params& p, LAS unsigned char* lds, int G) {
    unsigned char* ws = p.ws; const int c = (int)blockIdx.x;
    pg8::Gemm g{(const bf16*)(ws + WS_QA), (const bf16*)(ws + WS_WOA), T, 1024, 512, (WS_QM - WS_QA) / 2, (WS_WOM - WS_WOA) / 2};
    pg8::StaticOrder S; S.init(T, 1024, G, c, 3);
    pg8::EpiMerge E{(const bf16*)p.out, (const bf16*)(ws + WS_G2), (bf16*)(ws + WS_MERGED)};
    pg8::gemm_phase<pg8::EpiMerge, pg8::StaticOrder, false, true>(lds, g, S, E);
}
__device__ __forceinline__ void phase6(const Params& p, LAS unsigned char* lds, int G) {
    unsigned char* ws = p.ws; const int c = (int)blockIdx.x;
    pg8::Gemm g{(const bf16*)(ws + WS_MERGED), (const bf16*)(ws + WS_WO), T, 1024, DM, 0, 0};
    pg8::StaticOrder S; S.init(T, 1024, G, c);
    pg8::EpiResF32 E{p.x, p.out, 1024};
    pg8::gemm_phase<pg8::EpiResF32, pg8::StaticOrder, false, true>(lds, g, S, E);
}

template <int PH> __device__ __forceinline__ void run_phase(const Params& p, LAS unsigned char* lds, int G) {
    if (PH == 0) { const int bx = blockIdx.x; const int vcu = (G % 8 == 0) ? (bx % 8) * (G / 8) + bx / 8 : bx; phase0(p, lds, vcu, G); }
    if (PH == 1) phase1(p, lds, G);
    if (PH == 2) phase2(p, lds, G);
    if (PH == 3) phase3(p, lds, G);
    if (PH == 4) phase4(p, lds, G);
    if (PH == 5) phase5(p, lds, G);
    if (PH == 6) phase6(p, lds, G);
}

template <int PH> __global__ void __launch_bounds__(NTHR, 2) phase_kernel(Params p) {
    extern __shared__ __attribute__((aligned(16))) unsigned char lds_raw[];
    run_phase<PH>(p, (LAS unsigned char*)lds_raw, (int)gridDim.x);
}
#if FUSED
__global__ void __launch_bounds__(NTHR, 2) mega_kernel(Params p) {
    extern __shared__ __attribute__((aligned(16))) unsigned char lds_raw[];
    cg::grid_group grid = cg::this_grid();
    LAS unsigned char* lds = (LAS unsigned char*)lds_raw; const int G = (int)gridDim.x;
    run_phase<0>(p, lds, G); grid.sync();
    run_phase<1>(p, lds, G); grid.sync();
    run_phase<2>(p, lds, G); grid.sync();
    run_phase<3>(p, lds, G); grid.sync();
    run_phase<4>(p, lds, G); grid.sync();
    run_phase<5>(p, lds, G); grid.sync();
    run_phase<6>(p, lds, G);
}
#endif

template <int PH> static void launch_phase(const Params& p, int grid, hipStream_t stream) {
    static bool attr = false;
    if (!attr) { (void)hipFuncSetAttribute((const void*)phase_kernel<PH>, hipFuncAttributeMaxDynamicSharedMemorySize, LDS_BYTES); attr = true; }
    hipLaunchKernelGGL(phase_kernel<PH>, dim3(grid), dim3(NTHR), LDS_BYTES, stream, p);
}

extern "C" void kernel_launch(void* const* d_in, const int* in_sizes, int n_in, void* d_out, int out_size, void* d_ws, size_t ws_size, hipStream_t stream) {
    static int grid = 0;
    if (grid == 0) {
        int dev = 0, cus = 0;
        if (hipGetDevice(&dev) != hipSuccess || hipDeviceGetAttribute(&cus, hipDeviceAttributeMultiprocessorCount, dev) != hipSuccess) { fprintf(stderr, "kernel_launch: device query failed\n"); grid = -1; return; }
        if (n_in != 16 || out_size != T * DM || ws_size < 256 * MiB) { fprintf(stderr, "kernel_launch: unexpected shapes (n_in %d out %d ws %zu)\n", n_in, out_size, ws_size); grid = -1; return; }
#if FUSED
        int per_cu = 0;
        (void)hipFuncSetAttribute((const void*)mega_kernel, hipFuncAttributeMaxDynamicSharedMemorySize, LDS_BYTES);
        if (hipOccupancyMaxActiveBlocksPerMultiprocessor(&per_cu, (const void*)mega_kernel, NTHR, LDS_BYTES) != hipSuccess || per_cu < 1) { fprintf(stderr, "kernel_launch: occupancy query says %d\n", per_cu); grid = -1; return; }
        (void)hipGetLastError();
#endif
        grid = cus;
    }
    if (grid < 0) return;
    Params p{};
    p.x = (const float*)d_in[0]; p.mem = (const float*)d_in[1]; p.norm_g = (const float*)d_in[2]; p.mem_norm_g = (const float*)d_in[3]; p.w_in = (const float*)d_in[4]; p.b_gate = (const float*)d_in[5];
    p.w_mem_kv = (const float*)d_in[6]; p.q_norm_a = (const float*)d_in[7]; p.k_norm_a = (const float*)d_in[8]; p.q_norm_m = (const float*)d_in[9]; p.k_norm_m = (const float*)d_in[10]; p.conv_w = (const float*)d_in[11];
    p.w_out_a = (const float*)d_in[12]; p.w_out_b = (const float*)d_in[13]; p.w_out_m = (const float*)d_in[14]; p.w_o = (const float*)d_in[15];
    p.out = (float*)d_out; p.ws = (unsigned char*)d_ws;
#if FUSED
    void* args[] = {&p};
    hipError_t e = hipLaunchCooperativeKernel((const void*)mega_kernel, dim3(grid), dim3(NTHR), args, LDS_BYTES, stream);
    if (e != hipSuccess) fprintf(stderr, "cooperative launch failed: %s (grid %d)\n", hipGetErrorString(e), grid);
#else
    launch_phase<0>(p, grid, stream); launch_phase<1>(p, grid, stream); launch_phase<2>(p, grid, stream); launch_phase<3>(p, grid, stream);
    launch_phase<4>(p, grid, stream); launch_phase<5>(p, grid, stream); launch_phase<6>(p, grid, stream);
#endif
}
```

```cpp
#include <hip/hip_runtime.h>
#include <hip/hip_cooperative_groups.h>
#include <cstdio>
#include <cstdint>
namespace cg = cooperative_groups;
__device__ __forceinline__ int opaque_tid() { int t = (int)threadIdx.x; asm volatile("" : "+v"(t)); return t; }

#ifndef FUSED
#define FUSED 1
#endif
#ifndef TPROBE
#define TPROBE -1
#endif
#ifndef SKIP_TOPK
#define SKIP_TOPK 0
#endif
#ifndef SKIP_FA
#define SKIP_FA 0
#endif
#ifndef SKIP_FM
#define SKIP_FM 0
#endif

namespace pg8 {
#define PG8_LAS __attribute__((address_space(3)))
typedef unsigned short bf16_t;
typedef short bf16x8 __attribute__((ext_vector_type(8)));
typedef float f32x4 __attribute__((ext_vector_type(4)));
typedef unsigned u32x4 __attribute__((ext_vector_type(4)));
constexpr int BM = 256, BK = 64, HALF = 128, HTB = HALF * BK * 2  , STAGE_BYTES = 8 * HTB, NXCD = 8, WGM = 8;

__host__ __device__ __forceinline__ int lds_byte(int r, int c) { const int st = (r >> 4) * 2 + (c >> 5), rr = r & 15, cc = c & 31, ob = rr * 64 + cc * 2; return st * 1024 + (ob ^ (((ob >> 9) & 1) << 5)); }
__host__ __device__ __forceinline__ void stage_rc(int b, int& R, int& C) { const int st = b / 1024, sb = b % 1024, swz = sb ^ (((sb >> 9) & 1) << 5); R = (st >> 1) * 16 + swz / 64; C = (st & 1) * 32 + (swz % 64) / 2; }
__host__ __device__ __forceinline__ int perm32(int rho) { const int n = rho >> 4, i = rho & 15; return 8 * (i >> 2) + 4 * n + (i & 3); }

struct Unit { int pm, pn, br; };
struct Gemm { const bf16_t* A; const bf16_t* Bt; int M, N, K; long strideA, strideB, extraA2;
    __device__ __forceinline__ const bf16_t* a(int br) const { return A + (long)br * strideA + (br == 2 ? extraA2 : 0L); }
    __device__ __forceinline__ const bf16_t* b(int br) const { return Bt + (long)br * strideB; } };

__host__ __device__ __forceinline__ void tile_of(int L, int nM, int nN, int& pm, int& pn) {
    const int nwg = nM * nN; int wgid = L; { const int q = nwg / NXCD, r = nwg % NXCD, xcd = wgid % NXCD, off = wgid / NXCD; wgid = (xcd < r ? xcd * (q + 1) : r * (q + 1) + (xcd - r) * q) + off; }
    const int nig = WGM * nN, gid = wgid / nig, fm = gid * WGM, gsz = (nM - fm) < WGM ? (nM - fm) : WGM;
    pm = fm + ((wgid % nig) % gsz); pn = (wgid % nig) / gsz;
}
struct StaticOrder {
    int nM, nN, nwg, G, c, nsub, nM2, nN2;
    __host__ __device__ void init(int M, int N, int G_, int c_, int nsub_ = 1, int M2 = 0, int N2 = 0) { nM = M / BM; nN = N / BM; nwg = nM * nN; G = G_; c = c_; nsub = nsub_; nM2 = M2 / BM; nN2 = N2 / BM; }
    __host__ __device__ bool next(int i, Unit& u) const {
        const int ti = i / nsub; const long L = (long)ti * G + c; if (L >= nwg + nM2 * nN2) return false;
        if (L < nwg) { tile_of((int)L, nM, nN, u.pm, u.pn); u.br = i - ti * nsub; }
        else { tile_of((int)L - nwg, nM2, nN2, u.pm, u.pn); u.br = 1; }
        return true;
    }
    __device__ __forceinline__ void a_ready(const Unit&) const {}
    __device__ __forceinline__ void done(const Unit&) const {}
};

typedef float f32x2_t __attribute__((ext_vector_type(2))); typedef __bf16 bf16x2_t __attribute__((ext_vector_type(2)));
__device__ __forceinline__ unsigned cvt_pk_bf16(float lo, float hi) { f32x2_t v = {lo, hi}; bf16x2_t b = __builtin_convertvector(v, bf16x2_t); return __builtin_bit_cast(unsigned, b); }
__device__ __forceinline__ float bf_lo(unsigned w) { return __uint_as_float(w << 16); }
__device__ __forceinline__ float bf_hi(unsigned w) { return __uint_as_float(w & 0xffff0000u); }


struct EpiProjA {
    static constexpr bool PERM = true, AFTER_DRAIN = false;
    unsigned char* ws; bf16_t* brb; const float* rstd; const float* gq; const float* gk; bf16_t* g01; bf16_t* g2; const float* bgate;
    __device__ __forceinline__ bool keep(const Unit&) const { return false; }
    __device__ __forceinline__ void operator()(f32x4 (&acc)[2][2][4][2], const Unit& u, int wr, int wc, int fr, int fq) const {
        bf16_t* base; int ldc, colt; const int pn = u.pn; const float* rs = rstd;
        if (u.br == 0 && pn >= 23) {
            const int pg = pn - 23; bf16_t* gb; int gld, gct;
            if (pg < 8) { gb = g01; gld = 2048; gct = pg * 256; } else { gb = g2; gld = 1024; gct = (pg - 8) * 256; }
            const int row0g = u.pm * BM + wr * 64 + fr, col0g = gct + wc * 32 + 8 * fq, bcol0 = pg * BM + wc * 32 + 8 * fq;
            f32x4 bv[2][2];
#pragma unroll
            for (int bj = 0; bj < 2; ++bj)
#pragma unroll
                for (int n = 0; n < 2; ++n) bv[bj][n] = *(const f32x4*)(bgate + bcol0 + bj * HALF + 4 * n);
#pragma unroll
            for (int ai = 0; ai < 2; ++ai)
#pragma unroll
                for (int m = 0; m < 4; ++m) { const int row = row0g + ai * HALF + m * 16; bf16_t* rowp = gb + (size_t)row * gld + col0g;
#pragma unroll
                    for (int bj = 0; bj < 2; ++bj) { f32x4 v0 = acc[ai][bj][m][0] + bv[bj][0], v1 = acc[ai][bj][m][1] + bv[bj][1];
#pragma unroll
                        for (int e = 0; e < 4; ++e) { v0[e] = __builtin_amdgcn_rcpf(1.0f + __builtin_amdgcn_exp2f(-1.4426950408889634f * v0[e])); v1[e] = __builtin_amdgcn_rcpf(1.0f + __builtin_amdgcn_exp2f(-1.4426950408889634f * v1[e])); }
                        u32x4 w; w.x = cvt_pk_bf16(v0[0], v0[1]); w.y = cvt_pk_bf16(v0[2], v0[3]); w.z = cvt_pk_bf16(v1[0], v1[1]); w.w = cvt_pk_bf16(v1[2], v1[3]);
                        *(u32x4*)(rowp + bj * HALF) = w; } }
            return; }
        if (u.br == 0 && pn < 4) {
            bf16_t* dst = (bf16_t*)(ws + ((size_t)(80 + 16 * (pn >> 1)) << 20)); const float* gn = (pn < 2) ? gq : gk; const float osc = (pn < 2) ? 0.125f * 1.4426950408889634f : 1.0f;
            f32x4 gv[2][2];
#pragma unroll
            for (int bj = 0; bj < 2; ++bj)
#pragma unroll
                for (int n = 0; n < 2; ++n) gv[bj][n] = *(const f32x4*)(gn + 32 * bj + 8 * fq + 4 * n);
            const int row0n = u.pm * BM + wr * 64 + fr, hcol = ((pn & 1) * 4 + wc) * 64 + 8 * fq;
#pragma unroll
            for (int ai = 0; ai < 2; ++ai)
#pragma unroll
                for (int m = 0; m < 4; ++m) { const int row = row0n + ai * HALF + m * 16; const float sc = 1.0f;
                    f32x4 v[2][2]; float ss = 0.f;
#pragma unroll
                    for (int bj = 0; bj < 2; ++bj)
#pragma unroll
                        for (int n = 0; n < 2; ++n) { v[bj][n] = acc[ai][bj][m][n] * sc; ss += (v[bj][n][0] * v[bj][n][0] + v[bj][n][1] * v[bj][n][1]) + (v[bj][n][2] * v[bj][n][2] + v[bj][n][3] * v[bj][n][3]); }
                    ss += __shfl_xor(ss, 16); ss += __shfl_xor(ss, 32);
                    const float r = osc / sqrtf(ss * (1.0f / 64.0f) + 1e-6f);
#pragma unroll
                    for (int bj = 0; bj < 2; ++bj) { const f32x4 a = v[bj][0] * gv[bj][0] * r, b = v[bj][1] * gv[bj][1] * r;
                        u32x4 w; w.x = cvt_pk_bf16(a[0], a[1]); w.y = cvt_pk_bf16(a[2], a[3]); w.z = cvt_pk_bf16(b[0], b[1]); w.w = cvt_pk_bf16(b[2], b[3]);
                        *(u32x4*)(dst + (size_t)row * 512 + hcol + 32 * bj) = w; } }
            return; }
        if (u.br == 1) { base = (bf16_t*)(ws + ((size_t)53 << 19)); ldc = 1024; colt = pn * 256; rs = rstd + 16384; }
        else if (pn < 10) { base = (bf16_t*)(ws + ((size_t)(80 + 16 * (pn >> 1)) << 20)); ldc = 512; colt = (pn & 1) * 256; }
        else if (pn == 10) {
            bf16_t* kic = (bf16_t*)(ws + ((size_t)37 << 20)); float* wic = (float*)(ws + ((size_t)39 << 20));
            const int row0k = u.pm * BM + wr * 64 + fr;
#pragma unroll
            for (int ai = 0; ai < 2; ++ai)
#pragma unroll
                for (int m = 0; m < 4; ++m) { const int row = row0k + ai * HALF + m * 16; const float sc = 1.0f;
                    const int col = wc * 32 + 8 * fq;
                    const f32x4 v0 = acc[ai][0][m][0] * sc, v1 = acc[ai][0][m][1] * sc;
                    if (col < 64) { u32x4 w; w.x = cvt_pk_bf16(v0[0], v0[1]); w.y = cvt_pk_bf16(v0[2], v0[3]); w.z = cvt_pk_bf16(v1[0], v1[1]); w.w = cvt_pk_bf16(v1[2], v1[3]); *(u32x4*)(kic + ((size_t)((row >> 5) * 4 + (col >> 4)) * 64 + ((col >> 3) & 1) * 32 + (row & 31)) * 8) = w; }
                    else if (col == 64) { const float is = 0.125f * 0.35355339059327373f; *(f32x4*)(wic + (size_t)row * 8) = v0 * is; *(f32x4*)(wic + (size_t)row * 8 + 4) = v1 * is; } }
            return; }
        else if (pn < 19) {
            const int tl = pn - 11; bf16_t* dst = brb + (tl < 4 ? (size_t)0 : (size_t)16384 * 512);
            const int row0b = u.pm * BM + wr * 64 + fr, jc = 128 * (tl & 3) + wc * 32 + 8 * fq;
#pragma unroll
            for (int ai = 0; ai < 2; ++ai)
#pragma unroll
                for (int m = 0; m < 4; ++m) { const int row = row0b + ai * HALF + m * 16; const float sc = 1.0f;
                    f32x4 a0 = acc[ai][0][m][0] * sc, a1 = acc[ai][0][m][1] * sc, b0 = acc[ai][1][m][0] * sc, b1 = acc[ai][1][m][1] * sc;
                    if (tl < 4) {
#pragma unroll
                        for (int e = 0; e < 4; ++e) { b0[e] = b0[e] * __builtin_amdgcn_rcpf(1.0f + __builtin_amdgcn_exp2f(-1.4426950408889634f * b0[e])); b1[e] = b1[e] * __builtin_amdgcn_rcpf(1.0f + __builtin_amdgcn_exp2f(-1.4426950408889634f * b1[e])); } }
                    a0 = a0 * b0; a1 = a1 * b1;
                    u32x4 w; w.x = cvt_pk_bf16(a0[0], a0[1]); w.y = cvt_pk_bf16(a0[2], a0[3]); w.z = cvt_pk_bf16(a1[0], a1[1]); w.w = cvt_pk_bf16(a1[2], a1[3]);
                    *(u32x4*)(dst + (size_t)row * 512 + jc) = w; }
            return; }
        else { base = (bf16_t*)(ws + ((size_t)(160 + 16 * ((pn - 19) >> 1)) << 20)); ldc = 512; colt = ((pn - 19) & 1) * 256; }
        const int row0 = u.pm * BM + wr * 64 + fr, col0 = colt + wc * 32 + 8 * fq;
#pragma unroll
        for (int ai = 0; ai < 2; ++ai)
#pragma unroll
            for (int m = 0; m < 4; ++m) { const int row = row0 + ai * HALF + m * 16; const float sc = 1.0f; bf16_t* rowp = base + (size_t)row * ldc + col0;
#pragma unroll
                for (int bj = 0; bj < 2; ++bj) { const f32x4 v0 = acc[ai][bj][m][0] * sc, v1 = acc[ai][bj][m][1] * sc;
                    u32x4 w; w.x = cvt_pk_bf16(v0[0], v0[1]); w.y = cvt_pk_bf16(v0[2], v0[3]); w.z = cvt_pk_bf16(v1[0], v1[1]); w.w = cvt_pk_bf16(v1[2], v1[3]);
                    *(u32x4*)(rowp + bj * HALF) = w; } }
    }
};
struct EpiScale {
    static constexpr bool PERM = true, AFTER_DRAIN = false;
    bf16_t* O; int ldc; const float* rstd;
    __device__ __forceinline__ bool keep(const Unit&) const { return false; }
    __device__ __forceinline__ void operator()(f32x4 (&acc)[2][2][4][2], const Unit& u, int wr, int wc, int fr, int fq) const {
        const int row0 = u.pm * BM + wr * 64 + fr, col0 = u.pn * BM + wc * 32 + 8 * fq;
#pragma unroll
        for (int ai = 0; ai < 2; ++ai)
#pragma unroll
            for (int m = 0; m < 4; ++m) { const int row = row0 + ai * HALF + m * 16; const float sc = 1.0f; bf16_t* rowp = O + (size_t)row * ldc + col0;
#pragma unroll
                for (int bj = 0; bj < 2; ++bj) { const f32x4 v0 = acc[ai][bj][m][0] * sc, v1 = acc[ai][bj][m][1] * sc;
                    u32x4 w; w.x = cvt_pk_bf16(v0[0], v0[1]); w.y = cvt_pk_bf16(v0[2], v0[3]); w.z = cvt_pk_bf16(v1[0], v1[1]); w.w = cvt_pk_bf16(v1[2], v1[3]);
                    *(u32x4*)(rowp + bj * HALF) = w; } }
    }
};
__device__ __forceinline__ float sigmoidf_(float x) { return __builtin_amdgcn_rcpf(1.0f + __builtin_amdgcn_exp2f(-1.4426950408889634f * x)); }
struct EpiMerge {
    static constexpr bool PERM = true, AFTER_DRAIN = false;
    const bf16_t* g01; const bf16_t* g2; bf16_t* O;
    __device__ __forceinline__ bool keep(const Unit& u) const { return u.br != 2; }
    __device__ __forceinline__ void operator()(f32x4 (&acc)[2][2][4][2], const Unit& u, int wr, int wc, int fr, int fq) const {
        const int row0 = u.pm * BM + wr * 64 + fr, col0 = u.pn * BM + wc * 32 + 8 * fq; const int br = u.br;
        const bf16_t* nb = g01; int nld = 2048; const bf16_t* db = g2; int dld = 1024;
        if (br == 1) { nb = g2; nld = 1024; db = g01 + 1024; dld = 2048; }
        if (br == 2) { nb = g01 + 1024; db = nb; dld = 2048; }
#pragma unroll
        for (int ai = 0; ai < 2; ++ai) {
            u32x4 num[4][2], den[4][2];
#pragma unroll
            for (int m = 0; m < 4; ++m)
#pragma unroll
                for (int bj = 0; bj < 2; ++bj) { const int row = row0 + ai * HALF + m * 16, col = col0 + bj * HALF;
                    num[m][bj] = *(const u32x4*)(nb + (size_t)row * nld + col);
                    den[m][bj] = *(const u32x4*)(db + (size_t)row * dld + col); }
#pragma unroll
            for (int m = 0; m < 4; ++m)
#pragma unroll
                for (int bj = 0; bj < 2; ++bj) { const int row = row0 + ai * HALF + m * 16, col = col0 + bj * HALF;
                    float f[8];
#pragma unroll
                    for (int e = 0; e < 4; ++e) { const unsigned nw = num[m][bj][e], dw = den[m][bj][e];
                        f[2 * e] = (br == 2) ? bf_lo(nw) : bf_lo(nw) * __builtin_amdgcn_rcpf(bf_lo(dw)); f[2 * e + 1] = (br == 2) ? bf_hi(nw) : bf_hi(nw) * __builtin_amdgcn_rcpf(bf_hi(dw)); }
                    f32x4 v0 = acc[ai][bj][m][0], v1 = acc[ai][bj][m][1];
                    v0[0] *= f[0]; v0[1] *= f[1]; v0[2] *= f[2]; v0[3] *= f[3]; v1[0] *= f[4]; v1[1] *= f[5]; v1[2] *= f[6]; v1[3] *= f[7];
                    acc[ai][bj][m][0] = v0; acc[ai][bj][m][1] = v1;
                    if (br == 2) { u32x4 w; w.x = cvt_pk_bf16(v0[0], v0[1]); w.y = cvt_pk_bf16(v0[2], v0[3]); w.z = cvt_pk_bf16(v1[0], v1[1]); w.w = cvt_pk_bf16(v1[2], v1[3]);
                        *(u32x4*)(O + (size_t)row * 1024 + col) = w; } }
            asm volatile("" ::: "memory");
        }
    }
};
struct EpiResF32 {
    static constexpr bool PERM = false, AFTER_DRAIN = false;
    const float* base; float* out; int ldc;
    __device__ __forceinline__ bool keep(const Unit&) const { return false; }
    __device__ __forceinline__ void operator()(f32x4 (&acc)[2][2][4][2], const Unit& u, int wr, int wc, int fr, int fq) const {
        const int row0 = u.pm * BM + wr * 64 + fr, col0 = u.pn * BM + wc * 32 + 4 * fq;
#pragma unroll
        for (int ai = 0; ai < 2; ++ai)
#pragma unroll
            for (int mh = 0; mh < 2; ++mh) {
                f32x4 bs[2][2][2];
#pragma unroll
                for (int mm = 0; mm < 2; ++mm) { const size_t off = (size_t)(row0 + ai * HALF + (2 * mh + mm) * 16) * ldc + col0;
#pragma unroll
                    for (int bj = 0; bj < 2; ++bj)
#pragma unroll
                        for (int n = 0; n < 2; ++n) bs[mm][bj][n] = *(const f32x4*)(base + off + bj * HALF + n * 16); }
                asm volatile("" ::: "memory");
#pragma unroll
                for (int mm = 0; mm < 2; ++mm) { const size_t off = (size_t)(row0 + ai * HALF + (2 * mh + mm) * 16) * ldc + col0;
#pragma unroll
                    for (int bj = 0; bj < 2; ++bj)
#pragma unroll
                        for (int n = 0; n < 2; ++n) *(f32x4*)(out + off + bj * HALF + n * 16) = bs[mm][bj][n] + acc[ai][bj][2 * mh + mm][n]; }
                asm volatile("" ::: "memory");
            }
    }
};

template <class Epi, class Sched, bool ALIGN_EPI = false, bool SP2 = false>
__device__ __forceinline__ void gemm_phase(PG8_LAS unsigned char* lds, const Gemm g, const Sched& S, const Epi& E) {
    const int tid = opaque_tid(), wid = __builtin_amdgcn_readfirstlane(tid >> 6), lane = tid & 63, wr = wid >> 2, wc = wid & 3, fr = lane & 15, fq = lane >> 4;
    const int K = g.K, nt = K / BK;
    unsigned voffA[2], voffB[2];
#pragma unroll
    for (int i = 0; i < 2; ++i) { int R, C; stage_rc(tid * 16 + i * 8192, R, C); const int Rb = Epi::PERM ? ((R & ~31) + perm32(R & 31)) : R;
        voffA[i] = (unsigned)(R * K + C) * 2u; voffB[i] = (unsigned)(Rb * K + C) * 2u; }
    const size_t kstep = (size_t)(BK * 2);
    const size_t hstep = (size_t)HALF * K * 2;
    const size_t tstep = 2 * hstep;
    const unsigned ldsw = (unsigned)wid * 1024u;
    const int aoff = lds_byte(wr * 64 + fr, fq * 8), boff = lds_byte(wc * 32 + fr, fq * 8);
#define PG8_SA(b, h) (((b) * 2 + (h)) * HTB)
#define PG8_SB(b, h) ((4 + (b) * 2 + (h)) * HTB)
#define PG8_STAGE(bufoff, gbase, voff) do { _Pragma("unroll") for (int _i = 0; _i < 2; ++_i) \
        __builtin_amdgcn_global_load_lds((const unsigned*)((const char*)(gbase) + (voff)[_i]), (PG8_LAS unsigned*)(lds + (bufoff) + ldsw + _i * 8192), 16, 0, 0); } while (0)
#define PG8_LDA(dst, b, h) do { _Pragma("unroll") for (int m = 0; m < 4; ++m) _Pragma("unroll") for (int k = 0; k < 2; ++k) dst[m][k] = *(const PG8_LAS bf16x8*)(lds + PG8_SA(b, h) + aoff + m * 2048 + k * 1024); } while (0)
#define PG8_LDB(dst, b, h) do { _Pragma("unroll") for (int n = 0; n < 2; ++n) _Pragma("unroll") for (int k = 0; k < 2; ++k) dst[n][k] = *(const PG8_LAS bf16x8*)(lds + PG8_SB(b, h) + boff + n * 2048 + k * 1024); } while (0)
#define PG8_MMA(ai, bj, At, Bt) do { __builtin_amdgcn_s_setprio(1); _Pragma("unroll") for (int m = 0; m < 4; ++m) _Pragma("unroll") for (int n = 0; n < 2; ++n) _Pragma("unroll") for (int k = 0; k < 2; ++k) \
        acc[ai][bj][m][n] = __builtin_amdgcn_mfma_f32_16x16x32_bf16(Bt[n][k], At[m][k], acc[ai][bj][m][n], 0, 0, 0); __builtin_amdgcn_s_setprio(0); } while (0)
#define PG8_WAIT_V(n) asm volatile("s_waitcnt vmcnt(" #n ")" ::: "memory")
#define PG8_WAIT_L(n) asm volatile("s_waitcnt lgkmcnt(" #n ")" ::: "memory")
#define PG8_BAR __builtin_amdgcn_s_barrier()
#define PG8_SCHED __builtin_amdgcn_sched_barrier(0)
    Unit cur, nxt; int ui = 0;
    if (!S.next(0, cur)) return;
    f32x4 acc[2][2][4][2];
#pragma unroll
    for (int a = 0; a < 2; ++a)
#pragma unroll
        for (int b = 0; b < 2; ++b)
#pragma unroll
            for (int m = 0; m < 4; ++m)
#pragma unroll
                for (int n = 0; n < 2; ++n) acc[a][b][m][n] = (f32x4){0.f, 0.f, 0.f, 0.f};
    bf16x8 At[4][2], B0[2][2], B1[2][2];
    const char* cA = (const char*)g.a(cur.br) + (size_t)cur.pm * tstep; const char* cB = (const char*)g.b(cur.br) + (size_t)cur.pn * tstep;
    S.a_ready(cur);
    if constexpr (SP2) {
        PG8_STAGE(PG8_SB(0, 0), cB, voffB); PG8_STAGE(PG8_SB(0, 1), cB + hstep, voffB); PG8_STAGE(PG8_SA(0, 0), cA, voffA); PG8_STAGE(PG8_SA(0, 1), cA + hstep, voffA);
        if (wr == 1) PG8_BAR;
        PG8_WAIT_V(2); PG8_BAR;
        PG8_STAGE(PG8_SB(1, 0), cB + kstep, voffB); PG8_STAGE(PG8_SA(1, 0), cA + kstep, voffA); PG8_STAGE(PG8_SB(1, 1), cB + hstep + kstep, voffB);
        PG8_WAIT_V(6); PG8_BAR;
    } else {
        PG8_STAGE(PG8_SB(0, 0), cB, voffB); PG8_STAGE(PG8_SA(0, 0), cA, voffA); PG8_STAGE(PG8_SB(0, 1), cB + hstep, voffB); PG8_STAGE(PG8_SA(0, 1), cA + hstep, voffA);
        if (wr == 1) PG8_BAR;
        PG8_WAIT_V(4); PG8_BAR;
        PG8_STAGE(PG8_SB(1, 0), cB + kstep, voffB); PG8_STAGE(PG8_SA(1, 0), cA + kstep, voffA); PG8_STAGE(PG8_SB(1, 1), cB + hstep + kstep, voffB);
        PG8_WAIT_V(6); PG8_BAR;
    }
    for (;;) {
        const bool has_next = S.next(ui + 1, nxt);
        const char* nA = has_next ? (const char*)g.a(nxt.br) + (size_t)nxt.pm * tstep : cA; const char* nB = has_next ? (const char*)g.b(nxt.br) + (size_t)nxt.pn * tstep : cB;
        for (int t = 0; t < nt; t += 2) {
            const bool last = (t == nt - 2);
            const char* a1 = cA + (size_t)(t + 1) * kstep;
            const char* a2 = last ? nA : cA + (size_t)(t + 2) * kstep; const char* b2 = last ? nB : cB + (size_t)(t + 2) * kstep;
            const char* a3 = a2 + kstep; const char* b3 = b2 + kstep;
            if (last && has_next) S.a_ready(nxt);
            if constexpr (SP2) {
            PG8_LDB(B0, 0, 0); PG8_LDB(B1, 0, 1); PG8_SCHED; PG8_LDA(At, 0, 0); PG8_STAGE(PG8_SA(1, 1), a1 + hstep, voffA);
            PG8_WAIT_V(8); PG8_WAIT_L(0); PG8_BAR; PG8_MMA(0, 0, At, B0); PG8_MMA(0, 1, At, B1); PG8_BAR; PG8_SCHED;
            PG8_LDA(At, 0, 1); PG8_STAGE(PG8_SB(0, 0), b2, voffB); PG8_STAGE(PG8_SB(0, 1), b2 + hstep, voffB); PG8_STAGE(PG8_SA(0, 0), a2, voffA);
            PG8_WAIT_V(8); PG8_WAIT_L(0); PG8_BAR; PG8_MMA(1, 0, At, B0); PG8_MMA(1, 1, At, B1); PG8_BAR; PG8_SCHED;
            PG8_LDB(B0, 1, 0); PG8_LDB(B1, 1, 1); PG8_SCHED; PG8_LDA(At, 1, 0); PG8_STAGE(PG8_SA(0, 1), a2 + hstep, voffA);
            PG8_WAIT_V(8); PG8_WAIT_L(0); PG8_BAR; PG8_MMA(0, 0, At, B0); PG8_MMA(0, 1, At, B1); PG8_BAR; PG8_SCHED;
            PG8_LDA(At, 1, 1); PG8_STAGE(PG8_SB(1, 0), b3, voffB); PG8_STAGE(PG8_SB(1, 1), b3 + hstep, voffB); PG8_STAGE(PG8_SA(1, 0), a3, voffA);
            PG8_WAIT_V(8); PG8_WAIT_L(0); PG8_BAR; PG8_MMA(1, 0, At, B0); PG8_MMA(1, 1, At, B1); PG8_BAR; PG8_SCHED;
            } else {
            PG8_LDB(B0, 0, 0); PG8_SCHED; PG8_LDA(At, 0, 0); PG8_STAGE(PG8_SA(1, 1), a1 + hstep, voffA);
            PG8_WAIT_L(8); PG8_BAR; PG8_WAIT_L(0); PG8_MMA(0, 0, At, B0); PG8_BAR; PG8_SCHED;
            PG8_LDB(B1, 0, 1); PG8_STAGE(PG8_SB(0, 0), b2, voffB);
            PG8_BAR; PG8_WAIT_L(0); PG8_MMA(0, 1, At, B1); PG8_BAR;
            PG8_LDA(At, 0, 1); PG8_STAGE(PG8_SA(0, 0), a2, voffA);
            PG8_BAR; PG8_WAIT_L(0); PG8_MMA(1, 0, At, B0); PG8_BAR; PG8_SCHED;
            PG8_STAGE(PG8_SB(0, 1), b2 + hstep, voffB);
            PG8_WAIT_V(6); PG8_BAR; PG8_MMA(1, 1, At, B1); PG8_BAR;
            PG8_LDB(B0, 1, 0); PG8_SCHED; PG8_LDA(At, 1, 0); PG8_STAGE(PG8_SA(0, 1), a2 + hstep, voffA);
            PG8_WAIT_L(8); PG8_BAR; PG8_WAIT_L(0); PG8_MMA(0, 0, At, B0); PG8_BAR; PG8_SCHED;
            PG8_LDB(B1, 1, 1); PG8_STAGE(PG8_SB(1, 0), b3, voffB);
            PG8_BAR; PG8_WAIT_L(0); PG8_MMA(0, 1, At, B1); PG8_BAR;
            PG8_LDA(At, 1, 1); PG8_STAGE(PG8_SA(1, 0), a3, voffA);
            PG8_BAR; PG8_WAIT_L(0); PG8_MMA(1, 0, At, B0); PG8_BAR; PG8_SCHED;
            PG8_STAGE(PG8_SB(1, 1), b3 + hstep, voffB);
            PG8_WAIT_V(6); PG8_BAR; PG8_MMA(1, 1, At, B1); PG8_BAR;
            }
        }
        if constexpr (ALIGN_EPI) { if (wr == 0) PG8_BAR; }
        if constexpr (!Epi::AFTER_DRAIN) { E(acc, cur, wr, wc, fr, fq); S.done(cur); }
        if (!has_next) break;
        if (!E.keep(cur)) {
#pragma unroll
        for (int a = 0; a < 2; ++a)
#pragma unroll
            for (int b = 0; b < 2; ++b)
#pragma unroll
                for (int m = 0; m < 4; ++m)
#pragma unroll
                    for (int n = 0; n < 2; ++n) acc[a][b][m][n] = (f32x4){0.f, 0.f, 0.f, 0.f};
        }
        cur = nxt; cA = nA; cB = nB; ++ui;
        if constexpr (ALIGN_EPI) { if (wr == 1) PG8_BAR; }
    }
    PG8_WAIT_V(0);
    if constexpr (!ALIGN_EPI) { if (wr == 0) PG8_BAR; }
    PG8_BAR;
    if constexpr (Epi::AFTER_DRAIN) { E.fused(acc, cur, wr, wc, fr, fq, lds, wid, lane); S.done(cur); }
#undef PG8_SA
#undef PG8_SB
#undef PG8_STAGE
#undef PG8_LDA
#undef PG8_LDB
#undef PG8_MMA
#undef PG8_WAIT_V
#undef PG8_WAIT_L
#undef PG8_BAR
#undef PG8_SCHED
}
}

#define LAS __attribute__((address_space(3)))
typedef unsigned short bf16;
typedef short bf16x8 __attribute__((ext_vector_type(8)));
typedef short s16x4 __attribute__((ext_vector_type(4)));
typedef float f32x4 __attribute__((ext_vector_type(4)));
typedef float f32x16 __attribute__((ext_vector_type(16)));
typedef unsigned u32x4 __attribute__((ext_vector_type(4)));
typedef unsigned u32x2 __attribute__((ext_vector_type(2)));
typedef unsigned long long u64;

constexpr int NB = 4, SEQ = 4096, DM = 1024, T = NB * SEQ, MEML = 256, MT = NB * MEML;
constexpr int NIN_SRC = 8776, N1A = 5888, N1B = 3072, NIN = N1A + N1B;
constexpr int GAP0 = 2632, GAPLEN = 184;
constexpr float RMS_EPS = 1e-6f, LOG2E = 1.4426950408889634f;
constexpr int NWAVES = 8, NTHR = 512;
constexpr int LDS_BYTES = 147456;

constexpr size_t MiB = (size_t)1 << 20;
constexpr size_t WS_WIN = 0, WS_WMKV = 35 * MiB / 2, WS_WOA = 39 * MiB / 2, WS_WOM = 41 * MiB / 2, WS_WOB = 43 * MiB / 2, WS_WO = 45 * MiB / 2, WS_MEMB = 49 * MiB / 2, WS_MKV = 53 * MiB / 2;
constexpr size_t WS_RSTDX = 57 * MiB / 2, WS_RSTDM = WS_RSTDX + 65536;
constexpr size_t WS_MASK = 29 * MiB, WS_KIWI = 37 * MiB, WS_XB = 48 * MiB;
constexpr size_t WS_QA = 80 * MiB, WS_KA = 96 * MiB, WS_VA = 112 * MiB, WS_ZA = 128 * MiB, WS_QI = 144 * MiB, WS_QM = 160 * MiB, WS_ZM = 176 * MiB, WS_XBR = 240 * MiB;
static_assert(WS_WOB - WS_WOM == WS_WOM - WS_WOA, "uniform stride of the three out-projection weights");
constexpr size_t WS_G01 = 192 * MiB  , WS_MERGED = WS_ZA  ;
static_assert((size_t)NIN * DM * 2 == 35 * MiB / 2, "w_in copy size");

struct Params {
    const float *x, *mem, *norm_g, *mem_norm_g, *w_in, *b_gate, *w_mem_kv, *q_norm_a, *k_norm_a, *q_norm_m, *k_norm_m, *conv_w, *w_out_a, *w_out_b, *w_out_m, *w_o;
    float* out; unsigned char* ws;
};

__device__ __forceinline__ unsigned f2bf(float f) { unsigned u = __builtin_bit_cast(unsigned, f); return (u + 0x7fffu + ((u >> 16) & 1u)) >> 16; }
__device__ __forceinline__ unsigned pk2(float lo, float hi) { return f2bf(lo) | (f2bf(hi) << 16); }
__device__ __forceinline__ float bflo(unsigned w) { return __uint_as_float(w << 16); }
__device__ __forceinline__ float bfhi(unsigned w) { return __uint_as_float(w & 0xffff0000u); }
__device__ __forceinline__ float bf2f(bf16 h) { return __uint_as_float((unsigned)h << 16); }
__device__ __forceinline__ float wave_sum(float v) {
#pragma unroll
    for (int o = 1; o < 64; o <<= 1) v += __shfl_xor(v, o);
    return v;
}
__device__ __forceinline__ float siluf_(float z) { return z * __builtin_amdgcn_rcpf(1.0f + __builtin_amdgcn_exp2f(-LOG2E * z)); }
__device__ __forceinline__ float max_halves(float v) { const auto rr = __builtin_amdgcn_permlane32_swap(__float_as_uint(v), __float_as_uint(v), false, false); return fmaxf(__uint_as_float(rr[0]), __uint_as_float(rr[1])); }
__device__ __forceinline__ float sum_halves(float v) { const auto rr = __builtin_amdgcn_permlane32_swap(__float_as_uint(v), __float_as_uint(v), false, false); return __uint_as_float(rr[0]) + __uint_as_float(rr[1]); }

__device__ __forceinline__ void p0_transpose_item(const float* W, int K, int Nsrc, int Ndst, const float* gain, int gap0, int gaplen, bf16* WT, LAS float* scr, int item, int lane, bool headperm = false) {
    const int nblk = Ndst / 32, kb = item / nblk, nb = item % nblk, k0 = 64 * kb, n0 = 32 * nb;
    int nd = n0 + (lane & 7) * 4; const bool valid = (nd < gap0) || (nd >= gap0 + gaplen);
    if (headperm && nd < 1024) nd = (nd & ~255) + ((nd >> 5) & 3) * 64 + ((nd >> 7) & 1) * 32 + (nd & 31);
    int ns = nd < gap0 ? nd : nd - gaplen;
    if (headperm && nd >= 2816 && nd < 4864) {
        const int tl = (nd - 2816) >> 8, ct = (nd - 2816) & 255, j = 128 * (tl & 3) + (ct & 127), which = ct >> 7;
        ns = (tl < 4 ? (which ? 4168 : 2632) : (which ? 3656 : 3144)) + j; }
    f32x4 v[8]; float gk[8];
#pragma unroll
    for (int i = 0; i < 8; ++i) { const int kk = 8 * i + (lane >> 3); v[i] = (f32x4){0.f, 0.f, 0.f, 0.f}; gk[i] = 1.0f; if (valid) { v[i] = *(const f32x4*)(W + (size_t)(k0 + kk) * Nsrc + ns); if (gain) gk[i] = gain[k0 + kk]; } }
#pragma unroll
    for (int i = 0; i < 8; ++i) v[i] = v[i] * gk[i];
#pragma unroll
    for (int i = 0; i < 8; ++i) { const int kk = 8 * i + (lane >> 3); LAS float* d = scr + kk * 33 + (lane & 7) * 4; d[0] = v[i][0]; d[1] = v[i][1]; d[2] = v[i][2]; d[3] = v[i][3]; }
    asm volatile("s_waitcnt lgkmcnt(0)" ::: "memory");
    const int c = lane & 7;
#pragma unroll
    for (int j = 0; j < 4; ++j) { const int n = (lane >> 3) + 8 * j; const LAS float* sp = scr + (8 * c) * 33 + n;
        u32x4 o; o.x = pk2(sp[0 * 33], sp[1 * 33]); o.y = pk2(sp[2 * 33], sp[3 * 33]); o.z = pk2(sp[4 * 33], sp[5 * 33]); o.w = pk2(sp[6 * 33], sp[7 * 33]);
        *(u32x4*)(WT + (size_t)(n0 + n) * K + k0 + 8 * c) = o; }
    asm volatile("s_waitcnt lgkmcnt(0)" ::: "memory");
}
__device__ __forceinline__ void rows4_to_bf16(const float* xrow, bf16* orow, float* rstd_out, int lane) {
    f32x4 v[4][4]; float s[4];
#pragma unroll
    for (int r = 0; r < 4; ++r)
#pragma unroll
        for (int j = 0; j < 4; ++j) v[r][j] = *((const f32x4*)(xrow + (size_t)r * DM) + lane + 64 * j);
#pragma unroll
    for (int r = 0; r < 4; ++r) { float a = 0.f;
#pragma unroll
        for (int j = 0; j < 4; ++j) a += (v[r][j].x * v[r][j].x + v[r][j].y * v[r][j].y) + (v[r][j].z * v[r][j].z + v[r][j].w * v[r][j].w);
        s[r] = a; }
#pragma unroll
    for (int o = 1; o < 64; o <<= 1) { s[0] += __shfl_xor(s[0], o); s[1] += __shfl_xor(s[1], o); s[2] += __shfl_xor(s[2], o); s[3] += __shfl_xor(s[3], o); }
#pragma unroll
    for (int r = 0; r < 4; ++r) { const float rs = 1.0f / sqrtf(s[r] * (1.0f / DM) + RMS_EPS); u32x2* o8 = (u32x2*)(orow + (size_t)r * DM) + lane;
#pragma unroll
        for (int j = 0; j < 4; ++j) { u32x2 w; w.x = pk2(v[r][j].x * rs, v[r][j].y * rs); w.y = pk2(v[r][j].z * rs, v[r][j].w * rs); o8[64 * j] = w; } }
    (void)rstd_out;
}
__device__ __forceinline__ void phase0(const Params& p, LAS unsigned char* lds, int vcu, int G) {
    const int tid = opaque_tid(), lane = tid & 63, wave = tid >> 6;
    LAS float* scr = (LAS float*)(lds + wave * 16384);
    const int gw = vcu * NWAVES + wave, NGW = G * NWAVES;
    unsigned char* ws = p.ws;
    for (int m4 = gw; m4 < (T + MT) / 4; m4 += NGW) { const int m = 4 * m4;
        if (m < T) rows4_to_bf16(p.x + (size_t)m * DM, (bf16*)(ws + WS_XB) + (size_t)m * DM, (float*)(ws + WS_RSTDX) + m, lane);
        else { const int mm = m - T; rows4_to_bf16(p.mem + (size_t)mm * DM, (bf16*)(ws + WS_MEMB) + (size_t)mm * DM, (float*)(ws + WS_RSTDM) + mm, lane); } }
    constexpr int I_IN = (DM / 64) * (NIN / 32), I_MKV = (DM / 64) * (1024 / 32), I_OX = (512 / 64) * (1024 / 32), I_O = (DM / 64) * (1024 / 32);
    constexpr int NITEMS = I_IN + I_MKV + 3 * I_OX + I_O;
    for (int it = gw; it < NITEMS; it += NGW) {
        int r = it;
        if (r < I_IN) { p0_transpose_item(p.w_in, DM, NIN_SRC, NIN, p.norm_g, GAP0, GAPLEN, (bf16*)(ws + WS_WIN), scr, r, lane, true); continue; } r -= I_IN;
        if (r < I_MKV) { p0_transpose_item(p.w_mem_kv, DM, 1024, 1024, p.mem_norm_g, 1 << 30, 0, (bf16*)(ws + WS_WMKV), scr, r, lane); continue; } r -= I_MKV;
        if (r < I_OX) { p0_transpose_item(p.w_out_a, 512, 1024, 1024, nullptr, 1 << 30, 0, (bf16*)(ws + WS_WOA), scr, r, lane); continue; } r -= I_OX;
        if (r < I_OX) { p0_transpose_item(p.w_out_b, 512, 1024, 1024, nullptr, 1 << 30, 0, (bf16*)(ws + WS_WOB), scr, r, lane); continue; } r -= I_OX;
        if (r < I_OX) { p0_transpose_item(p.w_out_m, 512, 1024, 1024, nullptr, 1 << 30, 0, (bf16*)(ws + WS_WOM), scr, r, lane); continue; } r -= I_OX;
        p0_transpose_item(p.w_o, DM, 1024, 1024, nullptr, 1 << 30, 0, (bf16*)(ws + WS_WO), scr, r, lane);
    }
}

template <int HD>
__device__ __forceinline__ void headnorm(bf16* X, int ld, int R, int NH, const float* gain, float oscale, int gtid, int gthreads) {
    constexpr int TPH = HD / 8;
    const long total = (long)R * NH * TPH;
    for (long i = gtid; i < total; i += gthreads) {
        const int part = (int)(i % TPH); const long rh = i / TPH; const int head = (int)(rh % NH); const long row = rh / NH;
        bf16* ptr = X + row * ld + head * HD + part * 8;
        const u32x4 w = *(const u32x4*)ptr; float f[8];
#pragma unroll
        for (int e = 0; e < 4; ++e) { f[2 * e] = bflo(w[e]); f[2 * e + 1] = bfhi(w[e]); }
        float s = 0.f;
#pragma unroll
        for (int e = 0; e < 8; ++e) s += f[e] * f[e];
#pragma unroll
        for (int o = 1; o < TPH; o <<= 1) s += __shfl_xor(s, o);
        const float r = oscale / sqrtf(s * (1.0f / HD) + RMS_EPS);
        const f32x4 g0 = *(const f32x4*)(gain + part * 8), g1 = *(const f32x4*)(gain + part * 8 + 4);
        u32x4 o; o.x = pk2(f[0] * r * g0.x, f[1] * r * g0.y); o.y = pk2(f[2] * r * g0.z, f[3] * r * g0.w); o.z = pk2(f[4] * r * g1.x, f[5] * r * g1.y); o.w = pk2(f[6] * r * g1.z, f[7] * r * g1.w);
        *(u32x4*)ptr = o;
    }
}
__device__ __forceinline__ void conv_branch(const bf16* BR, const float* cw, bf16* XO, int gtid, int gthreads) {
    const long total = (long)T * 64; const bf16* U = BR + (size_t)T * 512;
    for (long i = gtid; i < total; i += gthreads) {
        const int c8 = (int)(i & 63) * 8; const long row = i >> 6; const int tl = (int)(row & (SEQ - 1));
        float y[8];
#pragma unroll
        for (int e = 0; e < 8; ++e) y[e] = 0.f;
#pragma unroll
        for (int k = 0; k < 3; ++k) {
            const int back = 2 - k;
            if (tl - back >= 0) {
                const u32x4 uw = *(const u32x4*)(U + (row - back) * 512 + c8);
                const f32x4 w0 = *(const f32x4*)(cw + k * 512 + c8), w1 = *(const f32x4*)(cw + k * 512 + c8 + 4);
                const float wk[8] = {w0.x, w0.y, w0.z, w0.w, w1.x, w1.y, w1.z, w1.w};
#pragma unroll
                for (int e = 0; e < 4; ++e) { y[2 * e] += wk[2 * e] * bflo(uw[e]); y[2 * e + 1] += wk[2 * e + 1] * bfhi(uw[e]); }
            }
        }
        const u32x4 vw = *(const u32x4*)(BR + row * 512 + c8);
        u32x4 o;
#pragma unroll
        for (int e = 0; e < 4; ++e) o[e] = pk2(bflo(vw[e]) * y[2 * e], bfhi(vw[e]) * y[2 * e + 1]);
        *(u32x4*)(XO + row * 512 + c8) = o;
    }
}

__device__ __forceinline__ unsigned umin_(unsigned a, unsigned b) { return a < b ? a : b; }
__device__ __forceinline__ unsigned umax_(unsigned a, unsigned b) { return a > b ? a : b; }
typedef unsigned short u16x2 __attribute__((ext_vector_type(2)));
typedef short i16x2 __attribute__((ext_vector_type(2)));
__device__ __forceinline__ u16x2 as_u16x2(unsigned x) { return __builtin_bit_cast(u16x2, x); }
__device__ __forceinline__ unsigned as_u32(u16x2 x) { return __builtin_bit_cast(unsigned, x); }
__device__ __forceinline__ u16x2 pkmin(u16x2 a, u16x2 b) { return __builtin_elementwise_min(a, b); }
__device__ __forceinline__ u16x2 pkmax(u16x2 a, u16x2 b) { return __builtin_elementwise_max(a, b); }
__device__ __forceinline__ int wave_sum_dpp(int v) {
    v += __builtin_amdgcn_update_dpp(0, v, 0xB1, 0xF, 0xF, true); v += __builtin_amdgcn_update_dpp(0, v, 0x4E, 0xF, 0xF, true);
    v += __builtin_amdgcn_update_dpp(0, v, 0x124, 0xF, 0xF, true); v += __builtin_amdgcn_update_dpp(0, v, 0x128, 0xF, 0xF, true);
    return (__builtin_amdgcn_readlane(v, 0) + __builtin_amdgcn_readlane(v, 16)) + (__builtin_amdgcn_readlane(v, 32) + __builtin_amdgcn_readlane(v, 48));
}
__device__ __forceinline__ unsigned wave_umin_dpp(unsigned v) {
    v = umin_(v, (unsigned)__builtin_amdgcn_update_dpp(0, (int)v, 0xB1, 0xF, 0xF, true)); v = umin_(v, (unsigned)__builtin_amdgcn_update_dpp(0, (int)v, 0x4E, 0xF, 0xF, true));
    v = umin_(v, (unsigned)__builtin_amdgcn_update_dpp(0, (int)v, 0x124, 0xF, 0xF, true)); v = umin_(v, (unsigned)__builtin_amdgcn_update_dpp(0, (int)v, 0x128, 0xF, 0xF, true));
    return umin_(umin_((unsigned)__builtin_amdgcn_readlane((int)v, 0), (unsigned)__builtin_amdgcn_readlane((int)v, 16)), umin_((unsigned)__builtin_amdgcn_readlane((int)v, 32), (unsigned)__builtin_amdgcn_readlane((int)v, 48)));
}
__device__ __forceinline__ unsigned wave_umax_dpp(unsigned v) {
    v = umax_(v, (unsigned)__builtin_amdgcn_update_dpp(0, (int)v, 0xB1, 0xF, 0xF, true)); v = umax_(v, (unsigned)__builtin_amdgcn_update_dpp(0, (int)v, 0x4E, 0xF, 0xF, true));
    v = umax_(v, (unsigned)__builtin_amdgcn_update_dpp(0, (int)v, 0x124, 0xF, 0xF, true)); v = umax_(v, (unsigned)__builtin_amdgcn_update_dpp(0, (int)v, 0x128, 0xF, 0xF, true));
    return umax_(umax_((unsigned)__builtin_amdgcn_readlane((int)v, 0), (unsigned)__builtin_amdgcn_readlane((int)v, 16)), umax_((unsigned)__builtin_amdgcn_readlane((int)v, 32), (unsigned)__builtin_amdgcn_readlane((int)v, 48)));
}
__device__ __forceinline__ int count_ge16(const unsigned (&v)[32], unsigned cand, int nc) {
    const unsigned c2 = cand | (cand << 16), c1 = (cand - 1u) | ((cand - 1u) << 16);
    unsigned a0 = 0u, a1 = 0u;
#pragma unroll
    for (int c8 = 0; c8 < 4; ++c8) {
        if (c8 < nc) {
#pragma unroll
            for (int ii = 0; ii < 8; ii += 2) {
                const u16x2 x0 = as_u16x2(v[8 * c8 + ii]), x1 = as_u16x2(v[8 * c8 + ii + 1]);
                a0 = __builtin_amdgcn_sad_u16(as_u32(pkmin(x0, as_u16x2(c2))), as_u32(pkmin(x0, as_u16x2(c1))), a0);
                a1 = __builtin_amdgcn_sad_u16(as_u32(pkmin(x1, as_u16x2(c2))), as_u32(pkmin(x1, as_u16x2(c1))), a1);
            }
        }
    }
    return wave_sum_dpp((int)(a0 + a1));
}
__device__ __forceinline__ void nat_words(u64 lo, u64 hi, u64& w0, u64& w1) { w0 = (lo & 0xffffffffull) | (hi << 32); w1 = (lo >> 32) | (hi & 0xffffffff00000000ull); }

template <int I> __device__ __forceinline__ void deposit_words(u64 lob, u64 hib, unsigned& wlo, unsigned& whi) {
    const unsigned l0 = (unsigned)lob, l1 = (unsigned)(lob >> 32), h0 = (unsigned)hib, h1 = (unsigned)(hib >> 32);
    asm volatile("s_nop 1" :: "s"(l0), "s"(l1), "s"(h0), "s"(h1));
    asm volatile("v_writelane_b32 %0, %1, %2" : "+v"(wlo) : "s"(l0), "n"(2 * I));
    asm volatile("v_writelane_b32 %0, %1, %2" : "+v"(whi) : "s"(h0), "n"(2 * I));
    asm volatile("v_writelane_b32 %0, %1, %2" : "+v"(wlo) : "s"(l1), "n"(2 * I + 1));
    asm volatile("v_writelane_b32 %0, %1, %2" : "+v"(whi) : "s"(h1), "n"(2 * I + 1));
}
template <int I> __device__ __forceinline__ void emit_simple(const unsigned (&v)[32], unsigned tau, unsigned tau_hi, unsigned& wlo, unsigned& whi) {
    const unsigned x = v[I];
    deposit_words<I>(__ballot((x & 0xffffu) >= tau), __ballot(x >= tau_hi), wlo, whi);
}
template <int I> __device__ __forceinline__ void emit_ties(const unsigned (&v)[32], unsigned tau, unsigned tau_hi, int& need, unsigned& wlo, unsigned& whi) {
    const unsigned x = v[I]; const unsigned xl = x & 0xffffu, xh = x & 0xffff0000u;
    u64 glo = __ballot(xl > tau), ghi = __ballot(xh > tau_hi); const u64 elo = __ballot(xl == tau), ehi = __ballot(xh == tau_hi);
    if ((elo | ehi) != 0ull) {
        u64 g0, g1, e0, e1; nat_words(glo, ghi, g0, g1); nat_words(elo, ehi, e0, e1);
#pragma unroll
        for (int h2 = 0; h2 < 2; ++h2) { u64 e = h2 ? e1 : e0; u64 take = 0ull;
            const int pc = __popcll(e);
            if (pc <= need) { take = e; need -= pc; } else { while (need > 0) { const u64 low = e & (0ull - e); take |= low; e ^= low; --need; } }
            if (h2) g1 |= take; else g0 |= take; }
        glo = (g0 & 0xffffffffull) | (g1 << 32); ghi = (g0 >> 32) | (g1 & 0xffffffff00000000ull);
    }
    deposit_words<I>(glo, ghi, wlo, whi);
}
#define REP8(F, B, ...) F<B + 0>(__VA_ARGS__); F<B + 1>(__VA_ARGS__); F<B + 2>(__VA_ARGS__); F<B + 3>(__VA_ARGS__); F<B + 4>(__VA_ARGS__); F<B + 5>(__VA_ARGS__); F<B + 6>(__VA_ARGS__); F<B + 7>(__VA_ARGS__)
typedef _Float16 f16x8 __attribute__((ext_vector_type(8)));
typedef _Float16 f16x2 __attribute__((ext_vector_type(2)));
__device__ __forceinline__ void topk_unit2(LAS unsigned char* lds, const bf16* QI, const bf16* KIWI  , const float* WIC  , u64* MASK, int b, int tb16) {
    const int tid = opaque_tid(), lane = tid & 63, wid = __builtin_amdgcn_readfirstlane(tid >> 6), r32 = lane & 31, hi = lane >> 5;
    const int grp = wid >> 2, w4 = wid & 3;
    const int t0 = tb16 * 16 + grp * 8; const size_t rowb = (size_t)b * SEQ;
    LAS unsigned* SC = (LAS unsigned*)lds + grp * (8 * 2048);
    const int nt2 = ((t0 + 8 + 127) >> 7) << 1;
    bf16x8 af[2][4]; f16x8 a2[2][2];
    {
        const int rho = r32, qq = 2 * ((rho >> 2) & 1) + (rho >> 4), head = (rho & 3) + 4 * ((rho >> 3) & 1);
#pragma unroll
        for (int m = 0; m < 2; ++m) { const bf16* pq = QI + (rowb + t0 + 4 * m + qq) * 512 + head * 64 + 8 * hi;
#pragma unroll
            for (int ks = 0; ks < 4; ++ks) af[m][ks] = *(const bf16x8*)(pq + 16 * ks); }
        f32x4 wa = {0.f, 0.f, 0.f, 0.f}, wb = {0.f, 0.f, 0.f, 0.f};
        if (r32 < 8) { wa = *(const f32x4*)(WIC + (rowb + t0 + r32) * 8); wb = *(const f32x4*)(WIC + (rowb + t0 + r32) * 8 + 4); }
#pragma unroll
        for (int m = 0; m < 2; ++m)
#pragma unroll
            for (int sx = 0; sx < 2; ++sx) { const bool on = (r32 == 4 * m + 2 * hi + sx);
                f16x8 w8; w8[0] = (_Float16)(on ? wa[0] : 0.f); w8[1] = (_Float16)(on ? wa[1] : 0.f); w8[2] = (_Float16)(on ? wa[2] : 0.f); w8[3] = (_Float16)(on ? wa[3] : 0.f);
                w8[4] = (_Float16)(on ? wb[0] : 0.f); w8[5] = (_Float16)(on ? wb[1] : 0.f); w8[6] = (_Float16)(on ? wb[2] : 0.f); w8[7] = (_Float16)(on ? wb[3] : 0.f); a2[m][sx] = w8; }
    }
    {
        bf16x8 bA[2][4], bB[2][4];
        const bf16* kbase = KIWI + rowb * 64 + lane * 8;
        auto loadb = [&](bf16x8 (&bb)[2][4], int j2) { const int jj = j2 < nt2 ? j2 : nt2 - 1;
#pragma unroll
            for (int tt = 0; tt < 2; ++tt)
#pragma unroll
                for (int ks = 0; ks < 4; ++ks) bb[tt][ks] = *(const bf16x8*)(kbase + (size_t)((2 * jj + tt) * 4 + ks) * 512); };
        auto compute = [&](const bf16x8 (&bb)[2][4], int j2) {
            f32x16 c2[2];
#pragma unroll
            for (int tt = 0; tt < 2; ++tt) {
                f32x16 acc2;
#pragma unroll
                for (int r = 0; r < 16; ++r) acc2[r] = 0.f;
#pragma unroll
                for (int m = 0; m < 2; ++m) {
                    f32x16 c1;
#pragma unroll
                    for (int r = 0; r < 16; ++r) c1[r] = 0.f;
#pragma unroll
                    for (int ks = 0; ks < 4; ++ks) c1 = __builtin_amdgcn_mfma_f32_32x32x16_bf16(af[m][ks], bb[tt][ks], c1, 0, 0, 0);
#pragma unroll
                    for (int sx = 0; sx < 2; ++sx) { f16x8 pf;
#pragma unroll
                        for (int e = 0; e < 4; ++e) { f16x2 h2 = __builtin_bit_cast(f16x2, __builtin_amdgcn_cvt_pkrtz(c1[8 * sx + 2 * e], c1[8 * sx + 2 * e + 1]));
                            h2 = __builtin_elementwise_max(h2, (f16x2){(_Float16)0.f, (_Float16)0.f}); pf[2 * e] = h2[0]; pf[2 * e + 1] = h2[1]; }
                        acc2 = __builtin_amdgcn_mfma_f32_32x32x16_f16(a2[m][sx], pf, acc2, 0, 0, 0); }
                }
                c2[tt] = acc2;
            }
            const int key0 = 64 * j2 + r32;
            const bool diag = (64 * j2 + 63 > t0);
#pragma unroll
            for (int e = 0; e < 4; ++e) {
                const int q = 4 * hi + e;
                const unsigned x = __builtin_bit_cast(unsigned, __builtin_amdgcn_cvt_pkrtz(c2[0][e], c2[1][e]));
                const i16x2 sg = __builtin_bit_cast(i16x2, x) >> 15;
                unsigned k = x ^ (__builtin_bit_cast(unsigned, sg) | 0x80008000u);
                if (diag) { const int t = t0 + q; if (key0 > t) k &= 0xffff0000u; if (key0 + 32 > t) k &= 0x0000ffffu; }
                SC[q * 2048 + j2 * 32 + r32] = k;
            } };
        loadb(bA, w4); __builtin_amdgcn_sched_barrier(0);
        for (int j2 = w4; j2 < nt2; j2 += 8) {
            loadb(bB, j2 + 4); __builtin_amdgcn_sched_barrier(0);
            compute(bA, j2); __builtin_amdgcn_sched_barrier(0);
            loadb(bA, j2 + 8); __builtin_amdgcn_sched_barrier(0);
            if (j2 + 4 < nt2) compute(bB, j2 + 4);
            __builtin_amdgcn_sched_barrier(0);
        }
    }
    __syncthreads();
#pragma unroll 1
    for (int qi = 0; qi < 2; ++qi) {
        const int q = 2 * w4 + qi, t = t0 + q, n = t + 1;
        unsigned wlo = 0u, whi = 0u;
        if (n <= 256) {
            const int lo = 64 * lane; u64 w;
            if (lo + 63 <= t) w = ~0ull; else if (lo > t) w = 0ull; else w = (1ull << (t - lo + 1)) - 1ull;
            wlo = (unsigned)w; whi = (unsigned)(w >> 32);
        } else {
            const int nw = (n + 127) >> 7, nc = (nw + 7) >> 3;
            unsigned v[32];
#pragma unroll
            for (int i = 0; i < 32; ++i) v[i] = 0u;
#pragma unroll
            for (int c8 = 0; c8 < 4; ++c8) {
                if (c8 < nc) {
#pragma unroll
                    for (int ii = 0; ii < 8; ++ii) { const int i = 8 * c8 + ii; if (i < nw) v[i] = SC[q * 2048 + 64 * i + lane]; }
                }
            }
            u16x2 ta = as_u16x2(0u), tb = as_u16x2(0u);
#pragma unroll
            for (int c8 = 0; c8 < 4; ++c8) {
                if (c8 < nc) {
#pragma unroll
                    for (int ii = 0; ii < 8; ++ii) { const u16x2 x = as_u16x2(v[8 * c8 + ii]); tb = pkmin(pkmax(x, tb), ta); ta = pkmax(ta, x); }
                }
            }
            const unsigned L = wave_umin_dpp(umin_(tb[0], tb[1])), U = wave_umax_dpp(umax_(tb[0], tb[1]));
            unsigned lo = L, hi = U + 1u; int clo = -1, chi = -1, cge = 0; unsigned tau = L; bool done = false;
            for (int iter = 0; hi - lo > 1u; ++iter) {
                unsigned cand = lo + ((hi - lo) >> 1);
                if (clo >= 0 && chi >= 0 && (iter & 1) == 0) {
                    const float frac = ((float)(clo - 256) + 0.5f) / (float)(clo - chi);
                    cand = lo + (unsigned)(frac * (float)(hi - lo));
                    cand = cand <= lo ? lo + 1u : (cand >= hi ? hi - 1u : cand);
                }
                const int cnt = count_ge16(v, cand, nc);
                if (cnt >= 256) { lo = cand; clo = cnt; if (cnt == 256) { done = true; break; } } else { hi = cand; chi = cnt; }
            }
            tau = lo; cge = done ? 256 : (clo >= 0 ? clo : count_ge16(v, tau, nc));
            const unsigned tau_hi = tau << 16;
            if (cge == 256) {
                if (0 < nc) { REP8(emit_simple, 0, v, tau, tau_hi, wlo, whi); }
                if (1 < nc) { REP8(emit_simple, 8, v, tau, tau_hi, wlo, whi); }
                if (2 < nc) { REP8(emit_simple, 16, v, tau, tau_hi, wlo, whi); }
                if (3 < nc) { REP8(emit_simple, 24, v, tau, tau_hi, wlo, whi); }
            } else {
                int need = 256 - ((hi == tau + 1u && chi >= 0) ? chi : ((tau == 0xffffu) ? 0 : count_ge16(v, tau + 1u, nc)));
                if (0 < nc) { REP8(emit_ties, 0, v, tau, tau_hi, need, wlo, whi); }
                if (1 < nc) { REP8(emit_ties, 8, v, tau, tau_hi, need, wlo, whi); }
                if (2 < nc) { REP8(emit_ties, 16, v, tau, tau_hi, need, wlo, whi); }
                if (3 < nc) { REP8(emit_ties, 24, v, tau, tau_hi, need, wlo, whi); }
            }
        }
        u32x2 w2; w2.x = wlo; w2.y = whi;
        *(u32x2*)(MASK + (rowb + t) * 64 + lane) = w2;
    }
    __syncthreads();
}

__device__ __forceinline__ s16x4 vtr(const LAS unsigned char* p) { typedef short v4i16_t __attribute__((ext_vector_type(4))); return __builtin_bit_cast(s16x4, __builtin_amdgcn_ds_read_tr16_b64_v4i16((LAS v4i16_t*)p)); }
__device__ __forceinline__ int crow(int r, int hi) { return (r & 3) + 8 * (r >> 2) + 4 * hi; }
__device__ __forceinline__ unsigned bf16_rne_bits(float f) { return f2bf(f); }
__device__ __forceinline__ void flash_unit_a(LAS unsigned char* lds, const bf16* Q, const bf16* K, const bf16* V, bf16* O, const bf16* Z, int qb, const u64* mask, float slope2, float smax  ) {
    constexpr int LD = 512, KBYTES = 8192, BUFB = 16384, FLAGS = 32768;
    const int tid = opaque_tid(), lane = tid & 63, wid = __builtin_amdgcn_readfirstlane(tid >> 6), r32 = lane & 31, hi = lane >> 5;
    const float NEG = -1.0e30f;
    const int nt = 4 * (qb + 1);
    bf16x8 qf[4];
    { const bf16* qp = Q + (size_t)(wid * 32 + r32) * LD + 8 * hi;
#pragma unroll
      for (int ks = 0; ks < 4; ++ks) qf[ks] = *(const bf16x8*)(qp + 16 * ks); }
    u32x4 ka0 = {0u, 0u, 0u, 0u}, ka1 = {0u, 0u, 0u, 0u}, qa = {0u, 0u, 0u, 0u};
    if (hi == 0) {
        const float r0 = slope2 * (float)r32, r1 = slope2 * (float)(r32 + 32);
        const unsigned h0 = bf16_rne_bits(r0), h1 = bf16_rne_bits(r1);
        ka0.x = h0 | (bf16_rne_bits(r0 - __uint_as_float(h0 << 16)) << 16); ka1.x = h1 | (bf16_rne_bits(r1 - __uint_as_float(h1 << 16)) << 16);
        qa.x = 0x3f803f80u; qa.y = 0x3f803f80u; qa.z = 0x00003f80u;
    }
    f32x16 o[2];
#pragma unroll
    for (int d = 0; d < 2; ++d)
#pragma unroll
        for (int r = 0; r < 16; ++r) o[d][r] = 0.f;
    f32x16 negm;
#pragma unroll
    for (int r = 0; r < 16; ++r) negm[r] = 0.f;
    float m_run = 0.f, l_run = 0.f;
    u32x4 kregA, vregA, kregB, vregB; u64 mwA, mwB;
    const bf16* ksrc = K + (size_t)lane * LD + wid * 8;
    const bf16* vsrc = V + (size_t)(16 * (wid & 3) + (lane >> 2)) * LD + (wid >> 2) * 32 + (lane & 3) * 8;
    const int kdst = wid * 1024 + lane * 16, vdst = KBYTES + (wid >> 2) * 4096 + (16 * (wid & 3) + (lane >> 2)) * 64 + (lane & 3) * 16;
    const u64* mrow = mask + (size_t)(wid * 32 + r32) * 64;
    auto loadt = [&](u32x4& kr, u32x4& vr, u64& mwr, int t) { const int tt = t > 0 ? t : 0;
        kr = *(const u32x4*)(ksrc + (size_t)tt * 64 * LD); vr = *(const u32x4*)(vsrc + (size_t)tt * 64 * LD); mwr = mrow[tt]; };
    loadt(kregA, vregA, mwA, nt - 1); loadt(kregB, vregB, mwB, nt - 2); __builtin_amdgcn_sched_barrier(0);
    const int kfb = hi * 1024 + r32 * 16;
    const int vfb = KBYTES + (4 * hi + ((lane & 15) >> 2)) * 64 + ((lane >> 4) & 1) * 32 + (lane & 3) * 8;
    const int qmax_w = qb * 256 + wid * 32 + 31;
    volatile LAS unsigned* flags = (volatile LAS unsigned*)(lds + FLAGS);
    bool wdone = false, have = false;
    auto step = [&](u32x4& kreg, u32x4& vreg, u64& mw, int it) -> bool {
        const int t = nt - 1 - it;
        LAS unsigned char* buf = lds + (it & 1) * BUFB;
        *(LAS u32x4*)(buf + kdst) = kreg; *(LAS u32x4*)(buf + vdst) = vreg;
        if (lane == 0) flags[(it & 1) * 8 + wid] = wdone ? 1u : 0u;
        __syncthreads();
        {
            unsigned all = 1u;
#pragma unroll
            for (int w = 0; w < 8; ++w) all &= flags[(it & 1) * 8 + w];
            if (all) return true;
        }
        const u64 mcur = mw;
        __builtin_amdgcn_sched_barrier(0);
        loadt(kreg, vreg, mw, t - 2);
        __builtin_amdgcn_sched_barrier(0);
        if (!wdone && 64 * t <= qmax_w) {
            {
                const float bt = -slope2 * 64.0f * (float)it;
                const unsigned b0 = bf16_rne_bits(bt); const float rem1 = bt - __uint_as_float(b0 << 16);
                const unsigned b1 = bf16_rne_bits(rem1); const float rem2 = rem1 - __uint_as_float(b1 << 16);
                const unsigned b2 = bf16_rne_bits(rem2);
                if (hi == 0) { ka0.y = b0 | (b1 << 16); ka0.z = b2; ka1.y = ka0.y; ka1.z = b2; }
            }
            f32x16 c0, c1;
            c0 = __builtin_amdgcn_mfma_f32_32x32x16_bf16(__builtin_bit_cast(bf16x8, ka0), __builtin_bit_cast(bf16x8, qa), negm, 0, 0, 0);
            c1 = __builtin_amdgcn_mfma_f32_32x32x16_bf16(__builtin_bit_cast(bf16x8, ka1), __builtin_bit_cast(bf16x8, qa), negm, 0, 0, 0);
#pragma unroll
            for (int ks = 0; ks < 4; ++ks) {
                const bf16x8 a0 = *(const LAS bf16x8*)(buf + kfb + ks * 2048), a1 = *(const LAS bf16x8*)(buf + kfb + ks * 2048 + 512);
                c0 = __builtin_amdgcn_mfma_f32_32x32x16_bf16(a0, qf[ks], c0, 0, 0, 0);
                c1 = __builtin_amdgcn_mfma_f32_32x32x16_bf16(a1, qf[ks], c1, 0, 0, 0);
            }
            const int mlo = (int)((unsigned)mcur >> (4 * hi)), mhi = (int)((unsigned)(mcur >> 32) >> (4 * hi));
#pragma unroll
            for (int r = 0; r < 16; ++r) { const int bpos = (r & 3) + 8 * (r >> 2);
                const unsigned s0 = (unsigned)__builtin_amdgcn_sbfe(mlo, bpos, 1), s1 = (unsigned)__builtin_amdgcn_sbfe(mhi, bpos, 1);
                c0[r] = __uint_as_float((__float_as_uint(c0[r]) & s0) | (__float_as_uint(NEG) & ~s0));
                c1[r] = __uint_as_float((__float_as_uint(c1[r]) & s1) | (__float_as_uint(NEG) & ~s1)); }
            float mx = fmaxf(c0[0], c1[0]);
#pragma unroll
            for (int r = 1; r < 16; ++r) mx = fmaxf(fmaxf(mx, c0[r]), c1[r]);
            mx = max_halves(mx);
            const bool need = (mx > 0.f) || (!have && mx > -1.0e29f);
            if (__any(need)) {
                const float dl = need ? mx : 0.f, f = have ? __builtin_amdgcn_exp2f(-dl) : 1.0f;
                m_run += dl; l_run *= f;
#pragma unroll
                for (int r = 0; r < 16; ++r) { c0[r] -= dl; c1[r] -= dl; negm[r] = -m_run; o[0][r] *= f; o[1][r] *= f; }
            }
            float ps = 0.f;
#pragma unroll
            for (int r = 0; r < 16; ++r) { c0[r] = __builtin_amdgcn_exp2f(c0[r]); c1[r] = __builtin_amdgcn_exp2f(c1[r]); ps += c0[r] + c1[r]; }
            l_run += ps;
            bf16x8 pf[4];
#pragma unroll
            for (int s = 0; s < 4; ++s) { u32x4 w;
#pragma unroll
                for (int e = 0; e < 4; ++e) { const int r = (s & 1) * 8 + 2 * e; w[e] = (s < 2) ? pg8::cvt_pk_bf16(c0[r], c0[r + 1]) : pg8::cvt_pk_bf16(c1[r], c1[r + 1]); }
                pf[s] = __builtin_bit_cast(bf16x8, w); }
#pragma unroll
            for (int d = 0; d < 2; ++d)
#pragma unroll
                for (int s = 0; s < 4; ++s) {
                    const s16x4 lo4 = vtr(buf + vfb + d * 4096 + (16 * s) * 64), hi4 = vtr(buf + vfb + d * 4096 + (16 * s + 8) * 64);
                    const bf16x8 vf = (bf16x8){lo4[0], lo4[1], lo4[2], lo4[3], hi4[0], hi4[1], hi4[2], hi4[3]};
                    o[d] = __builtin_amdgcn_mfma_f32_32x32x16_bf16(vf, pf[s], o[d], 0, 0, 0);
                }
            const float ub = smax + slope2 * 63.0f - slope2 * 64.0f * (float)(it + 1);
            const float lt = sum_halves(l_run);
            have = lt > 0.f;
            wdone = __all(have && (ub - m_run < -40.0f)) != 0;
        }
        return false;
    };
    for (int it = 0; it < nt; it += 2) {
        if (step(kregA, vregA, mwA, it)) break;
        if (step(kregB, vregB, mwB, it + 1)) break;
    }
    const float l_tot = sum_halves(l_run), inv = 1.0f / l_tot;
    bf16* orow = O + (size_t)(wid * 32 + r32) * LD; const bf16* zrow = Z + (size_t)(wid * 32 + r32) * LD;
    u32x2 zall[2][4];
#pragma unroll
    for (int d = 0; d < 2; ++d)
#pragma unroll
        for (int rg = 0; rg < 4; ++rg) zall[d][rg] = *(const u32x2*)(zrow + d * 32 + 8 * rg + 4 * hi);
    asm volatile("" ::: "memory");
#pragma unroll
    for (int d = 0; d < 2; ++d)
#pragma unroll
        for (int rg = 0; rg < 4; ++rg) { const int d0 = d * 32 + 8 * rg + 4 * hi;
            const u32x2 zw = zall[d][rg];
            u32x2 ow; ow.x = pk2(o[d][4 * rg] * inv * siluf_(bflo(zw.x)), o[d][4 * rg + 1] * inv * siluf_(bfhi(zw.x))); ow.y = pk2(o[d][4 * rg + 2] * inv * siluf_(bflo(zw.y)), o[d][4 * rg + 3] * inv * siluf_(bfhi(zw.y)));
            *(u32x2*)(orow + d0) = ow; }
    __syncthreads();
}
__device__ __forceinline__ void flash_unit_c(LAS unsigned char* lds, const bf16* Q, const bf16* K, const bf16* V, bf16* O, const bf16* Z, int qb, const u64* mask, float slope2, float smax  ) {
    constexpr int LD = 512, KBYTES = 8192, TILEB = 16384, BUFB = 32768, MERGE = 65536, FLAGS = 65536 + 36864;
    const int tid = opaque_tid(), lane = tid & 63, wid = __builtin_amdgcn_readfirstlane(tid >> 6), r32 = lane & 31, hi = lane >> 5;
    const float NEG = -1.0e30f;
    const int nt = 2 * (qb + 1);
    const int grp = wid >> 2, wq = wid & 3;
    bf16x8 qf[4];
    { const bf16* qp = Q + (size_t)(wq * 32 + r32) * LD + 8 * hi;
#pragma unroll
      for (int ks = 0; ks < 4; ++ks) qf[ks] = *(const bf16x8*)(qp + 16 * ks); }
    u32x4 ka0 = {0u, 0u, 0u, 0u}, ka1 = {0u, 0u, 0u, 0u}, qa = {0u, 0u, 0u, 0u};
    if (hi == 0) {
        const float r0 = slope2 * (float)r32, r1 = slope2 * (float)(r32 + 32);
        const unsigned h0 = bf16_rne_bits(r0), h1 = bf16_rne_bits(r1);
        ka0.x = h0 | (bf16_rne_bits(r0 - __uint_as_float(h0 << 16)) << 16); ka1.x = h1 | (bf16_rne_bits(r1 - __uint_as_float(h1 << 16)) << 16);
        qa.x = 0x3f803f80u; qa.y = 0x3f803f80u; qa.z = 0x00003f80u;
    }
    f32x16 o[2];
#pragma unroll
    for (int d = 0; d < 2; ++d)
#pragma unroll
        for (int r = 0; r < 16; ++r) o[d][r] = 0.f;
    f32x16 negm;
#pragma unroll
    for (int r = 0; r < 16; ++r) negm[r] = 0.f;
    float m_run = 0.f, l_run = 0.f;
    u32x4 kregA[2], vregA[2], kregB[2], vregB[2]; u64 mwA, mwB;
    const bf16* ksrc = K + (size_t)lane * LD + wid * 8;
    const bf16* vsrc = V + (size_t)(16 * (wid & 3) + (lane >> 2)) * LD + (wid >> 2) * 32 + (lane & 3) * 8;
    const int kdst = wid * 1024 + lane * 16, vdst = KBYTES + (wid >> 2) * 4096 + (16 * (wid & 3) + (lane >> 2)) * 64 + (lane & 3) * 16;
    const u64* mrow = mask + (size_t)(wq * 32 + r32) * 64;
    auto loadt = [&](u32x4 (&kr)[2], u32x4 (&vr)[2], u64& mwr, int it) {
#pragma unroll
        for (int j = 0; j < 2; ++j) { int t = nt - 1 - 2 * it - j; t = t > 0 ? t : 0; kr[j] = *(const u32x4*)(ksrc + (size_t)t * 64 * LD); vr[j] = *(const u32x4*)(vsrc + (size_t)t * 64 * LD); }
        int tm = nt - 1 - 2 * it - grp; tm = tm > 0 ? tm : 0; mwr = mrow[tm]; };
    loadt(kregA, vregA, mwA, 0); loadt(kregB, vregB, mwB, 1); __builtin_amdgcn_sched_barrier(0);
    const int kfb = hi * 1024 + r32 * 16;
    const int vfb = KBYTES + (4 * hi + ((lane & 15) >> 2)) * 64 + ((lane >> 4) & 1) * 32 + (lane & 3) * 8;
    const int qmax_w = qb * 128 + wq * 32 + 31;
    volatile LAS unsigned* flags = (volatile LAS unsigned*)(lds + FLAGS);
    bool wdone = false, have = false;
    auto step = [&](u32x4 (&kreg)[2], u32x4 (&vreg)[2], u64& mw, int it) -> bool {
        const int ti = 2 * it + grp, t = nt - 1 - ti;
        LAS unsigned char* sbuf = lds + (it & 1) * BUFB;
        *(LAS u32x4*)(sbuf + kdst) = kreg[0]; *(LAS u32x4*)(sbuf + vdst) = vreg[0]; *(LAS u32x4*)(sbuf + TILEB + kdst) = kreg[1]; *(LAS u32x4*)(sbuf + TILEB + vdst) = vreg[1];
        const LAS unsigned char* buf = sbuf + grp * TILEB;
        if (lane == 0) flags[(it & 1) * 8 + wid] = wdone ? 1u : 0u;
        __syncthreads();
        {
            unsigned all = 1u;
#pragma unroll
            for (int w = 0; w < 8; ++w) all &= flags[(it & 1) * 8 + w];
            if (all) return true;
        }
        const u64 mcur = mw;
        __builtin_amdgcn_sched_barrier(0);
        loadt(kreg, vreg, mw, it + 2);
        __builtin_amdgcn_sched_barrier(0);
        if (!wdone && 64 * t <= qmax_w) {
            {
                const float bt = -slope2 * 64.0f * (float)ti;
                const unsigned b0 = bf16_rne_bits(bt); const float rem1 = bt - __uint_as_float(b0 << 16);
                const unsigned b1 = bf16_rne_bits(rem1); const float rem2 = rem1 - __uint_as_float(b1 << 16);
                const unsigned b2 = bf16_rne_bits(rem2);
                if (hi == 0) { ka0.y = b0 | (b1 << 16); ka0.z = b2; ka1.y = ka0.y; ka1.z = b2; }
            }
            f32x16 c0, c1;
            c0 = __builtin_amdgcn_mfma_f32_32x32x16_bf16(__builtin_bit_cast(bf16x8, ka0), __builtin_bit_cast(bf16x8, qa), negm, 0, 0, 0);
            c1 = __builtin_amdgcn_mfma_f32_32x32x16_bf16(__builtin_bit_cast(bf16x8, ka1), __builtin_bit_cast(bf16x8, qa), negm, 0, 0, 0);
#pragma unroll
            for (int ks = 0; ks < 4; ++ks) {
                const bf16x8 a0 = *(const LAS bf16x8*)(buf + kfb + ks * 2048), a1 = *(const LAS bf16x8*)(buf + kfb + ks * 2048 + 512);
                c0 = __builtin_amdgcn_mfma_f32_32x32x16_bf16(a0, qf[ks], c0, 0, 0, 0);
                c1 = __builtin_amdgcn_mfma_f32_32x32x16_bf16(a1, qf[ks], c1, 0, 0, 0);
            }
            const int mlo = (int)((unsigned)mcur >> (4 * hi)), mhi = (int)((unsigned)(mcur >> 32) >> (4 * hi));
#pragma unroll
            for (int r = 0; r < 16; ++r) { const int bpos = (r & 3) + 8 * (r >> 2);
                const unsigned s0 = (unsigned)__builtin_amdgcn_sbfe(mlo, bpos, 1), s1 = (unsigned)__builtin_amdgcn_sbfe(mhi, bpos, 1);
                c0[r] = __uint_as_float((__float_as_uint(c0[r]) & s0) | (__float_as_uint(NEG) & ~s0));
                c1[r] = __uint_as_float((__float_as_uint(c1[r]) & s1) | (__float_as_uint(NEG) & ~s1)); }
            float mx = fmaxf(c0[0], c1[0]);
#pragma unroll
            for (int r = 1; r < 16; ++r) mx = fmaxf(fmaxf(mx, c0[r]), c1[r]);
            mx = max_halves(mx);
            const bool need = (mx > 0.f) || (!have && mx > -1.0e29f);
            if (__any(need)) {
                const float dl = need ? mx : 0.f, f = have ? __builtin_amdgcn_exp2f(-dl) : 1.0f;
                m_run += dl; l_run *= f;
#pragma unroll
                for (int r = 0; r < 16; ++r) { c0[r] -= dl; c1[r] -= dl; negm[r] = -m_run; o[0][r] *= f; o[1][r] *= f; }
            }
            float ps = 0.f;
#pragma unroll
            for (int r = 0; r < 16; ++r) { c0[r] = __builtin_amdgcn_exp2f(c0[r]); c1[r] = __builtin_amdgcn_exp2f(c1[r]); ps += c0[r] + c1[r]; }
            l_run += ps;
            bf16x8 pf[4];
#pragma unroll
            for (int s = 0; s < 4; ++s) { u32x4 w;
#pragma unroll
                for (int e = 0; e < 4; ++e) { const int r = (s & 1) * 8 + 2 * e; w[e] = (s < 2) ? pg8::cvt_pk_bf16(c0[r], c0[r + 1]) : pg8::cvt_pk_bf16(c1[r], c1[r + 1]); }
                pf[s] = __builtin_bit_cast(bf16x8, w); }
#pragma unroll
            for (int d = 0; d < 2; ++d)
#pragma unroll
                for (int s = 0; s < 4; ++s) {
                    const s16x4 lo4 = vtr(buf + vfb + d * 4096 + (16 * s) * 64), hi4 = vtr(buf + vfb + d * 4096 + (16 * s + 8) * 64);
                    const bf16x8 vf = (bf16x8){lo4[0], lo4[1], lo4[2], lo4[3], hi4[0], hi4[1], hi4[2], hi4[3]};
                    o[d] = __builtin_amdgcn_mfma_f32_32x32x16_bf16(vf, pf[s], o[d], 0, 0, 0);
                }
            const float ub = smax + slope2 * 63.0f - slope2 * 64.0f * (float)(ti + 2);
            const float lt = sum_halves(l_run);
            have = lt > 0.f;
            wdone = __all(have && (ub - m_run < -40.0f)) != 0;
        }
        return false;
    };
    for (int it = 0; it < nt / 2; it += 2) {
        if (step(kregA, vregA, mwA, it)) break;
        if (it + 1 < nt / 2) { if (step(kregB, vregB, mwB, it + 1)) break; }
    }
    __syncthreads();
    { LAS float* mg = (LAS float*)(lds + MERGE) + (wq * 64 + lane) * 36;
      if (grp == 1) { mg[0] = m_run; mg[1] = l_run;
#pragma unroll
          for (int r = 0; r < 16; ++r) { mg[2 + r] = o[0][r]; mg[18 + r] = o[1][r]; } }
      __syncthreads();
      if (grp == 0) {
          const float mB = mg[0], lB = mg[1];
          const float ltA = sum_halves(l_run), ltB = sum_halves(lB);
          const float mm = (ltA > 0.f && ltB > 0.f) ? fmaxf(m_run, mB) : (ltA > 0.f ? m_run : mB);
          const float fA = ltA > 0.f ? __builtin_amdgcn_exp2f(m_run - mm) : 0.f, fB = ltB > 0.f ? __builtin_amdgcn_exp2f(mB - mm) : 0.f;
          l_run = l_run * fA + lB * fB;
#pragma unroll
          for (int r = 0; r < 16; ++r) { o[0][r] = o[0][r] * fA + mg[2 + r] * fB; o[1][r] = o[1][r] * fA + mg[18 + r] * fB; } } }
    if (grp == 0) {
    const float l_tot = sum_halves(l_run), inv = 1.0f / l_tot;
    bf16* orow = O + (size_t)(wq * 32 + r32) * LD; const bf16* zrow = Z + (size_t)(wq * 32 + r32) * LD;
    u32x2 zall[2][4];
#pragma unroll
    for (int d = 0; d < 2; ++d)
#pragma unroll
        for (int rg = 0; rg < 4; ++rg) zall[d][rg] = *(const u32x2*)(zrow + d * 32 + 8 * rg + 4 * hi);
    asm volatile("" ::: "memory");
#pragma unroll
    for (int d = 0; d < 2; ++d)
#pragma unroll
        for (int rg = 0; rg < 4; ++rg) { const int d0 = d * 32 + 8 * rg + 4 * hi;
            const u32x2 zw = zall[d][rg];
            u32x2 ow; ow.x = pk2(o[d][4 * rg] * inv * siluf_(bflo(zw.x)), o[d][4 * rg + 1] * inv * siluf_(bfhi(zw.x))); ow.y = pk2(o[d][4 * rg + 2] * inv * siluf_(bflo(zw.y)), o[d][4 * rg + 3] * inv * siluf_(bfhi(zw.y)));
            *(u32x2*)(orow + d0) = ow; }
    }
    __syncthreads();
}

__device__ __forceinline__ void flash_unit_m(LAS unsigned char* lds, const bf16* Q, const bf16* K, const bf16* V, bf16* O, const bf16* Z, const float* gq) {
    constexpr int D = 128, KS = 8, DB = 4, KBYTES = D * 128, BUFB = 2 * KBYTES, LDQ = 512, LDKV = 1024;
    const int tid = opaque_tid(), lane = tid & 63, wid = __builtin_amdgcn_readfirstlane(tid >> 6), r32 = lane & 31, hi = lane >> 5;
    {
        u32x4 kreg[4][2], vreg[4][2];
        const bf16* ksrc = K + (size_t)lane * LDKV + wid * 8;
        const bf16* vsrc = V + (size_t)(16 * (wid & 3) + (lane >> 2)) * LDKV + (wid >> 2) * 32 + (lane & 3) * 8;
#pragma unroll
        for (int t = 0; t < 4; ++t)
#pragma unroll
            for (int i = 0; i < 2; ++i) { kreg[t][i] = *(const u32x4*)(ksrc + (size_t)t * 64 * LDKV + i * 64); vreg[t][i] = *(const u32x4*)(vsrc + (size_t)t * 64 * LDKV + i * 64); }
        const int kdst = wid * 1024 + lane * 16, vdst = KBYTES + (wid >> 2) * 4096 + (16 * (wid & 3) + (lane >> 2)) * 64 + (lane & 3) * 16;
#pragma unroll
        for (int t = 0; t < 4; ++t)
#pragma unroll
            for (int i = 0; i < 2; ++i) { *(LAS u32x4*)(lds + t * BUFB + kdst + i * 8192) = kreg[t][i]; *(LAS u32x4*)(lds + t * BUFB + vdst + i * 8192) = vreg[t][i]; }
    }
    bf16x8 qf[KS];
    {
        const bf16* qp = Q + (size_t)(wid * 32 + r32) * LDQ + 8 * hi; u32x4 raw[KS]; float ss = 0.f;
#pragma unroll
        for (int ks = 0; ks < KS; ++ks) { raw[ks] = *(const u32x4*)(qp + 16 * ks);
#pragma unroll
            for (int e = 0; e < 4; ++e) { const float a = bflo(raw[ks][e]), b = bfhi(raw[ks][e]); ss += a * a + b * b; } }
        ss = sum_halves(ss);
        const float r = 0.08838834764831845f * LOG2E / sqrtf(ss * (1.0f / 128.0f) + RMS_EPS);
#pragma unroll
        for (int ks = 0; ks < KS; ++ks) { const f32x4 g0 = *(const f32x4*)(gq + 16 * ks + 8 * hi), g1 = *(const f32x4*)(gq + 16 * ks + 8 * hi + 4); u32x4 w;
            w.x = pg8::cvt_pk_bf16(bflo(raw[ks].x) * r * g0.x, bfhi(raw[ks].x) * r * g0.y); w.y = pg8::cvt_pk_bf16(bflo(raw[ks].y) * r * g0.z, bfhi(raw[ks].y) * r * g0.w);
            w.z = pg8::cvt_pk_bf16(bflo(raw[ks].z) * r * g1.x, bfhi(raw[ks].z) * r * g1.y); w.w = pg8::cvt_pk_bf16(bflo(raw[ks].w) * r * g1.z, bfhi(raw[ks].w) * r * g1.w);
            qf[ks] = __builtin_bit_cast(bf16x8, w); }
    }
    f32x16 o[DB];
#pragma unroll
    for (int d = 0; d < DB; ++d)
#pragma unroll
        for (int r = 0; r < 16; ++r) o[d][r] = 0.f;
    float m_run = -1.0e30f, l_run = 0.f;
    const int kfb = hi * 1024 + r32 * 16;
    const int vfb = KBYTES + (4 * hi + ((lane & 15) >> 2)) * 64 + ((lane >> 4) & 1) * 32 + (lane & 3) * 8;
    __syncthreads();
#pragma unroll 1
    for (int t = 0; t < 4; ++t) {
        const LAS unsigned char* buf = lds + t * BUFB;
        f32x16 c0, c1;
#pragma unroll
        for (int r = 0; r < 16; ++r) { c0[r] = 0.f; c1[r] = 0.f; }
#pragma unroll
        for (int ks = 0; ks < KS; ++ks) {
            const bf16x8 a0 = *(const LAS bf16x8*)(buf + kfb + ks * 2048), a1 = *(const LAS bf16x8*)(buf + kfb + ks * 2048 + 512);
            c0 = __builtin_amdgcn_mfma_f32_32x32x16_bf16(a0, qf[ks], c0, 0, 0, 0);
            c1 = __builtin_amdgcn_mfma_f32_32x32x16_bf16(a1, qf[ks], c1, 0, 0, 0);
        }
        float mx = fmaxf(c0[0], c1[0]);
#pragma unroll
        for (int r = 1; r < 16; ++r) mx = fmaxf(fmaxf(mx, c0[r]), c1[r]);
        mx = max_halves(mx);
        const float m_new = fmaxf(m_run, mx), alpha = __builtin_amdgcn_exp2f(m_run - m_new);
        m_run = m_new;
        float ps = 0.f;
#pragma unroll
        for (int r = 0; r < 16; ++r) { c0[r] = __builtin_amdgcn_exp2f(c0[r] - m_new); c1[r] = __builtin_amdgcn_exp2f(c1[r] - m_new); ps += c0[r] + c1[r]; }
        l_run = l_run * alpha + ps;
#pragma unroll
        for (int d = 0; d < DB; ++d)
#pragma unroll
            for (int r = 0; r < 16; ++r) o[d][r] *= alpha;
        bf16x8 pf[4];
#pragma unroll
        for (int s = 0; s < 4; ++s) { u32x4 w;
#pragma unroll
            for (int e = 0; e < 4; ++e) { const int r = (s & 1) * 8 + 2 * e; w[e] = (s < 2) ? pg8::cvt_pk_bf16(c0[r], c0[r + 1]) : pg8::cvt_pk_bf16(c1[r], c1[r + 1]); }
            pf[s] = __builtin_bit_cast(bf16x8, w); }
#pragma unroll
        for (int d = 0; d < DB; ++d)
#pragma unroll
            for (int s = 0; s < 4; ++s) {
                const s16x4 lo4 = vtr(buf + vfb + d * 4096 + (16 * s) * 64), hi4 = vtr(buf + vfb + d * 4096 + (16 * s + 8) * 64);
                const bf16x8 vf = (bf16x8){lo4[0], lo4[1], lo4[2], lo4[3], hi4[0], hi4[1], hi4[2], hi4[3]};
                o[d] = __builtin_amdgcn_mfma_f32_32x32x16_bf16(vf, pf[s], o[d], 0, 0, 0);
            }
    }
    const float inv = 1.0f / sum_halves(l_run);
    bf16* orow = O + (size_t)(wid * 32 + r32) * LDQ; const bf16* zrow = Z + (size_t)(wid * 32 + r32) * LDQ;
    u32x2 zall[DB][4];
#pragma unroll
    for (int d = 0; d < DB; ++d)
#pragma unroll
        for (int rg = 0; rg < 4; ++rg) zall[d][rg] = *(const u32x2*)(zrow + d * 32 + 8 * rg + 4 * hi);
    asm volatile("" ::: "memory");
#pragma unroll
    for (int d = 0; d < DB; ++d)
#pragma unroll
        for (int rg = 0; rg < 4; ++rg) { const int d0 = d * 32 + 8 * rg + 4 * hi;
            const u32x2 zw = zall[d][rg];
            u32x2 ow; ow.x = pk2(o[d][4 * rg] * inv * siluf_(bflo(zw.x)), o[d][4 * rg + 1] * inv * siluf_(bfhi(zw.x))); ow.y = pk2(o[d][4 * rg + 2] * inv * siluf_(bflo(zw.y)), o[d][4 * rg + 3] * inv * siluf_(bfhi(zw.y)));
            *(u32x2*)(orow + d0) = ow; }
    __syncthreads();
}

#define RLX_AGENT __ATOMIC_RELAXED, __HIP_MEMORY_SCOPE_AGENT
constexpr size_t WS_CTL = 45 * MiB, CTL_ZERO_BYTES = 16384;
constexpr int LDS_BARST = 131072 + 8192;
#define XB_TMO      128
#define XB_XCNT(j)  (256  + 64 * (j))
#define XB_XSUB(j)  (1280 + 64 * (j))
#define XB_XGEN(j)  (2304 + 64 * (j))
#define XB_TOP      3328
#define XB_TOPGEN   3392
#define XCD_BAR_WORDS 3456
#define XB_SPIN_CAP (1u << 18)

__device__ __forceinline__ unsigned xb_ld(unsigned* p)              { return __hip_atomic_load(p, __ATOMIC_RELAXED, __HIP_MEMORY_SCOPE_AGENT); }
__device__ __forceinline__ unsigned xb_add(unsigned* p, unsigned v) { return __hip_atomic_fetch_add(p, v, __ATOMIC_RELAXED, __HIP_MEMORY_SCOPE_AGENT); }
__device__ __forceinline__ unsigned xb_xcc_id() { return (unsigned)__builtin_amdgcn_s_getreg((3 << 11) | 20) & 0xFu; }
#define XB_SPIN(cond, bar) do { unsigned _sp = 0; while (cond) { __builtin_amdgcn_s_sleep(1); \
    if ((++_sp & 255u) == 0u) { if (xb_ld(&(bar)[XB_TMO])) break; if (_sp > XB_SPIN_CAP) { atomicAdd(&(bar)[XB_TMO], 1u); break; } } } } while (0)

struct XcdBarrier {
    unsigned* bar; unsigned x;
    volatile LAS unsigned* st;
};
__device__ __forceinline__ XcdBarrier xcd_barrier_post(unsigned* bar, volatile LAS unsigned* st) {
    XcdBarrier b; b.bar = bar; b.x = xb_xcc_id(); b.st = st;
    if (threadIdx.x == 0) (void)xb_add(&bar[XB_XCNT(b.x)], 1u);
    return b;
}
__device__ __forceinline__ void xcd_barrier_complete(unsigned* bar, unsigned x, unsigned& nloc, unsigned& nx) {
    const unsigned G = gridDim.x * gridDim.y * gridDim.z;
    unsigned sum, cnt, mine, sp = 0u;
    for (;;) {
        sum = 0u; cnt = 0u; mine = 0u;
#pragma unroll
        for (unsigned j = 0; j < 16; ++j) { const unsigned c = xb_ld(&bar[XB_XCNT(j)]); sum += c; cnt += (c > 0u) ? 1u : 0u; mine = (j == x) ? c : mine; }
        if (sum == G) break;
        __builtin_amdgcn_s_sleep(1);
        if ((++sp & 255u) == 0u) { if (xb_ld(&bar[XB_TMO])) break; if (sp > XB_SPIN_CAP) { atomicAdd(&bar[XB_TMO], 1u); break; } }
    }
    nloc = mine > 0u ? mine : 1u; nx = cnt > 0u ? cnt : 1u;
}

__device__ __forceinline__ void xcd_barrier(const XcdBarrier& b) {
    asm volatile("s_waitcnt vmcnt(0)" ::: "memory");
    __syncthreads();
    if (threadIdx.x == 0) {
        unsigned* bar = b.bar;
        __builtin_amdgcn_s_waitcnt(0);
        unsigned nloc = b.st[0], nx = b.st[1];
        if (nloc == 0u) { xcd_barrier_complete(bar, b.x, nloc, nx); b.st[0] = nloc; b.st[1] = nx; }
        const unsigned old = xb_add(&bar[XB_XSUB(b.x)], 1u);
        const unsigned gen = old / nloc;
        if (old + 1u == (gen + 1u) * nloc) {
            __builtin_amdgcn_fence(__ATOMIC_RELEASE, "agent");
            asm volatile("s_waitcnt vmcnt(0)" ::: "memory");
            const unsigned og = xb_add(&bar[XB_TOP], 1u);
            const unsigned tg = og / nx;
            if (og + 1u == (tg + 1u) * nx) xb_add(&bar[XB_TOPGEN], 1u);
            else XB_SPIN(xb_ld(&bar[XB_TOPGEN]) == tg, bar);
            __builtin_amdgcn_fence(__ATOMIC_ACQUIRE, "agent");
            xb_add(&bar[XB_XGEN(b.x)], 1u);
            asm volatile("s_waitcnt vmcnt(0)" ::: "memory");
        } else {
            XB_SPIN(xb_ld(&bar[XB_XGEN(b.x)]) == gen, bar);
            __builtin_amdgcn_fence(__ATOMIC_ACQUIRE, "agent");
            asm volatile("s_waitcnt vmcnt(0)" ::: "memory");
        }
    }
    __syncthreads();
}

__device__ __forceinline__ void phase1(const Params& p, LAS unsigned char* lds, int G) {
    unsigned char* ws = p.ws; const int c = (int)blockIdx.x;
    pg8::Gemm g{(const bf16*)(ws + WS_XB), (const bf16*)(ws + WS_WIN), T, NIN, DM, ((long)WS_MEMB - (long)WS_XB) / 2, ((long)WS_WMKV - (long)WS_WIN) / 2, 0};
    pg8::StaticOrder S; S.init(T, NIN, G, c, 1, MT, 1024);
    pg8::EpiProjA E{ws, (bf16*)p.out, (const float*)(ws + WS_RSTDX), p.q_norm_a, p.k_norm_a, (bf16*)(ws + WS_G01), (bf16*)p.out + (size_t)16 * MiB, p.b_gate};
    pg8::gemm_phase<pg8::EpiProjA, pg8::StaticOrder, true, true>(lds, g, S, E);
}
constexpr int QW_TOPK = 3600, QW_ATTN = 3664;
__device__ __forceinline__ unsigned queue_next(unsigned* ctr, LAS unsigned char* lds) {
    volatile LAS unsigned* slot = (volatile LAS unsigned*)(lds + 32768 + 256);
    if (threadIdx.x == 0) *slot = __hip_atomic_fetch_add(ctr, 1u, __ATOMIC_RELAXED, __HIP_MEMORY_SCOPE_AGENT);
    __syncthreads();
    const unsigned u = *slot;
    __syncthreads();
    return u;
}
__device__ __forceinline__ void phase2(const Params& p, LAS unsigned char* lds, int G) {
    unsigned char* ws = p.ws; const int c = (int)blockIdx.x;
    const int gtid = c * NTHR + opaque_tid(), gthreads = G * NTHR;
    headnorm<128>((bf16*)(ws + WS_MKV), 1024, MT, 4, p.k_norm_m, 1.0f, gtid, gthreads);
    conv_branch((const bf16*)p.out, p.conv_w, (bf16*)p.out, gtid, gthreads);
#if TPROBE >= 0
    if (blockIdx.x == 0 && threadIdx.x == 0) ((unsigned long long*)(p.ws + 46 * MiB))[10] = __builtin_amdgcn_s_memrealtime();
#endif
    unsigned* ctr = (unsigned*)(ws + 45 * MiB) + 3600;
    const unsigned nunits = NB * (SEQ / 16);
    for (;;) {
        const unsigned u = queue_next(ctr, lds + 98304);
        if (u >= nunits) break;
        if (!SKIP_TOPK) topk_unit2(lds, (const bf16*)(ws + WS_QI), (const bf16*)(ws + WS_KIWI), (const float*)(ws + WS_KIWI + 2 * MiB), (u64*)(ws + WS_MASK), (int)(u & 3u), 255 - (int)(u >> 2));
    }
}
__device__ __forceinline__ void phase3(const Params& p, LAS unsigned char* lds, int G) {
    unsigned char* ws = p.ws;
    float gq = 0.f, gk = 0.f;
    for (int i = 0; i < 64; ++i) { gq = fmaxf(gq, fabsf(p.q_norm_a[i])); gk = fmaxf(gk, fabsf(p.k_norm_a[i])); }
    const float smax = 64.0f * 0.125f * LOG2E * gq * gk * 1.02f + 0.5f;
    unsigned* ctr = (unsigned*)(ws + 45 * MiB) + QW_ATTN;
    for (;;) {
        const unsigned u = queue_next(ctr, lds);
        if (u >= 864u) break;
        unsigned ur = u;
        if (u >= 352u && u < 608u) ur = u + 256u; else if (u >= 608u) ur = u - 256u;
        if (ur < 96u) {
            const int h = 7 - (int)(ur >> 5), qb = 31 - (int)((ur & 31u) >> 2), b = (int)(ur & 3u);
            const float slope2 = exp2f(-(float)(h + 1)) * LOG2E;
            const size_t row0 = (size_t)b * SEQ + qb * 128;
            bf16* q = (bf16*)(ws + WS_QA) + row0 * 512 + h * 64;
            if (!SKIP_FA) flash_unit_c(lds, q, (const bf16*)(ws + WS_KA) + (size_t)b * SEQ * 512 + h * 64, (const bf16*)(ws + WS_VA) + (size_t)b * SEQ * 512 + h * 64,
                                       q, (const bf16*)(ws + WS_ZA) + row0 * 512 + h * 64, qb, (const u64*)(ws + WS_MASK) + row0 * 64, slope2, smax);
        } else if (ur < 608u) {
            const unsigned uu = ur - 96u;
            const int h = 7 - (int)(uu >> 6), qb = 15 - (int)((uu & 63u) >> 2), b = (int)(uu & 3u);
            if (!(h >= 5 && qb >= 12)) {
            const float slope2 = exp2f(-(float)(h + 1)) * LOG2E;
            const size_t row0 = (size_t)b * SEQ + qb * 256;
            bf16* q = (bf16*)(ws + WS_QA) + row0 * 512 + h * 64;
            if (!SKIP_FA) flash_unit_a(lds, q, (const bf16*)(ws + WS_KA) + (size_t)b * SEQ * 512 + h * 64, (const bf16*)(ws + WS_VA) + (size_t)b * SEQ * 512 + h * 64,
                                       q, (const bf16*)(ws + WS_ZA) + row0 * 512 + h * 64, qb, (const u64*)(ws + WS_MASK) + row0 * 64, slope2, smax);
            }
        } else {
            const int v = (int)ur - 608, b2 = v >> 6, hm = (v >> 4) & 3, qb = v & 15; const size_t row0 = (size_t)b2 * SEQ + qb * 256;
            bf16* q = (bf16*)(ws + WS_QM) + row0 * 512 + hm * 128;
            const bf16* kv = (const bf16*)(ws + WS_MKV) + (size_t)b2 * MEML * 1024 + hm * 128;
            if (!SKIP_FM) flash_unit_m(lds, q, kv, kv + 512, q, (const bf16*)(ws + WS_ZM) + row0 * 512 + hm * 128, p.q_norm_m);
        }
    }
}
__device__ __forceinline__ void phase4(const Params&, LAS unsigned char*, int) {}
__device__ __forceinline__ void phase5(const Params& p, LAS unsigned char* lds, int G) {
    unsigned char* ws = p.ws; const int c = (int)blockIdx.x;
    const long sA = (long)(WS_QM - WS_QA) / 2;
    pg8::Gemm g{(const bf16*)(ws + WS_QA), (const bf16*)(ws + WS_WOA), T, 1024, 512, sA, (long)(WS_WOM - WS_WOA) / 2, ((const char*)p.out - (const char*)(ws + WS_QA)) / 2 - 2 * sA};
    pg8::StaticOrder S; S.init(T, 1024, G, c, 3);
    pg8::EpiMerge E{(const bf16*)(ws + WS_G01), (const bf16*)p.out + (size_t)16 * MiB, (bf16*)(ws + WS_MERGED)};
    pg8::gemm_phase<pg8::EpiMerge, pg8::StaticOrder, true, true>(lds, g, S, E);
}
__device__ __forceinline__ void phase6(const Params& p, LAS unsigned char* lds, int G) {
    unsigned char* ws = p.ws; const int c = (int)blockIdx.x;
    pg8::Gemm g{(const bf16*)(ws + WS_MERGED), (const bf16*)(ws + WS_WO), T, 1024, DM, 0, 0, 0};
    pg8::StaticOrder S; S.init(T, 1024, G, c);
    pg8::EpiResF32 E{p.x, p.out, 1024};
    pg8::gemm_phase<pg8::EpiResF32, pg8::StaticOrder, false, true>(lds, g, S, E);
}

template <int PH> __device__ __forceinline__ void run_phase(const Params& p, LAS unsigned char* lds, int G) {
    if (PH == 0) { const int bx = blockIdx.x; const int vcu = (G % 8 == 0) ? (bx % 8) * (G / 8) + bx / 8 : bx; phase0(p, lds, vcu, G); }
    if (PH == 1) phase1(p, lds, G);
    if (PH == 2) phase2(p, lds, G);
    if (PH == 3) phase3(p, lds, G);
    if (PH == 4) phase4(p, lds, G);
    if (PH == 5) phase5(p, lds, G);
    if (PH == 6) phase6(p, lds, G);
}

template <int PH> __global__ void __launch_bounds__(NTHR, 2) phase_kernel(Params p) {
    extern __shared__ __attribute__((aligned(16))) unsigned char lds_raw[];
    run_phase<PH>(p, (LAS unsigned char*)lds_raw, (int)gridDim.x);
}
#if FUSED
__global__ void __launch_bounds__(NTHR, 2) mega_kernel(Params p) {
    extern __shared__ __attribute__((aligned(16))) unsigned char lds_raw[];
    cg::grid_group grid = cg::this_grid();
    LAS unsigned char* lds = (LAS unsigned char*)lds_raw; const int G = (int)gridDim.x;
    if (p.ws == nullptr) grid.sync();
    volatile LAS unsigned* bst = (volatile LAS unsigned*)(lds + LDS_BARST);
    if (threadIdx.x < 2) bst[threadIdx.x] = 0u;
    __syncthreads();
    XcdBarrier bar = xcd_barrier_post((unsigned*)(p.ws + WS_CTL), bst);
#define GSYNC() xcd_barrier(bar)
#if TPROBE >= 0
    unsigned long long* ts = (unsigned long long*)(p.ws + 46 * MiB);
#define STAMP(k) do { if (blockIdx.x == 0 && threadIdx.x == 0) ts[k] = __builtin_amdgcn_s_memrealtime(); } while (0)
    if (blockIdx.x == 0 && threadIdx.x == 0) { ts[12] = 0; ts[13] = 0; ts[14] = 0; ts[15] = ~0ull; }
    GSYNC();
#else
#define STAMP(k) do {} while (0)
#endif
    STAMP(0);
    run_phase<0>(p, lds, G); GSYNC(); STAMP(1);
    run_phase<1>(p, lds, G); GSYNC(); STAMP(2);
#if TPROBE >= 0
    unsigned long long tb0 = __builtin_amdgcn_s_memrealtime();
    run_phase<2>(p, lds, G);
    if (threadIdx.x == 0) { const unsigned long long dt = __builtin_amdgcn_s_memrealtime() - tb0; atomicMax(&ts[14], dt); atomicMin(&ts[15], dt); }
    GSYNC(); STAMP(3);
#else
    run_phase<2>(p, lds, G); GSYNC(); STAMP(3);
#endif
    run_phase<3>(p, lds, G); GSYNC(); STAMP(4);
    STAMP(5);
    run_phase<5>(p, lds, G); GSYNC(); STAMP(6);
    run_phase<6>(p, lds, G);
#if TPROBE >= 0
    GSYNC(); STAMP(7);
    GSYNC(); STAMP(8);
    GSYNC();
    {
        float us;
        if (TPROBE <= 6) us = (float)(ts[TPROBE + 1] - ts[TPROBE]) * 0.01f;
        else if (TPROBE == 7) us = (float)(ts[7] - ts[0]) * 0.01f * 0.1f;
        else if (TPROBE == 8) us = 100.f;
        else if (TPROBE == 14) us = (float)ts[14] * 0.01f;
        else if (TPROBE == 15) us = (float)ts[15] * 0.01f;
        else if (TPROBE == 12) us = (float)ts[12] * 0.01f;
        else if (TPROBE == 13) us = (float)ts[13] * 0.01f;
        else if (TPROBE == 10) us = (float)(ts[10] - ts[2]) * 0.01f;
        else us = (float)(ts[8] - ts[7]) * 0.01f * 10.f;
        const float a = sqrtf(us * 1e-5f);
        for (long i = (long)blockIdx.x * NTHR + threadIdx.x; i < (long)T * DM; i += (long)G * NTHR) p.out[i] += (i & 1) ? a : -a;
    }
#endif
}
#endif

template <int PH> static void launch_phase(const Params& p, int grid, hipStream_t stream) {
    static bool attr = false;
    if (!attr) { (void)hipFuncSetAttribute((const void*)phase_kernel<PH>, hipFuncAttributeMaxDynamicSharedMemorySize, LDS_BYTES); attr = true; }
    hipLaunchKernelGGL(phase_kernel<PH>, dim3(grid), dim3(NTHR), LDS_BYTES, stream, p);
}

extern "C" void kernel_launch(void* const* d_in, const int* in_sizes, int n_in, void* d_out, int out_size, void* d_ws, size_t ws_size, hipStream_t stream) {
    static int grid = 0;
    if (grid == 0) {
        int dev = 0, cus = 0;
        if (hipGetDevice(&dev) != hipSuccess || hipDeviceGetAttribute(&cus, hipDeviceAttributeMultiprocessorCount, dev) != hipSuccess) { fprintf(stderr, "kernel_launch: device query failed\n"); grid = -1; return; }
        if (n_in != 16 || out_size != T * DM || ws_size < 256 * MiB) { fprintf(stderr, "kernel_launch: unexpected shapes (n_in %d out %d ws %zu)\n", n_in, out_size, ws_size); grid = -1; return; }
#if FUSED
        int per_cu = 0;
        (void)hipFuncSetAttribute((const void*)mega_kernel, hipFuncAttributeMaxDynamicSharedMemorySize, LDS_BYTES);
        if (hipOccupancyMaxActiveBlocksPerMultiprocessor(&per_cu, (const void*)mega_kernel, NTHR, LDS_BYTES) != hipSuccess || per_cu < 1) { fprintf(stderr, "kernel_launch: occupancy query says %d\n", per_cu); grid = -1; return; }
        (void)hipGetLastError();
#endif
        grid = cus;
    }
    if (grid < 0) return;
    Params p{};
    p.x = (const float*)d_in[0]; p.mem = (const float*)d_in[1]; p.norm_g = (const float*)d_in[2]; p.mem_norm_g = (const float*)d_in[3]; p.w_in = (const float*)d_in[4]; p.b_gate = (const float*)d_in[5];
    p.w_mem_kv = (const float*)d_in[6]; p.q_norm_a = (const float*)d_in[7]; p.k_norm_a = (const float*)d_in[8]; p.q_norm_m = (const float*)d_in[9]; p.k_norm_m = (const float*)d_in[10]; p.conv_w = (const float*)d_in[11];
    p.w_out_a = (const float*)d_in[12]; p.w_out_b = (const float*)d_in[13]; p.w_out_m = (const float*)d_in[14]; p.w_o = (const float*)d_in[15];
    p.out = (float*)d_out; p.ws = (unsigned char*)d_ws;
#if FUSED
    (void)hipMemsetAsync((unsigned char*)d_ws + WS_CTL, 0, CTL_ZERO_BYTES, stream);
    void* args[] = {&p};
    hipError_t e = hipLaunchCooperativeKernel((const void*)mega_kernel, dim3(grid), dim3(NTHR), args, LDS_BYTES, stream);
    if (e != hipSuccess) fprintf(stderr, "cooperative launch failed: %s (grid %d)\n", hipGetErrorString(e), grid);
#else
    launch_phase<0>(p, grid, stream); launch_phase<1>(p, grid, stream); launch_phase<2>(p, grid, stream); launch_phase<3>(p, grid, stream);
    launch_phase<4>(p, grid, stream); launch_phase<5>(p, grid, stream); launch_phase<6>(p, grid, stream);
#endif
}
```

```cpp
#include <hip/hip_runtime.h>
#include <hip/hip_cooperative_groups.h>
#include <cstdio>
#include <cstdint>
namespace cg = cooperative_groups;
__device__ __forceinline__ int opaque_tid() { int t = (int)threadIdx.x; asm volatile("" : "+v"(t)); return t; }

#ifndef FUSED
#define FUSED 1
#endif
#ifndef TPROBE
#define TPROBE -1
#endif
#ifndef SKIP_TOPK
#define SKIP_TOPK 0
#endif
#ifndef SKIP_FA
#define SKIP_FA 0
#endif
#ifndef SKIP_FM
#define SKIP_FM 0
#endif

namespace pg8 {
#define PG8_LAS __attribute__((address_space(3)))
typedef unsigned short bf16_t;
typedef short bf16x8 __attribute__((ext_vector_type(8)));
typedef float f32x4 __attribute__((ext_vector_type(4)));
typedef unsigned u32x4 __attribute__((ext_vector_type(4)));
constexpr int BM = 256, BK = 64, HALF = 128, HTB = HALF * BK * 2  , STAGE_BYTES = 8 * HTB, NXCD = 8, WGM = 8;

__host__ __device__ __forceinline__ int lds_byte(int r, int c) { const int st = (r >> 4) * 2 + (c >> 5), rr = r & 15, cc = c & 31, ob = rr * 64 + cc * 2; return st * 1024 + (ob ^ (((ob >> 9) & 1) << 5)); }
__host__ __device__ __forceinline__ void stage_rc(int b, int& R, int& C) { const int st = b / 1024, sb = b % 1024, swz = sb ^ (((sb >> 9) & 1) << 5); R = (st >> 1) * 16 + swz / 64; C = (st & 1) * 32 + (swz % 64) / 2; }
__host__ __device__ __forceinline__ int perm32(int rho) { const int n = rho >> 4, i = rho & 15; return 8 * (i >> 2) + 4 * n + (i & 3); }

struct Unit { int pm, pn, br; };
struct Gemm { const bf16_t* A; const bf16_t* Bt; int M, N, K; long strideA, strideB, extraA2;
    __device__ __forceinline__ const bf16_t* a(int br) const { return A + (long)br * strideA + (br == 2 ? extraA2 : 0L); }
    __device__ __forceinline__ const bf16_t* b(int br) const { return Bt + (long)br * strideB; } };

__host__ __device__ __forceinline__ void tile_of(int L, int nM, int nN, int& pm, int& pn) {
    const int nwg = nM * nN; int wgid = L; { const int q = nwg / NXCD, r = nwg % NXCD, xcd = wgid % NXCD, off = wgid / NXCD; wgid = (xcd < r ? xcd * (q + 1) : r * (q + 1) + (xcd - r) * q) + off; }
    const int nig = WGM * nN, gid = wgid / nig, fm = gid * WGM, gsz = (nM - fm) < WGM ? (nM - fm) : WGM;
    pm = fm + ((wgid % nig) % gsz); pn = (wgid % nig) / gsz;
}
struct StaticOrder {
    int nM, nN, nwg, G, c, nsub, nM2, nN2;
    __host__ __device__ void init(int M, int N, int G_, int c_, int nsub_ = 1, int M2 = 0, int N2 = 0) { nM = M / BM; nN = N / BM; nwg = nM * nN; G = G_; c = c_; nsub = nsub_; nM2 = M2 / BM; nN2 = N2 / BM; }
    __host__ __device__ bool next(int i, Unit& u) const {
        const int ti = i / nsub; const long L = (long)ti * G + c; if (L >= nwg + nM2 * nN2) return false;
        if (L < nwg) { tile_of((int)L, nM, nN, u.pm, u.pn); u.br = i - ti * nsub; }
        else { tile_of((int)L - nwg, nM2, nN2, u.pm, u.pn); u.br = 1; }
        return true;
    }
    __device__ __forceinline__ void a_ready(const Unit&) const {}
    __device__ __forceinline__ void done(const Unit&) const {}
};

typedef float f32x2_t __attribute__((ext_vector_type(2))); typedef __bf16 bf16x2_t __attribute__((ext_vector_type(2)));
__device__ __forceinline__ unsigned cvt_pk_bf16(float lo, float hi) { f32x2_t v = {lo, hi}; bf16x2_t b = __builtin_convertvector(v, bf16x2_t); return __builtin_bit_cast(unsigned, b); }
__device__ __forceinline__ float bf_lo(unsigned w) { return __uint_as_float(w << 16); }
__device__ __forceinline__ float bf_hi(unsigned w) { return __uint_as_float(w & 0xffff0000u); }


struct EpiProjA {
    static constexpr bool PERM = true, AFTER_DRAIN = false;
    unsigned char* ws; bf16_t* brb; const float* rstd; const float* gq; const float* gk; bf16_t* g01; bf16_t* g2; const float* bgate;
    __device__ __forceinline__ bool keep(const Unit&) const { return false; }
    __device__ __forceinline__ void operator()(f32x4 (&acc)[2][2][4][2], const Unit& u, int wr, int wc, int fr, int fq) const {
        bf16_t* base; int ldc, colt; const int pn = u.pn; const float* rs = rstd;
        if (u.br == 0 && pn >= 23) {
            const int pg = pn - 23; bf16_t* gb; int gld, gct;
            if (pg < 8) { gb = g01; gld = 2048; gct = pg * 256; } else { gb = g2; gld = 1024; gct = (pg - 8) * 256; }
            const int row0g = u.pm * BM + wr * 64 + fr, col0g = gct + wc * 32 + 8 * fq, bcol0 = pg * BM + wc * 32 + 8 * fq;
            f32x4 bv[2][2];
#pragma unroll
            for (int bj = 0; bj < 2; ++bj)
#pragma unroll
                for (int n = 0; n < 2; ++n) bv[bj][n] = *(const f32x4*)(bgate + bcol0 + bj * HALF + 4 * n);
#pragma unroll
            for (int ai = 0; ai < 2; ++ai)
#pragma unroll
                for (int m = 0; m < 4; ++m) { const int row = row0g + ai * HALF + m * 16; bf16_t* rowp = gb + (size_t)row * gld + col0g;
#pragma unroll
                    for (int bj = 0; bj < 2; ++bj) { f32x4 v0 = acc[ai][bj][m][0] + bv[bj][0], v1 = acc[ai][bj][m][1] + bv[bj][1];
#pragma unroll
                        for (int e = 0; e < 4; ++e) { v0[e] = __builtin_amdgcn_rcpf(1.0f + __builtin_amdgcn_exp2f(-1.4426950408889634f * v0[e])); v1[e] = __builtin_amdgcn_rcpf(1.0f + __builtin_amdgcn_exp2f(-1.4426950408889634f * v1[e])); }
                        u32x4 w; w.x = cvt_pk_bf16(v0[0], v0[1]); w.y = cvt_pk_bf16(v0[2], v0[3]); w.z = cvt_pk_bf16(v1[0], v1[1]); w.w = cvt_pk_bf16(v1[2], v1[3]);
                        *(u32x4*)(rowp + bj * HALF) = w; } }
            return; }
        if (u.br == 0 && pn < 4) {
            bf16_t* dst = (bf16_t*)(ws + ((size_t)(80 + 16 * (pn >> 1)) << 20)); const float* gn = (pn < 2) ? gq : gk; const float osc = (pn < 2) ? 0.125f * 1.4426950408889634f : 1.0f;
            f32x4 gv[2][2];
#pragma unroll
            for (int bj = 0; bj < 2; ++bj)
#pragma unroll
                for (int n = 0; n < 2; ++n) gv[bj][n] = *(const f32x4*)(gn + 32 * bj + 8 * fq + 4 * n);
            const int row0n = u.pm * BM + wr * 64 + fr, hcol = ((pn & 1) * 4 + wc) * 64 + 8 * fq;
#pragma unroll
            for (int ai = 0; ai < 2; ++ai)
#pragma unroll
                for (int m = 0; m < 4; ++m) { const int row = row0n + ai * HALF + m * 16; const float sc = 1.0f;
                    f32x4 v[2][2]; float ss = 0.f;
#pragma unroll
                    for (int bj = 0; bj < 2; ++bj)
#pragma unroll
                        for (int n = 0; n < 2; ++n) { v[bj][n] = acc[ai][bj][m][n] * sc; ss += (v[bj][n][0] * v[bj][n][0] + v[bj][n][1] * v[bj][n][1]) + (v[bj][n][2] * v[bj][n][2] + v[bj][n][3] * v[bj][n][3]); }
                    ss += __shfl_xor(ss, 16); ss += __shfl_xor(ss, 32);
                    const float r = osc / sqrtf(ss * (1.0f / 64.0f) + 1e-6f);
#pragma unroll
                    for (int bj = 0; bj < 2; ++bj) { const f32x4 a = v[bj][0] * gv[bj][0] * r, b = v[bj][1] * gv[bj][1] * r;
                        u32x4 w; w.x = cvt_pk_bf16(a[0], a[1]); w.y = cvt_pk_bf16(a[2], a[3]); w.z = cvt_pk_bf16(b[0], b[1]); w.w = cvt_pk_bf16(b[2], b[3]);
                        *(u32x4*)(dst + (size_t)row * 512 + hcol + 32 * bj) = w; } }
            return; }
        if (u.br == 1) { base = (bf16_t*)(ws + ((size_t)53 << 19)); ldc = 1024; colt = pn * 256; rs = rstd + 16384; }
        else if (pn < 10) { base = (bf16_t*)(ws + ((size_t)(80 + 16 * (pn >> 1)) << 20)); ldc = 512; colt = (pn & 1) * 256; }
        else if (pn == 10) {
            bf16_t* kic = (bf16_t*)(ws + ((size_t)37 << 20)); float* wic = (float*)(ws + ((size_t)39 << 20));
            const int row0k = u.pm * BM + wr * 64 + fr;
#pragma unroll
            for (int ai = 0; ai < 2; ++ai)
#pragma unroll
                for (int m = 0; m < 4; ++m) { const int row = row0k + ai * HALF + m * 16; const float sc = 1.0f;
                    const int col = wc * 32 + 8 * fq;
                    const f32x4 v0 = acc[ai][0][m][0] * sc, v1 = acc[ai][0][m][1] * sc;
                    if (col < 64) { u32x4 w; w.x = cvt_pk_bf16(v0[0], v0[1]); w.y = cvt_pk_bf16(v0[2], v0[3]); w.z = cvt_pk_bf16(v1[0], v1[1]); w.w = cvt_pk_bf16(v1[2], v1[3]); *(u32x4*)(kic + ((size_t)((row >> 5) * 4 + (col >> 4)) * 64 + ((col >> 3) & 1) * 32 + (row & 31)) * 8) = w; }
                    else if (col == 64) { const float is = 0.125f * 0.35355339059327373f; *(f32x4*)(wic + (size_t)row * 8) = v0 * is; *(f32x4*)(wic + (size_t)row * 8 + 4) = v1 * is; } }
            return; }
        else if (pn < 19) {
            const int tl = pn - 11; bf16_t* dst = brb + (tl < 4 ? (size_t)0 : (size_t)16384 * 512);
            const int row0b = u.pm * BM + wr * 64 + fr, jc = 128 * (tl & 3) + wc * 32 + 8 * fq;
#pragma unroll
            for (int ai = 0; ai < 2; ++ai)
#pragma unroll
                for (int m = 0; m < 4; ++m) { const int row = row0b + ai * HALF + m * 16; const float sc = 1.0f;
                    f32x4 a0 = acc[ai][0][m][0] * sc, a1 = acc[ai][0][m][1] * sc, b0 = acc[ai][1][m][0] * sc, b1 = acc[ai][1][m][1] * sc;
                    if (tl < 4) {
#pragma unroll
                        for (int e = 0; e < 4; ++e) { b0[e] = b0[e] * __builtin_amdgcn_rcpf(1.0f + __builtin_amdgcn_exp2f(-1.4426950408889634f * b0[e])); b1[e] = b1[e] * __builtin_amdgcn_rcpf(1.0f + __builtin_amdgcn_exp2f(-1.4426950408889634f * b1[e])); } }
                    a0 = a0 * b0; a1 = a1 * b1;
                    u32x4 w; w.x = cvt_pk_bf16(a0[0], a0[1]); w.y = cvt_pk_bf16(a0[2], a0[3]); w.z = cvt_pk_bf16(a1[0], a1[1]); w.w = cvt_pk_bf16(a1[2], a1[3]);
                    *(u32x4*)(dst + (size_t)row * 512 + jc) = w; }
            return; }
        else { base = (bf16_t*)(ws + ((size_t)(160 + 16 * ((pn - 19) >> 1)) << 20)); ldc = 512; colt = ((pn - 19) & 1) * 256; }
        const int row0 = u.pm * BM + wr * 64 + fr, col0 = colt + wc * 32 + 8 * fq;
#pragma unroll
        for (int ai = 0; ai < 2; ++ai)
#pragma unroll
            for (int m = 0; m < 4; ++m) { const int row = row0 + ai * HALF + m * 16; const float sc = 1.0f; bf16_t* rowp = base + (size_t)row * ldc + col0;
#pragma unroll
                for (int bj = 0; bj < 2; ++bj) { const f32x4 v0 = acc[ai][bj][m][0] * sc, v1 = acc[ai][bj][m][1] * sc;
                    u32x4 w; w.x = cvt_pk_bf16(v0[0], v0[1]); w.y = cvt_pk_bf16(v0[2], v0[3]); w.z = cvt_pk_bf16(v1[0], v1[1]); w.w = cvt_pk_bf16(v1[2], v1[3]);
                    *(u32x4*)(rowp + bj * HALF) = w; } }
    }
};
struct EpiScale {
    static constexpr bool PERM = true, AFTER_DRAIN = false;
    bf16_t* O; int ldc; const float* rstd;
    __device__ __forceinline__ bool keep(const Unit&) const { return false; }
    __device__ __forceinline__ void operator()(f32x4 (&acc)[2][2][4][2], const Unit& u, int wr, int wc, int fr, int fq) const {
        const int row0 = u.pm * BM + wr * 64 + fr, col0 = u.pn * BM + wc * 32 + 8 * fq;
#pragma unroll
        for (int ai = 0; ai < 2; ++ai)
#pragma unroll
            for (int m = 0; m < 4; ++m) { const int row = row0 + ai * HALF + m * 16; const float sc = 1.0f; bf16_t* rowp = O + (size_t)row * ldc + col0;
#pragma unroll
                for (int bj = 0; bj < 2; ++bj) { const f32x4 v0 = acc[ai][bj][m][0] * sc, v1 = acc[ai][bj][m][1] * sc;
                    u32x4 w; w.x = cvt_pk_bf16(v0[0], v0[1]); w.y = cvt_pk_bf16(v0[2], v0[3]); w.z = cvt_pk_bf16(v1[0], v1[1]); w.w = cvt_pk_bf16(v1[2], v1[3]);
                    *(u32x4*)(rowp + bj * HALF) = w; } }
    }
};
__device__ __forceinline__ float sigmoidf_(float x) { return __builtin_amdgcn_rcpf(1.0f + __builtin_amdgcn_exp2f(-1.4426950408889634f * x)); }
struct EpiMerge {
    static constexpr bool PERM = true, AFTER_DRAIN = false;
    const bf16_t* g01; const bf16_t* g2; bf16_t* O;
    __device__ __forceinline__ bool keep(const Unit& u) const { return u.br != 2; }
    __device__ __forceinline__ void operator()(f32x4 (&acc)[2][2][4][2], const Unit& u, int wr, int wc, int fr, int fq) const {
        const int row0 = u.pm * BM + wr * 64 + fr, col0 = u.pn * BM + wc * 32 + 8 * fq; const int br = u.br;
        const bf16_t* nb = g01; int nld = 2048; const bf16_t* db = g2; int dld = 1024;
        if (br == 1) { nb = g2; nld = 1024; db = g01 + 1024; dld = 2048; }
        if (br == 2) { nb = g01 + 1024; db = nb; dld = 2048; }
#pragma unroll
        for (int ai = 0; ai < 2; ++ai) {
            u32x4 num[4][2], den[4][2];
#pragma unroll
            for (int m = 0; m < 4; ++m)
#pragma unroll
                for (int bj = 0; bj < 2; ++bj) { const int row = row0 + ai * HALF + m * 16, col = col0 + bj * HALF;
                    num[m][bj] = *(const u32x4*)(nb + (size_t)row * nld + col);
                    den[m][bj] = *(const u32x4*)(db + (size_t)row * dld + col); }
#pragma unroll
            for (int m = 0; m < 4; ++m)
#pragma unroll
                for (int bj = 0; bj < 2; ++bj) { const int row = row0 + ai * HALF + m * 16, col = col0 + bj * HALF;
                    float f[8];
#pragma unroll
                    for (int e = 0; e < 4; ++e) { const unsigned nw = num[m][bj][e], dw = den[m][bj][e];
                        f[2 * e] = (br == 2) ? bf_lo(nw) : bf_lo(nw) * __builtin_amdgcn_rcpf(bf_lo(dw)); f[2 * e + 1] = (br == 2) ? bf_hi(nw) : bf_hi(nw) * __builtin_amdgcn_rcpf(bf_hi(dw)); }
                    f32x4 v0 = acc[ai][bj][m][0], v1 = acc[ai][bj][m][1];
                    v0[0] *= f[0]; v0[1] *= f[1]; v0[2] *= f[2]; v0[3] *= f[3]; v1[0] *= f[4]; v1[1] *= f[5]; v1[2] *= f[6]; v1[3] *= f[7];
                    acc[ai][bj][m][0] = v0; acc[ai][bj][m][1] = v1;
                    if (br == 2) { u32x4 w; w.x = cvt_pk_bf16(v0[0], v0[1]); w.y = cvt_pk_bf16(v0[2], v0[3]); w.z = cvt_pk_bf16(v1[0], v1[1]); w.w = cvt_pk_bf16(v1[2], v1[3]);
                        *(u32x4*)(O + (size_t)row * 1024 + col) = w; } }
            asm volatile("" ::: "memory");
        }
    }
};
struct EpiResF32 {
    static constexpr bool PERM = false, AFTER_DRAIN = false;
    const float* base; float* out; int ldc;
    __device__ __forceinline__ bool keep(const Unit&) const { return false; }
    __device__ __forceinline__ void operator()(f32x4 (&acc)[2][2][4][2], const Unit& u, int wr, int wc, int fr, int fq) const {
        const int row0 = u.pm * BM + wr * 64 + fr, col0 = u.pn * BM + wc * 32 + 4 * fq;
#pragma unroll
        for (int ai = 0; ai < 2; ++ai)
#pragma unroll
            for (int mh = 0; mh < 2; ++mh) {
                f32x4 bs[2][2][2];
#pragma unroll
                for (int mm = 0; mm < 2; ++mm) { const size_t off = (size_t)(row0 + ai * HALF + (2 * mh + mm) * 16) * ldc + col0;
#pragma unroll
                    for (int bj = 0; bj < 2; ++bj)
#pragma unroll
                        for (int n = 0; n < 2; ++n) bs[mm][bj][n] = *(const f32x4*)(base + off + bj * HALF + n * 16); }
                asm volatile("" ::: "memory");
#pragma unroll
                for (int mm = 0; mm < 2; ++mm) { const size_t off = (size_t)(row0 + ai * HALF + (2 * mh + mm) * 16) * ldc + col0;
#pragma unroll
                    for (int bj = 0; bj < 2; ++bj)
#pragma unroll
                        for (int n = 0; n < 2; ++n) *(f32x4*)(out + off + bj * HALF + n * 16) = bs[mm][bj][n] + acc[ai][bj][2 * mh + mm][n]; }
                asm volatile("" ::: "memory");
            }
    }
};

template <class Epi, class Sched, bool ALIGN_EPI = false, bool SP2 = false>
__device__ __forceinline__ void gemm_phase(PG8_LAS unsigned char* lds, const Gemm g, const Sched& S, const Epi& E) {
    const int tid = opaque_tid(), wid = __builtin_amdgcn_readfirstlane(tid >> 6), lane = tid & 63, wr = wid >> 2, wc = wid & 3, fr = lane & 15, fq = lane >> 4;
    const int K = g.K, nt = K / BK;
    unsigned voffA[2], voffB[2];
#pragma unroll
    for (int i = 0; i < 2; ++i) { int R, C; stage_rc(tid * 16 + i * 8192, R, C); const int Rb = Epi::PERM ? ((R & ~31) + perm32(R & 31)) : R;
        voffA[i] = (unsigned)(R * K + C) * 2u; voffB[i] = (unsigned)(Rb * K + C) * 2u; }
    const size_t kstep = (size_t)(BK * 2);
    const size_t hstep = (size_t)HALF * K * 2;
    const size_t tstep = 2 * hstep;
    const unsigned ldsw = (unsigned)wid * 1024u;
    const int aoff = lds_byte(wr * 64 + fr, fq * 8), boff = lds_byte(wc * 32 + fr, fq * 8);
#define PG8_SA(b, h) (((b) * 2 + (h)) * HTB)
#define PG8_SB(b, h) ((4 + (b) * 2 + (h)) * HTB)
#define PG8_STAGE(bufoff, gbase, voff) do { _Pragma("unroll") for (int _i = 0; _i < 2; ++_i) \
        __builtin_amdgcn_global_load_lds((const unsigned*)((const char*)(gbase) + (voff)[_i]), (PG8_LAS unsigned*)(lds + (bufoff) + ldsw + _i * 8192), 16, 0, 0); } while (0)
#define PG8_LDA(dst, b, h) do { _Pragma("unroll") for (int m = 0; m < 4; ++m) _Pragma("unroll") for (int k = 0; k < 2; ++k) dst[m][k] = *(const PG8_LAS bf16x8*)(lds + PG8_SA(b, h) + aoff + m * 2048 + k * 1024); } while (0)
#define PG8_LDB(dst, b, h) do { _Pragma("unroll") for (int n = 0; n < 2; ++n) _Pragma("unroll") for (int k = 0; k < 2; ++k) dst[n][k] = *(const PG8_LAS bf16x8*)(lds + PG8_SB(b, h) + boff + n * 2048 + k * 1024); } while (0)
#define PG8_MMA(ai, bj, At, Bt) do { __builtin_amdgcn_s_setprio(1); _Pragma("unroll") for (int m = 0; m < 4; ++m) _Pragma("unroll") for (int n = 0; n < 2; ++n) _Pragma("unroll") for (int k = 0; k < 2; ++k) \
        acc[ai][bj][m][n] = __builtin_amdgcn_mfma_f32_16x16x32_bf16(Bt[n][k], At[m][k], acc[ai][bj][m][n], 0, 0, 0); __builtin_amdgcn_s_setprio(0); } while (0)
#define PG8_WAIT_V(n) asm volatile("s_waitcnt vmcnt(" #n ")" ::: "memory")
#define PG8_WAIT_L(n) asm volatile("s_waitcnt lgkmcnt(" #n ")" ::: "memory")
#define PG8_BAR __builtin_amdgcn_s_barrier()
#define PG8_SCHED __builtin_amdgcn_sched_barrier(0)
    Unit cur, nxt; int ui = 0;
    if (!S.next(0, cur)) return;
    f32x4 acc[2][2][4][2];
#pragma unroll
    for (int a = 0; a < 2; ++a)
#pragma unroll
        for (int b = 0; b < 2; ++b)
#pragma unroll
            for (int m = 0; m < 4; ++m)
#pragma unroll
                for (int n = 0; n < 2; ++n) acc[a][b][m][n] = (f32x4){0.f, 0.f, 0.f, 0.f};
    bf16x8 At[4][2], B0[2][2], B1[2][2];
    const char* cA = (const char*)g.a(cur.br) + (size_t)cur.pm * tstep; const char* cB = (const char*)g.b(cur.br) + (size_t)cur.pn * tstep;
    S.a_ready(cur);
    if constexpr (SP2) {
        PG8_STAGE(PG8_SB(0, 0), cB, voffB); PG8_STAGE(PG8_SB(0, 1), cB + hstep, voffB); PG8_STAGE(PG8_SA(0, 0), cA, voffA); PG8_STAGE(PG8_SA(0, 1), cA + hstep, voffA);
        if (wr == 1) PG8_BAR;
        PG8_WAIT_V(2); PG8_BAR;
        PG8_STAGE(PG8_SB(1, 0), cB + kstep, voffB); PG8_STAGE(PG8_SA(1, 0), cA + kstep, voffA); PG8_STAGE(PG8_SB(1, 1), cB + hstep + kstep, voffB);
        PG8_WAIT_V(6); PG8_BAR;
    } else {
        PG8_STAGE(PG8_SB(0, 0), cB, voffB); PG8_STAGE(PG8_SA(0, 0), cA, voffA); PG8_STAGE(PG8_SB(0, 1), cB + hstep, voffB); PG8_STAGE(PG8_SA(0, 1), cA + hstep, voffA);
        if (wr == 1) PG8_BAR;
        PG8_WAIT_V(4); PG8_BAR;
        PG8_STAGE(PG8_SB(1, 0), cB + kstep, voffB); PG8_STAGE(PG8_SA(1, 0), cA + kstep, voffA); PG8_STAGE(PG8_SB(1, 1), cB + hstep + kstep, voffB);
        PG8_WAIT_V(6); PG8_BAR;
    }
    for (;;) {
        const bool has_next = S.next(ui + 1, nxt);
        const char* nA = has_next ? (const char*)g.a(nxt.br) + (size_t)nxt.pm * tstep : cA; const char* nB = has_next ? (const char*)g.b(nxt.br) + (size_t)nxt.pn * tstep : cB;
        for (int t = 0; t < nt; t += 2) {
            const bool last = (t == nt - 2);
            const char* a1 = cA + (size_t)(t + 1) * kstep;
            const char* a2 = last ? nA : cA + (size_t)(t + 2) * kstep; const char* b2 = last ? nB : cB + (size_t)(t + 2) * kstep;
            const char* a3 = a2 + kstep; const char* b3 = b2 + kstep;
            if (last && has_next) S.a_ready(nxt);
            if constexpr (SP2) {
            PG8_LDB(B0, 0, 0); PG8_LDB(B1, 0, 1); PG8_SCHED; PG8_LDA(At, 0, 0); PG8_STAGE(PG8_SA(1, 1), a1 + hstep, voffA);
            PG8_WAIT_V(8); PG8_WAIT_L(0); PG8_BAR; PG8_MMA(0, 0, At, B0); PG8_MMA(0, 1, At, B1); PG8_BAR; PG8_SCHED;
            PG8_LDA(At, 0, 1); PG8_STAGE(PG8_SB(0, 0), b2, voffB); PG8_STAGE(PG8_SB(0, 1), b2 + hstep, voffB); PG8_STAGE(PG8_SA(0, 0), a2, voffA);
            PG8_WAIT_V(8); PG8_WAIT_L(0); PG8_BAR; PG8_MMA(1, 0, At, B0); PG8_MMA(1, 1, At, B1); PG8_BAR; PG8_SCHED;
            PG8_LDB(B0, 1, 0); PG8_LDB(B1, 1, 1); PG8_SCHED; PG8_LDA(At, 1, 0); PG8_STAGE(PG8_SA(0, 1), a2 + hstep, voffA);
            PG8_WAIT_V(8); PG8_WAIT_L(0); PG8_BAR; PG8_MMA(0, 0, At, B0); PG8_MMA(0, 1, At, B1); PG8_BAR; PG8_SCHED;
            PG8_LDA(At, 1, 1); PG8_STAGE(PG8_SB(1, 0), b3, voffB); PG8_STAGE(PG8_SB(1, 1), b3 + hstep, voffB); PG8_STAGE(PG8_SA(1, 0), a3, voffA);
            PG8_WAIT_V(8); PG8_WAIT_L(0); PG8_BAR; PG8_MMA(1, 0, At, B0); PG8_MMA(1, 1, At, B1); PG8_BAR; PG8_SCHED;
            } else {
            PG8_LDB(B0, 0, 0); PG8_SCHED; PG8_LDA(At, 0, 0); PG8_STAGE(PG8_SA(1, 1), a1 + hstep, voffA);
            PG8_WAIT_L(8); PG8_BAR; PG8_WAIT_L(0); PG8_MMA(0, 0, At, B0); PG8_BAR; PG8_SCHED;
            PG8_LDB(B1, 0, 1); PG8_STAGE(PG8_SB(0, 0), b2, voffB);
            PG8_BAR; PG8_WAIT_L(0); PG8_MMA(0, 1, At, B1); PG8_BAR;
            PG8_LDA(At, 0, 1); PG8_STAGE(PG8_SA(0, 0), a2, voffA);
            PG8_BAR; PG8_WAIT_L(0); PG8_MMA(1, 0, At, B0); PG8_BAR; PG8_SCHED;
            PG8_STAGE(PG8_SB(0, 1), b2 + hstep, voffB);
            PG8_WAIT_V(6); PG8_BAR; PG8_MMA(1, 1, At, B1); PG8_BAR;
            PG8_LDB(B0, 1, 0); PG8_SCHED; PG8_LDA(At, 1, 0); PG8_STAGE(PG8_SA(0, 1), a2 + hstep, voffA);
            PG8_WAIT_L(8); PG8_BAR; PG8_WAIT_L(0); PG8_MMA(0, 0, At, B0); PG8_BAR; PG8_SCHED;
            PG8_LDB(B1, 1, 1); PG8_STAGE(PG8_SB(1, 0), b3, voffB);
            PG8_BAR; PG8_WAIT_L(0); PG8_MMA(0, 1, At, B1); PG8_BAR;
            PG8_LDA(At, 1, 1); PG8_STAGE(PG8_SA(1, 0), a3, voffA);
            PG8_BAR; PG8_WAIT_L(0); PG8_MMA(1, 0, At, B0); PG8_BAR; PG8_SCHED;
            PG8_STAGE(PG8_SB(1, 1), b3 + hstep, voffB);
            PG8_WAIT_V(6); PG8_BAR; PG8_MMA(1, 1, At, B1); PG8_BAR;
            }
        }
        if constexpr (ALIGN_EPI) { if (wr == 0) PG8_BAR; }
        if constexpr (!Epi::AFTER_DRAIN) { E(acc, cur, wr, wc, fr, fq); S.done(cur); }
        if (!has_next) break;
        if (!E.keep(cur)) {
#pragma unroll
        for (int a = 0; a < 2; ++a)
#pragma unroll
            for (int b = 0; b < 2; ++b)
#pragma unroll
                for (int m = 0; m < 4; ++m)
#pragma unroll
                    for (int n = 0; n < 2; ++n) acc[a][b][m][n] = (f32x4){0.f, 0.f, 0.f, 0.f};
        }
        cur = nxt; cA = nA; cB = nB; ++ui;
        if constexpr (ALIGN_EPI) { if (wr == 1) PG8_BAR; }
    }
    PG8_WAIT_V(0);
    if constexpr (!ALIGN_EPI) { if (wr == 0) PG8_BAR; }
    PG8_BAR;
    if constexpr (Epi::AFTER_DRAIN) { E.fused(acc, cur, wr, wc, fr, fq, lds, wid, lane); S.done(cur); }
#undef PG8_SA
#undef PG8_SB
#undef PG8_STAGE
#undef PG8_LDA
#undef PG8_LDB
#undef PG8_MMA
#undef PG8_WAIT_V
#undef PG8_WAIT_L
#undef PG8_BAR
#undef PG8_SCHED
}
}

#define LAS __attribute__((address_space(3)))
typedef unsigned short bf16;
typedef short bf16x8 __attribute__((ext_vector_type(8)));
typedef short s16x4 __attribute__((ext_vector_type(4)));
typedef float f32x4 __attribute__((ext_vector_type(4)));
typedef float f32x16 __attribute__((ext_vector_type(16)));
typedef unsigned u32x4 __attribute__((ext_vector_type(4)));
typedef unsigned u32x2 __attribute__((ext_vector_type(2)));
typedef unsigned long long u64;

constexpr int NB = 4, SEQ = 4096, DM = 1024, T = NB * SEQ, MEML = 256, MT = NB * MEML;
constexpr int NIN_SRC = 8776, N1A = 5888, N1B = 3072, NIN = N1A + N1B;
constexpr int GAP0 = 2632, GAPLEN = 184;
constexpr float RMS_EPS = 1e-6f, LOG2E = 1.4426950408889634f;
constexpr int NWAVES = 8, NTHR = 512;
constexpr int LDS_BYTES = 147456;

constexpr size_t MiB = (size_t)1 << 20;
constexpr size_t WS_WIN = 0, WS_WMKV = 35 * MiB / 2, WS_WOA = 39 * MiB / 2, WS_WOM = 41 * MiB / 2, WS_WOB = 43 * MiB / 2, WS_WO = 45 * MiB / 2, WS_MEMB = 49 * MiB / 2, WS_MKV = 53 * MiB / 2;
constexpr size_t WS_RSTDX = 57 * MiB / 2, WS_RSTDM = WS_RSTDX + 65536;
constexpr size_t WS_MASK = 29 * MiB, WS_KIWI = 37 * MiB, WS_XB = 48 * MiB;
constexpr size_t WS_QA = 80 * MiB, WS_KA = 96 * MiB, WS_VA = 112 * MiB, WS_ZA = 128 * MiB, WS_QI = 144 * MiB, WS_QM = 160 * MiB, WS_ZM = 176 * MiB, WS_XBR = 240 * MiB;
static_assert(WS_WOB - WS_WOM == WS_WOM - WS_WOA, "uniform stride of the three out-projection weights");
constexpr size_t WS_G01 = 192 * MiB  , WS_MERGED = WS_ZA  ;
static_assert((size_t)NIN * DM * 2 == 35 * MiB / 2, "w_in copy size");

struct Params {
    const float *x, *mem, *norm_g, *mem_norm_g, *w_in, *b_gate, *w_mem_kv, *q_norm_a, *k_norm_a, *q_norm_m, *k_norm_m, *conv_w, *w_out_a, *w_out_b, *w_out_m, *w_o;
    float* out; unsigned char* ws;
};

__device__ __forceinline__ unsigned f2bf(float f) { unsigned u = __builtin_bit_cast(unsigned, f); return (u + 0x7fffu + ((u >> 16) & 1u)) >> 16; }
__device__ __forceinline__ unsigned pk2(float lo, float hi) { return f2bf(lo) | (f2bf(hi) << 16); }
__device__ __forceinline__ float bflo(unsigned w) { return __uint_as_float(w << 16); }
__device__ __forceinline__ float bfhi(unsigned w) { return __uint_as_float(w & 0xffff0000u); }
__device__ __forceinline__ float bf2f(bf16 h) { return __uint_as_float((unsigned)h << 16); }
__device__ __forceinline__ float wave_sum(float v) {
#pragma unroll
    for (int o = 1; o < 64; o <<= 1) v += __shfl_xor(v, o);
    return v;
}
__device__ __forceinline__ float siluf_(float z) { return z * __builtin_amdgcn_rcpf(1.0f + __builtin_amdgcn_exp2f(-LOG2E * z)); }
__device__ __forceinline__ float max_halves(float v) { const auto rr = __builtin_amdgcn_permlane32_swap(__float_as_uint(v), __float_as_uint(v), false, false); return fmaxf(__uint_as_float(rr[0]), __uint_as_float(rr[1])); }
__device__ __forceinline__ float sum_halves(float v) { const auto rr = __builtin_amdgcn_permlane32_swap(__float_as_uint(v), __float_as_uint(v), false, false); return __uint_as_float(rr[0]) + __uint_as_float(rr[1]); }

__device__ __forceinline__ void p0_transpose_item(const float* W, int K, int Nsrc, int Ndst, const float* gain, int gap0, int gaplen, bf16* WT, LAS float* scr, int item, int lane, bool headperm = false) {
    const int nblk = Ndst / 32, kb = item / nblk, nb = item % nblk, k0 = 64 * kb, n0 = 32 * nb;
    int nd = n0 + (lane & 7) * 4; const bool valid = (nd < gap0) || (nd >= gap0 + gaplen);
    if (headperm && nd < 1024) nd = (nd & ~255) + ((nd >> 5) & 3) * 64 + ((nd >> 7) & 1) * 32 + (nd & 31);
    int ns = nd < gap0 ? nd : nd - gaplen;
    if (headperm && nd >= 2816 && nd < 4864) {
        const int tl = (nd - 2816) >> 8, ct = (nd - 2816) & 255, j = 128 * (tl & 3) + (ct & 127), which = ct >> 7;
        ns = (tl < 4 ? (which ? 4168 : 2632) : (which ? 3656 : 3144)) + j; }
    f32x4 v[8]; float gk[8];
#pragma unroll
    for (int i = 0; i < 8; ++i) { const int kk = 8 * i + (lane >> 3); v[i] = (f32x4){0.f, 0.f, 0.f, 0.f}; gk[i] = 1.0f; if (valid) { v[i] = *(const f32x4*)(W + (size_t)(k0 + kk) * Nsrc + ns); if (gain) gk[i] = gain[k0 + kk]; } }
#pragma unroll
    for (int i = 0; i < 8; ++i) v[i] = v[i] * gk[i];
#pragma unroll
    for (int i = 0; i < 8; ++i) { const int kk = 8 * i + (lane >> 3); LAS float* d = scr + kk * 33 + (lane & 7) * 4; d[0] = v[i][0]; d[1] = v[i][1]; d[2] = v[i][2]; d[3] = v[i][3]; }
    asm volatile("s_waitcnt lgkmcnt(0)" ::: "memory");
    const int c = lane & 7;
#pragma unroll
    for (int j = 0; j < 4; ++j) { const int n = (lane >> 3) + 8 * j; const LAS float* sp = scr + (8 * c) * 33 + n;
        u32x4 o; o.x = pk2(sp[0 * 33], sp[1 * 33]); o.y = pk2(sp[2 * 33], sp[3 * 33]); o.z = pk2(sp[4 * 33], sp[5 * 33]); o.w = pk2(sp[6 * 33], sp[7 * 33]);
        *(u32x4*)(WT + (size_t)(n0 + n) * K + k0 + 8 * c) = o; }
    asm volatile("s_waitcnt lgkmcnt(0)" ::: "memory");
}
__device__ __forceinline__ void rows4_to_bf16(const float* xrow, bf16* orow, float* rstd_out, int lane) {
    f32x4 v[4][4]; float s[4];
#pragma unroll
    for (int r = 0; r < 4; ++r)
#pragma unroll
        for (int j = 0; j < 4; ++j) v[r][j] = *((const f32x4*)(xrow + (size_t)r * DM) + lane + 64 * j);
#pragma unroll
    for (int r = 0; r < 4; ++r) { float a = 0.f;
#pragma unroll
        for (int j = 0; j < 4; ++j) a += (v[r][j].x * v[r][j].x + v[r][j].y * v[r][j].y) + (v[r][j].z * v[r][j].z + v[r][j].w * v[r][j].w);
        s[r] = a; }
#pragma unroll
    for (int o = 1; o < 64; o <<= 1) { s[0] += __shfl_xor(s[0], o); s[1] += __shfl_xor(s[1], o); s[2] += __shfl_xor(s[2], o); s[3] += __shfl_xor(s[3], o); }
#pragma unroll
    for (int r = 0; r < 4; ++r) { const float rs = 1.0f / sqrtf(s[r] * (1.0f / DM) + RMS_EPS); u32x2* o8 = (u32x2*)(orow + (size_t)r * DM) + lane;
#pragma unroll
        for (int j = 0; j < 4; ++j) { u32x2 w; w.x = pk2(v[r][j].x * rs, v[r][j].y * rs); w.y = pk2(v[r][j].z * rs, v[r][j].w * rs); o8[64 * j] = w; } }
    (void)rstd_out;
}
__device__ __forceinline__ void phase0(const Params& p, LAS unsigned char* lds, int vcu, int G) {
    const int tid = opaque_tid(), lane = tid & 63, wave = tid >> 6;
    LAS float* scr = (LAS float*)(lds + wave * 16384);
    const int gw = vcu * NWAVES + wave, NGW = G * NWAVES;
    unsigned char* ws = p.ws;
    for (int m4 = gw; m4 < (T + MT) / 4; m4 += NGW) { const int m = 4 * m4;
        if (m < T) rows4_to_bf16(p.x + (size_t)m * DM, (bf16*)(ws + WS_XB) + (size_t)m * DM, (float*)(ws + WS_RSTDX) + m, lane);
        else { const int mm = m - T; rows4_to_bf16(p.mem + (size_t)mm * DM, (bf16*)(ws + WS_MEMB) + (size_t)mm * DM, (float*)(ws + WS_RSTDM) + mm, lane); } }
    constexpr int I_IN = (DM / 64) * (NIN / 32), I_MKV = (DM / 64) * (1024 / 32), I_OX = (512 / 64) * (1024 / 32), I_O = (DM / 64) * (1024 / 32);
    constexpr int NITEMS = I_IN + I_MKV + 3 * I_OX + I_O;
    for (int it = gw; it < NITEMS; it += NGW) {
        int r = it;
        if (r < I_IN) { p0_transpose_item(p.w_in, DM, NIN_SRC, NIN, p.norm_g, GAP0, GAPLEN, (bf16*)(ws + WS_WIN), scr, r, lane, true); continue; } r -= I_IN;
        if (r < I_MKV) { p0_transpose_item(p.w_mem_kv, DM, 1024, 1024, p.mem_norm_g, 1 << 30, 0, (bf16*)(ws + WS_WMKV), scr, r, lane); continue; } r -= I_MKV;
        if (r < I_OX) { p0_transpose_item(p.w_out_a, 512, 1024, 1024, nullptr, 1 << 30, 0, (bf16*)(ws + WS_WOA), scr, r, lane); continue; } r -= I_OX;
        if (r < I_OX) { p0_transpose_item(p.w_out_b, 512, 1024, 1024, nullptr, 1 << 30, 0, (bf16*)(ws + WS_WOB), scr, r, lane); continue; } r -= I_OX;
        if (r < I_OX) { p0_transpose_item(p.w_out_m, 512, 1024, 1024, nullptr, 1 << 30, 0, (bf16*)(ws + WS_WOM), scr, r, lane); continue; } r -= I_OX;
        p0_transpose_item(p.w_o, DM, 1024, 1024, nullptr, 1 << 30, 0, (bf16*)(ws + WS_WO), scr, r, lane);
    }
}

template <int HD>
__device__ __forceinline__ void headnorm(bf16* X, int ld, int R, int NH, const float* gain, float oscale, int gtid, int gthreads) {
    constexpr int TPH = HD / 8;
    const long total = (long)R * NH * TPH;
    for (long i = gtid; i < total; i += gthreads) {
        const int part = (int)(i % TPH); const long rh = i / TPH; const int head = (int)(rh % NH); const long row = rh / NH;
        bf16* ptr = X + row * ld + head * HD + part * 8;
        const u32x4 w = *(const u32x4*)ptr; float f[8];
#pragma unroll
        for (int e = 0; e < 4; ++e) { f[2 * e] = bflo(w[e]); f[2 * e + 1] = bfhi(w[e]); }
        float s = 0.f;
#pragma unroll
        for (int e = 0; e < 8; ++e) s += f[e] * f[e];
#pragma unroll
        for (int o = 1; o < TPH; o <<= 1) s += __shfl_xor(s, o);
        const float r = oscale / sqrtf(s * (1.0f / HD) + RMS_EPS);
        const f32x4 g0 = *(const f32x4*)(gain + part * 8), g1 = *(const f32x4*)(gain + part * 8 + 4);
        u32x4 o; o.x = pk2(f[0] * r * g0.x, f[1] * r * g0.y); o.y = pk2(f[2] * r * g0.z, f[3] * r * g0.w); o.z = pk2(f[4] * r * g1.x, f[5] * r * g1.y); o.w = pk2(f[6] * r * g1.z, f[7] * r * g1.w);
        *(u32x4*)ptr = o;
    }
}
__device__ __forceinline__ void conv_branch(const bf16* BR, const float* cw, bf16* XO, int gtid, int gthreads) {
    const long total = (long)T * 64; const bf16* U = BR + (size_t)T * 512;
    for (long i = gtid; i < total; i += gthreads) {
        const int c8 = (int)(i & 63) * 8; const long row = i >> 6; const int tl = (int)(row & (SEQ - 1));
        float y[8];
#pragma unroll
        for (int e = 0; e < 8; ++e) y[e] = 0.f;
#pragma unroll
        for (int k = 0; k < 3; ++k) {
            const int back = 2 - k;
            if (tl - back >= 0) {
                const u32x4 uw = *(const u32x4*)(U + (row - back) * 512 + c8);
                const f32x4 w0 = *(const f32x4*)(cw + k * 512 + c8), w1 = *(const f32x4*)(cw + k * 512 + c8 + 4);
                const float wk[8] = {w0.x, w0.y, w0.z, w0.w, w1.x, w1.y, w1.z, w1.w};
#pragma unroll
                for (int e = 0; e < 4; ++e) { y[2 * e] += wk[2 * e] * bflo(uw[e]); y[2 * e + 1] += wk[2 * e + 1] * bfhi(uw[e]); }
            }
        }
        const u32x4 vw = *(const u32x4*)(BR + row * 512 + c8);
        u32x4 o;
#pragma unroll
        for (int e = 0; e < 4; ++e) o[e] = pk2(bflo(vw[e]) * y[2 * e], bfhi(vw[e]) * y[2 * e + 1]);
        *(u32x4*)(XO + row * 512 + c8) = o;
    }
}

__device__ __forceinline__ unsigned umin_(unsigned a, unsigned b) { return a < b ? a : b; }
__device__ __forceinline__ unsigned umax_(unsigned a, unsigned b) { return a > b ? a : b; }
typedef unsigned short u16x2 __attribute__((ext_vector_type(2)));
typedef short i16x2 __attribute__((ext_vector_type(2)));
__device__ __forceinline__ u16x2 as_u16x2(unsigned x) { return __builtin_bit_cast(u16x2, x); }
__device__ __forceinline__ unsigned as_u32(u16x2 x) { return __builtin_bit_cast(unsigned, x); }
__device__ __forceinline__ u16x2 pkmin(u16x2 a, u16x2 b) { return __builtin_elementwise_min(a, b); }
__device__ __forceinline__ u16x2 pkmax(u16x2 a, u16x2 b) { return __builtin_elementwise_max(a, b); }
__device__ __forceinline__ int wave_sum_dpp(int v) {
    v += __builtin_amdgcn_update_dpp(0, v, 0xB1, 0xF, 0xF, true); v += __builtin_amdgcn_update_dpp(0, v, 0x4E, 0xF, 0xF, true);
    v += __builtin_amdgcn_update_dpp(0, v, 0x124, 0xF, 0xF, true); v += __builtin_amdgcn_update_dpp(0, v, 0x128, 0xF, 0xF, true);
    return (__builtin_amdgcn_readlane(v, 0) + __builtin_amdgcn_readlane(v, 16)) + (__builtin_amdgcn_readlane(v, 32) + __builtin_amdgcn_readlane(v, 48));
}
__device__ __forceinline__ unsigned wave_umin_dpp(unsigned v) {
    v = umin_(v, (unsigned)__builtin_amdgcn_update_dpp(0, (int)v, 0xB1, 0xF, 0xF, true)); v = umin_(v, (unsigned)__builtin_amdgcn_update_dpp(0, (int)v, 0x4E, 0xF, 0xF, true));
    v = umin_(v, (unsigned)__builtin_amdgcn_update_dpp(0, (int)v, 0x124, 0xF, 0xF, true)); v = umin_(v, (unsigned)__builtin_amdgcn_update_dpp(0, (int)v, 0x128, 0xF, 0xF, true));
    return umin_(umin_((unsigned)__builtin_amdgcn_readlane((int)v, 0), (unsigned)__builtin_amdgcn_readlane((int)v, 16)), umin_((unsigned)__builtin_amdgcn_readlane((int)v, 32), (unsigned)__builtin_amdgcn_readlane((int)v, 48)));
}
__device__ __forceinline__ unsigned wave_umax_dpp(unsigned v) {
    v = umax_(v, (unsigned)__builtin_amdgcn_update_dpp(0, (int)v, 0xB1, 0xF, 0xF, true)); v = umax_(v, (unsigned)__builtin_amdgcn_update_dpp(0, (int)v, 0x4E, 0xF, 0xF, true));
    v = umax_(v, (unsigned)__builtin_amdgcn_update_dpp(0, (int)v, 0x124, 0xF, 0xF, true)); v = umax_(v, (unsigned)__builtin_amdgcn_update_dpp(0, (int)v, 0x128, 0xF, 0xF, true));
    return umax_(umax_((unsigned)__builtin_amdgcn_readlane((int)v, 0), (unsigned)__builtin_amdgcn_readlane((int)v, 16)), umax_((unsigned)__builtin_amdgcn_readlane((int)v, 32), (unsigned)__builtin_amdgcn_readlane((int)v, 48)));
}
__device__ __forceinline__ int count_ge16(const unsigned (&v)[32], unsigned cand, int nc) {
    const unsigned c2 = cand | (cand << 16), c1 = (cand - 1u) | ((cand - 1u) << 16);
    unsigned a0 = 0u, a1 = 0u;
#pragma unroll
    for (int c8 = 0; c8 < 4; ++c8) {
        if (c8 < nc) {
#pragma unroll
            for (int ii = 0; ii < 8; ii += 2) {
                const u16x2 x0 = as_u16x2(v[8 * c8 + ii]), x1 = as_u16x2(v[8 * c8 + ii + 1]);
                a0 = __builtin_amdgcn_sad_u16(as_u32(pkmin(x0, as_u16x2(c2))), as_u32(pkmin(x0, as_u16x2(c1))), a0);
                a1 = __builtin_amdgcn_sad_u16(as_u32(pkmin(x1, as_u16x2(c2))), as_u32(pkmin(x1, as_u16x2(c1))), a1);
            }
        }
    }
    return wave_sum_dpp((int)(a0 + a1));
}
__device__ __forceinline__ void nat_words(u64 lo, u64 hi, u64& w0, u64& w1) { w0 = (lo & 0xffffffffull) | (hi << 32); w1 = (lo >> 32) | (hi & 0xffffffff00000000ull); }

template <int I> __device__ __forceinline__ void deposit_words(u64 lob, u64 hib, unsigned& wlo, unsigned& whi) {
    const unsigned l0 = (unsigned)lob, l1 = (unsigned)(lob >> 32), h0 = (unsigned)hib, h1 = (unsigned)(hib >> 32);
    asm volatile("s_nop 1" :: "s"(l0), "s"(l1), "s"(h0), "s"(h1));
    asm volatile("v_writelane_b32 %0, %1, %2" : "+v"(wlo) : "s"(l0), "n"(2 * I));
    asm volatile("v_writelane_b32 %0, %1, %2" : "+v"(whi) : "s"(h0), "n"(2 * I));
    asm volatile("v_writelane_b32 %0, %1, %2" : "+v"(wlo) : "s"(l1), "n"(2 * I + 1));
    asm volatile("v_writelane_b32 %0, %1, %2" : "+v"(whi) : "s"(h1), "n"(2 * I + 1));
}
template <int I> __device__ __forceinline__ void emit_simple(const unsigned (&v)[32], unsigned tau, unsigned tau_hi, unsigned& wlo, unsigned& whi) {
    const unsigned x = v[I];
    deposit_words<I>(__ballot((x & 0xffffu) >= tau), __ballot(x >= tau_hi), wlo, whi);
}
template <int I> __device__ __forceinline__ void emit_ties(const unsigned (&v)[32], unsigned tau, unsigned tau_hi, int& need, unsigned& wlo, unsigned& whi) {
    const unsigned x = v[I]; const unsigned xl = x & 0xffffu, xh = x & 0xffff0000u;
    u64 glo = __ballot(xl > tau), ghi = __ballot(xh > tau_hi); const u64 elo = __ballot(xl == tau), ehi = __ballot(xh == tau_hi);
    if ((elo | ehi) != 0ull) {
        u64 g0, g1, e0, e1; nat_words(glo, ghi, g0, g1); nat_words(elo, ehi, e0, e1);
#pragma unroll
        for (int h2 = 0; h2 < 2; ++h2) { u64 e = h2 ? e1 : e0; u64 take = 0ull;
            const int pc = __popcll(e);
            if (pc <= need) { take = e; need -= pc; } else { while (need > 0) { const u64 low = e & (0ull - e); take |= low; e ^= low; --need; } }
            if (h2) g1 |= take; else g0 |= take; }
        glo = (g0 & 0xffffffffull) | (g1 << 32); ghi = (g0 >> 32) | (g1 & 0xffffffff00000000ull);
    }
    deposit_words<I>(glo, ghi, wlo, whi);
}
#define REP8(F, B, ...) F<B + 0>(__VA_ARGS__); F<B + 1>(__VA_ARGS__); F<B + 2>(__VA_ARGS__); F<B + 3>(__VA_ARGS__); F<B + 4>(__VA_ARGS__); F<B + 5>(__VA_ARGS__); F<B + 6>(__VA_ARGS__); F<B + 7>(__VA_ARGS__)
typedef _Float16 f16x8 __attribute__((ext_vector_type(8)));
typedef _Float16 f16x2 __attribute__((ext_vector_type(2)));
__device__ __forceinline__ void topk_unit2(LAS unsigned char* lds, const bf16* QI, const bf16* KIWI  , const float* WIC  , u64* MASK, int b, int tb16) {
    const int tid = opaque_tid(), lane = tid & 63, wid = __builtin_amdgcn_readfirstlane(tid >> 6), r32 = lane & 31, hi = lane >> 5;
    const int grp = wid >> 2, w4 = wid & 3;
    const int t0 = tb16 * 16 + grp * 8; const size_t rowb = (size_t)b * SEQ;
    LAS unsigned* SC = (LAS unsigned*)lds + grp * (8 * 2048);
    const int nt2 = ((t0 + 8 + 127) >> 7) << 1;
    bf16x8 af[2][4]; f16x8 a2[2][2];
    {
        const int rho = r32, qq = 2 * ((rho >> 2) & 1) + (rho >> 4), head = (rho & 3) + 4 * ((rho >> 3) & 1);
#pragma unroll
        for (int m = 0; m < 2; ++m) { const bf16* pq = QI + (rowb + t0 + 4 * m + qq) * 512 + head * 64 + 8 * hi;
#pragma unroll
            for (int ks = 0; ks < 4; ++ks) af[m][ks] = *(const bf16x8*)(pq + 16 * ks); }
        f32x4 wa = {0.f, 0.f, 0.f, 0.f}, wb = {0.f, 0.f, 0.f, 0.f};
        if (r32 < 8) { wa = *(const f32x4*)(WIC + (rowb + t0 + r32) * 8); wb = *(const f32x4*)(WIC + (rowb + t0 + r32) * 8 + 4); }
#pragma unroll
        for (int m = 0; m < 2; ++m)
#pragma unroll
            for (int sx = 0; sx < 2; ++sx) { const bool on = (r32 == 4 * m + 2 * hi + sx);
                f16x8 w8; w8[0] = (_Float16)(on ? wa[0] : 0.f); w8[1] = (_Float16)(on ? wa[1] : 0.f); w8[2] = (_Float16)(on ? wa[2] : 0.f); w8[3] = (_Float16)(on ? wa[3] : 0.f);
                w8[4] = (_Float16)(on ? wb[0] : 0.f); w8[5] = (_Float16)(on ? wb[1] : 0.f); w8[6] = (_Float16)(on ? wb[2] : 0.f); w8[7] = (_Float16)(on ? wb[3] : 0.f); a2[m][sx] = w8; }
    }
    {
        bf16x8 bA[2][4], bB[2][4];
        const bf16* kbase = KIWI + rowb * 64 + lane * 8;
        auto loadb = [&](bf16x8 (&bb)[2][4], int j2) { const int jj = j2 < nt2 ? j2 : nt2 - 1;
#pragma unroll
            for (int tt = 0; tt < 2; ++tt)
#pragma unroll
                for (int ks = 0; ks < 4; ++ks) bb[tt][ks] = *(const bf16x8*)(kbase + (size_t)((2 * jj + tt) * 4 + ks) * 512); };
        auto compute = [&](const bf16x8 (&bb)[2][4], int j2) {
            f32x16 c2[2];
#pragma unroll
            for (int tt = 0; tt < 2; ++tt) {
                f32x16 acc2;
#pragma unroll
                for (int r = 0; r < 16; ++r) acc2[r] = 0.f;
#pragma unroll
                for (int m = 0; m < 2; ++m) {
                    f32x16 c1;
#pragma unroll
                    for (int r = 0; r < 16; ++r) c1[r] = 0.f;
#pragma unroll
                    for (int ks = 0; ks < 4; ++ks) c1 = __builtin_amdgcn_mfma_f32_32x32x16_bf16(af[m][ks], bb[tt][ks], c1, 0, 0, 0);
#pragma unroll
                    for (int sx = 0; sx < 2; ++sx) { f16x8 pf;
#pragma unroll
                        for (int e = 0; e < 4; ++e) { f16x2 h2 = __builtin_bit_cast(f16x2, __builtin_amdgcn_cvt_pkrtz(c1[8 * sx + 2 * e], c1[8 * sx + 2 * e + 1]));
                            h2 = __builtin_elementwise_max(h2, (f16x2){(_Float16)0.f, (_Float16)0.f}); pf[2 * e] = h2[0]; pf[2 * e + 1] = h2[1]; }
                        acc2 = __builtin_amdgcn_mfma_f32_32x32x16_f16(a2[m][sx], pf, acc2, 0, 0, 0); }
                }
                c2[tt] = acc2;
            }
            const int key0 = 64 * j2 + r32;
            const bool diag = (64 * j2 + 63 > t0);
#pragma unroll
            for (int e = 0; e < 4; ++e) {
                const int q = 4 * hi + e;
                const unsigned x = __builtin_bit_cast(unsigned, __builtin_amdgcn_cvt_pkrtz(c2[0][e], c2[1][e]));
                const i16x2 sg = __builtin_bit_cast(i16x2, x) >> 15;
                unsigned k = x ^ (__builtin_bit_cast(unsigned, sg) | 0x80008000u);
                if (diag) { const int t = t0 + q; if (key0 > t) k &= 0xffff0000u; if (key0 + 32 > t) k &= 0x0000ffffu; }
                SC[q * 2048 + j2 * 32 + r32] = k;
            } };
        loadb(bA, w4); __builtin_amdgcn_sched_barrier(0);
        for (int j2 = w4; j2 < nt2; j2 += 8) {
            loadb(bB, j2 + 4); __builtin_amdgcn_sched_barrier(0);
            compute(bA, j2); __builtin_amdgcn_sched_barrier(0);
            loadb(bA, j2 + 8); __builtin_amdgcn_sched_barrier(0);
            if (j2 + 4 < nt2) compute(bB, j2 + 4);
            __builtin_amdgcn_sched_barrier(0);
        }
    }
    __syncthreads();
#pragma unroll 1
    for (int qi = 0; qi < 2; ++qi) {
        const int q = 2 * w4 + qi, t = t0 + q, n = t + 1;
        unsigned wlo = 0u, whi = 0u;
        if (n <= 256) {
            const int lo = 64 * lane; u64 w;
            if (lo + 63 <= t) w = ~0ull; else if (lo > t) w = 0ull; else w = (1ull << (t - lo + 1)) - 1ull;
            wlo = (unsigned)w; whi = (unsigned)(w >> 32);
        } else {
            const int nw = (n + 127) >> 7, nc = (nw + 7) >> 3;
            unsigned v[32];
#pragma unroll
            for (int i = 0; i < 32; ++i) v[i] = 0u;
#pragma unroll
            for (int c8 = 0; c8 < 4; ++c8) {
                if (c8 < nc) {
#pragma unroll
                    for (int ii = 0; ii < 8; ++ii) { const int i = 8 * c8 + ii; if (i < nw) v[i] = SC[q * 2048 + 64 * i + lane]; }
                }
            }
            u16x2 ta = as_u16x2(0u), tb = as_u16x2(0u);
#pragma unroll
            for (int c8 = 0; c8 < 4; ++c8) {
                if (c8 < nc) {
#pragma unroll
                    for (int ii = 0; ii < 8; ++ii) { const u16x2 x = as_u16x2(v[8 * c8 + ii]); tb = pkmin(pkmax(x, tb), ta); ta = pkmax(ta, x); }
                }
            }
            const unsigned L = wave_umin_dpp(umin_(tb[0], tb[1])), U = wave_umax_dpp(umax_(tb[0], tb[1]));
            unsigned lo = L, hi = U + 1u; int clo = -1, chi = -1, cge = 0; unsigned tau = L; bool done = false;
            for (int iter = 0; hi - lo > 1u; ++iter) {
                unsigned cand = lo + ((hi - lo) >> 1);
                if (clo >= 0 && chi >= 0 && (iter & 1) == 0) {
                    const float frac = ((float)(clo - 256) + 0.5f) / (float)(clo - chi);
                    cand = lo + (unsigned)(frac * (float)(hi - lo));
                    cand = cand <= lo ? lo + 1u : (cand >= hi ? hi - 1u : cand);
                }
                const int cnt = count_ge16(v, cand, nc);
                if (cnt >= 256) { lo = cand; clo = cnt; if (cnt == 256) { done = true; break; } } else { hi = cand; chi = cnt; }
            }
            tau = lo; cge = done ? 256 : (clo >= 0 ? clo : count_ge16(v, tau, nc));
            const unsigned tau_hi = tau << 16;
            if (cge == 256) {
                if (0 < nc) { REP8(emit_simple, 0, v, tau, tau_hi, wlo, whi); }
                if (1 < nc) { REP8(emit_simple, 8, v, tau, tau_hi, wlo, whi); }
                if (2 < nc) { REP8(emit_simple, 16, v, tau, tau_hi, wlo, whi); }
                if (3 < nc) { REP8(emit_simple, 24, v, tau, tau_hi, wlo, whi); }
            } else {
                int need = 256 - ((hi == tau + 1u && chi >= 0) ? chi : ((tau == 0xffffu) ? 0 : count_ge16(v, tau + 1u, nc)));
                if (0 < nc) { REP8(emit_ties, 0, v, tau, tau_hi, need, wlo, whi); }
                if (1 < nc) { REP8(emit_ties, 8, v, tau, tau_hi, need, wlo, whi); }
                if (2 < nc) { REP8(emit_ties, 16, v, tau, tau_hi, need, wlo, whi); }
                if (3 < nc) { REP8(emit_ties, 24, v, tau, tau_hi, need, wlo, whi); }
            }
        }
        u32x2 w2; w2.x = wlo; w2.y = whi;
        *(u32x2*)(MASK + ((size_t)(b * 64 + lane) * SEQ + t)) = w2;
    }
    __syncthreads();
}

__device__ __forceinline__ s16x4 vtr(const LAS unsigned char* p) { typedef short v4i16_t __attribute__((ext_vector_type(4))); return __builtin_bit_cast(s16x4, __builtin_amdgcn_ds_read_tr16_b64_v4i16((LAS v4i16_t*)p)); }
__device__ __forceinline__ int crow(int r, int hi) { return (r & 3) + 8 * (r >> 2) + 4 * hi; }
__device__ __forceinline__ unsigned bf16_rne_bits(float f) { return f2bf(f); }
__device__ __forceinline__ void flash_unit_a(LAS unsigned char* lds, const bf16* Q, const bf16* K, const bf16* V, bf16* O, const bf16* Z, int qb, const u64* mask, float slope2, float smax  ) {
    constexpr int LD = 512, KBYTES = 8192, BUFB = 16384, FLAGS = 32768;
    const int tid = opaque_tid(), lane = tid & 63, wid = __builtin_amdgcn_readfirstlane(tid >> 6), r32 = lane & 31, hi = lane >> 5;
    const float NEG = -1.0e30f;
    const int nt = 4 * (qb + 1);
    bf16x8 qf[4];
    { const bf16* qp = Q + (size_t)(wid * 32 + r32) * LD + 8 * hi;
#pragma unroll
      for (int ks = 0; ks < 4; ++ks) qf[ks] = *(const bf16x8*)(qp + 16 * ks); }
    u32x4 ka0 = {0u, 0u, 0u, 0u}, ka1 = {0u, 0u, 0u, 0u}, qa = {0u, 0u, 0u, 0u};
    if (hi == 0) {
        const float r0 = slope2 * (float)r32, r1 = slope2 * (float)(r32 + 32);
        const unsigned h0 = bf16_rne_bits(r0), h1 = bf16_rne_bits(r1);
        ka0.x = h0 | (bf16_rne_bits(r0 - __uint_as_float(h0 << 16)) << 16); ka1.x = h1 | (bf16_rne_bits(r1 - __uint_as_float(h1 << 16)) << 16);
        qa.x = 0x3f803f80u; qa.y = 0x3f803f80u; qa.z = 0x00003f80u;
    }
    f32x16 o[2];
#pragma unroll
    for (int d = 0; d < 2; ++d)
#pragma unroll
        for (int r = 0; r < 16; ++r) o[d][r] = 0.f;
    f32x16 negm;
#pragma unroll
    for (int r = 0; r < 16; ++r) negm[r] = 0.f;
    float m_run = 0.f, l_run = 0.f;
    u32x4 kregA, vregA, kregB, vregB; u64 mwA, mwB;
    const bf16* ksrc = K + (size_t)lane * LD + wid * 8;
    const bf16* vsrc = V + (size_t)(16 * (wid & 3) + (lane >> 2)) * LD + (wid >> 2) * 32 + (lane & 3) * 8;
    const int kdst = wid * 1024 + lane * 16, vdst = KBYTES + (wid >> 2) * 4096 + (16 * (wid & 3) + (lane >> 2)) * 64 + (lane & 3) * 16;
    const u64* mrow = mask + (wid * 32 + r32);
    auto loadt = [&](u32x4& kr, u32x4& vr, u64& mwr, int t) { const int tt = t > 0 ? t : 0;
        kr = *(const u32x4*)(ksrc + (size_t)tt * 64 * LD); vr = *(const u32x4*)(vsrc + (size_t)tt * 64 * LD); mwr = mrow[(size_t)tt * SEQ]; };
    loadt(kregA, vregA, mwA, nt - 1); loadt(kregB, vregB, mwB, nt - 2); __builtin_amdgcn_sched_barrier(0);
    const int kfb = hi * 1024 + r32 * 16;
    const int vfb = KBYTES + (4 * hi + ((lane & 15) >> 2)) * 64 + ((lane >> 4) & 1) * 32 + (lane & 3) * 8;
    const int qmax_w = qb * 256 + wid * 32 + 31;
    volatile LAS unsigned* flags = (volatile LAS unsigned*)(lds + FLAGS);
    bool wdone = false, have = false;
    auto step = [&](u32x4& kreg, u32x4& vreg, u64& mw, int it) -> bool {
        const int t = nt - 1 - it;
        LAS unsigned char* buf = lds + (it & 1) * BUFB;
        *(LAS u32x4*)(buf + kdst) = kreg; *(LAS u32x4*)(buf + vdst) = vreg;
        if (lane == 0) flags[(it & 1) * 8 + wid] = wdone ? 1u : 0u;
        __syncthreads();
        unsigned fl[8];
#pragma unroll
        for (int w = 0; w < 8; ++w) fl[w] = flags[(it & 1) * 8 + w];
        bf16x8 kf[8];
#pragma unroll
        for (int ks = 0; ks < 4; ++ks) { kf[2 * ks] = *(const LAS bf16x8*)(buf + kfb + ks * 2048); kf[2 * ks + 1] = *(const LAS bf16x8*)(buf + kfb + ks * 2048 + 512); }
        __builtin_amdgcn_sched_barrier(0);
        {
            unsigned all = 1u;
#pragma unroll
            for (int w = 0; w < 8; ++w) all &= fl[w];
            if (all) return true;
        }
        const u64 mcur = mw;
        __builtin_amdgcn_sched_barrier(0);
        loadt(kreg, vreg, mw, t - 2);
        __builtin_amdgcn_sched_barrier(0);
        if (!wdone && 64 * t <= qmax_w) {
            {
                const float bt = -slope2 * 64.0f * (float)it;
                const unsigned b0 = bf16_rne_bits(bt); const float rem1 = bt - __uint_as_float(b0 << 16);
                const unsigned b1 = bf16_rne_bits(rem1); const float rem2 = rem1 - __uint_as_float(b1 << 16);
                const unsigned b2 = bf16_rne_bits(rem2);
                if (hi == 0) { ka0.y = b0 | (b1 << 16); ka0.z = b2; ka1.y = ka0.y; ka1.z = b2; }
            }
            f32x16 c0, c1;
            c0 = __builtin_amdgcn_mfma_f32_32x32x16_bf16(__builtin_bit_cast(bf16x8, ka0), __builtin_bit_cast(bf16x8, qa), negm, 0, 0, 0);
            c1 = __builtin_amdgcn_mfma_f32_32x32x16_bf16(__builtin_bit_cast(bf16x8, ka1), __builtin_bit_cast(bf16x8, qa), negm, 0, 0, 0);
#pragma unroll
            for (int ks = 0; ks < 4; ++ks) {
                c0 = __builtin_amdgcn_mfma_f32_32x32x16_bf16(kf[2 * ks], qf[ks], c0, 0, 0, 0);
                c1 = __builtin_amdgcn_mfma_f32_32x32x16_bf16(kf[2 * ks + 1], qf[ks], c1, 0, 0, 0);
            }
            s16x4 vlo[2][4], vhi[2][4];
#pragma unroll
            for (int d = 0; d < 2; ++d)
#pragma unroll
                for (int s2 = 0; s2 < 4; ++s2) { vlo[d][s2] = vtr(buf + vfb + d * 4096 + (16 * s2) * 64); vhi[d][s2] = vtr(buf + vfb + d * 4096 + (16 * s2 + 8) * 64); }
            __builtin_amdgcn_sched_barrier(0);
            const int mlo = (int)((unsigned)mcur >> (4 * hi)), mhi = (int)((unsigned)(mcur >> 32) >> (4 * hi));
#pragma unroll
            for (int r = 0; r < 16; ++r) { const int bpos = (r & 3) + 8 * (r >> 2);
                const unsigned s0 = (unsigned)__builtin_amdgcn_sbfe(mlo, bpos, 1), s1 = (unsigned)__builtin_amdgcn_sbfe(mhi, bpos, 1);
                c0[r] = __uint_as_float((__float_as_uint(c0[r]) & s0) | (__float_as_uint(NEG) & ~s0));
                c1[r] = __uint_as_float((__float_as_uint(c1[r]) & s1) | (__float_as_uint(NEG) & ~s1)); }
            float mx = fmaxf(c0[0], c1[0]);
#pragma unroll
            for (int r = 1; r < 16; ++r) mx = fmaxf(fmaxf(mx, c0[r]), c1[r]);
            mx = max_halves(mx);
            const bool need = (mx > 0.f) || (!have && mx > -1.0e29f);
            if (__any(need)) {
                const float dl = need ? mx : 0.f, f = have ? __builtin_amdgcn_exp2f(-dl) : 1.0f;
                m_run += dl; l_run *= f;
#pragma unroll
                for (int r = 0; r < 16; ++r) { c0[r] -= dl; c1[r] -= dl; negm[r] = -m_run; o[0][r] *= f; o[1][r] *= f; }
            }
            float ps = 0.f;
#pragma unroll
            for (int r = 0; r < 16; ++r) { c0[r] = __builtin_amdgcn_exp2f(c0[r]); c1[r] = __builtin_amdgcn_exp2f(c1[r]); ps += c0[r] + c1[r]; }
            l_run += ps;
            bf16x8 pf[4];
#pragma unroll
            for (int s = 0; s < 4; ++s) { u32x4 w;
#pragma unroll
                for (int e = 0; e < 4; ++e) { const int r = (s & 1) * 8 + 2 * e; w[e] = (s < 2) ? pg8::cvt_pk_bf16(c0[r], c0[r + 1]) : pg8::cvt_pk_bf16(c1[r], c1[r + 1]); }
                pf[s] = __builtin_bit_cast(bf16x8, w); }
#pragma unroll
            for (int d = 0; d < 2; ++d)
#pragma unroll
                for (int s = 0; s < 4; ++s) {
                    const s16x4 lo4 = vlo[d][s], hi4 = vhi[d][s];
                    const bf16x8 vf = (bf16x8){lo4[0], lo4[1], lo4[2], lo4[3], hi4[0], hi4[1], hi4[2], hi4[3]};
                    o[d] = __builtin_amdgcn_mfma_f32_32x32x16_bf16(vf, pf[s], o[d], 0, 0, 0);
                }
            const float ub = smax + slope2 * 63.0f - slope2 * 64.0f * (float)(it + 1);
            const float lt = sum_halves(l_run);
            have = lt > 0.f;
            wdone = __all(have && (ub - m_run < -40.0f)) != 0;
        }
        return false;
    };
    for (int it = 0; it < nt; it += 2) {
        if (step(kregA, vregA, mwA, it)) break;
        if (step(kregB, vregB, mwB, it + 1)) break;
    }
    const float l_tot = sum_halves(l_run), inv = 1.0f / l_tot;
    bf16* orow = O + (size_t)(wid * 32 + r32) * LD; const bf16* zrow = Z + (size_t)(wid * 32 + r32) * LD;
    u32x2 zall[2][4];
#pragma unroll
    for (int d = 0; d < 2; ++d)
#pragma unroll
        for (int rg = 0; rg < 4; ++rg) zall[d][rg] = *(const u32x2*)(zrow + d * 32 + 8 * rg + 4 * hi);
    asm volatile("" ::: "memory");
#pragma unroll
    for (int d = 0; d < 2; ++d)
#pragma unroll
        for (int rg = 0; rg < 4; ++rg) { const int d0 = d * 32 + 8 * rg + 4 * hi;
            const u32x2 zw = zall[d][rg];
            u32x2 ow; ow.x = pk2(o[d][4 * rg] * inv * siluf_(bflo(zw.x)), o[d][4 * rg + 1] * inv * siluf_(bfhi(zw.x))); ow.y = pk2(o[d][4 * rg + 2] * inv * siluf_(bflo(zw.y)), o[d][4 * rg + 3] * inv * siluf_(bfhi(zw.y)));
            *(u32x2*)(orow + d0) = ow; }
    __syncthreads();
}
__device__ __forceinline__ void flash_unit_c(LAS unsigned char* lds, const bf16* Q, const bf16* K, const bf16* V, bf16* O, const bf16* Z, int qb, const u64* mask, float slope2, float smax  ) {
    constexpr int LD = 512, KBYTES = 8192, TILEB = 16384, BUFB = 32768, MERGE = 65536, FLAGS = 65536 + 36864;
    const int tid = opaque_tid(), lane = tid & 63, wid = __builtin_amdgcn_readfirstlane(tid >> 6), r32 = lane & 31, hi = lane >> 5;
    const float NEG = -1.0e30f;
    const int nt = 2 * (qb + 1);
    const int grp = wid >> 2, wq = wid & 3;
    bf16x8 qf[4];
    { const bf16* qp = Q + (size_t)(wq * 32 + r32) * LD + 8 * hi;
#pragma unroll
      for (int ks = 0; ks < 4; ++ks) qf[ks] = *(const bf16x8*)(qp + 16 * ks); }
    u32x4 ka0 = {0u, 0u, 0u, 0u}, ka1 = {0u, 0u, 0u, 0u}, qa = {0u, 0u, 0u, 0u};
    if (hi == 0) {
        const float r0 = slope2 * (float)r32, r1 = slope2 * (float)(r32 + 32);
        const unsigned h0 = bf16_rne_bits(r0), h1 = bf16_rne_bits(r1);
        ka0.x = h0 | (bf16_rne_bits(r0 - __uint_as_float(h0 << 16)) << 16); ka1.x = h1 | (bf16_rne_bits(r1 - __uint_as_float(h1 << 16)) << 16);
        qa.x = 0x3f803f80u; qa.y = 0x3f803f80u; qa.z = 0x00003f80u;
    }
    f32x16 o[2];
#pragma unroll
    for (int d = 0; d < 2; ++d)
#pragma unroll
        for (int r = 0; r < 16; ++r) o[d][r] = 0.f;
    f32x16 negm;
#pragma unroll
    for (int r = 0; r < 16; ++r) negm[r] = 0.f;
    float m_run = 0.f, l_run = 0.f;
    u32x4 kregA[2], vregA[2], kregB[2], vregB[2]; u64 mwA, mwB;
    const bf16* ksrc = K + (size_t)lane * LD + wid * 8;
    const bf16* vsrc = V + (size_t)(16 * (wid & 3) + (lane >> 2)) * LD + (wid >> 2) * 32 + (lane & 3) * 8;
    const int kdst = wid * 1024 + lane * 16, vdst = KBYTES + (wid >> 2) * 4096 + (16 * (wid & 3) + (lane >> 2)) * 64 + (lane & 3) * 16;
    const u64* mrow = mask + (wq * 32 + r32);
    auto loadt = [&](u32x4 (&kr)[2], u32x4 (&vr)[2], u64& mwr, int it) {
#pragma unroll
        for (int j = 0; j < 2; ++j) { int t = nt - 1 - 2 * it - j; t = t > 0 ? t : 0; kr[j] = *(const u32x4*)(ksrc + (size_t)t * 64 * LD); vr[j] = *(const u32x4*)(vsrc + (size_t)t * 64 * LD); }
        int tm = nt - 1 - 2 * it - grp; tm = tm > 0 ? tm : 0; mwr = mrow[(size_t)tm * SEQ]; };
    loadt(kregA, vregA, mwA, 0); loadt(kregB, vregB, mwB, 1); __builtin_amdgcn_sched_barrier(0);
    const int kfb = hi * 1024 + r32 * 16;
    const int vfb = KBYTES + (4 * hi + ((lane & 15) >> 2)) * 64 + ((lane >> 4) & 1) * 32 + (lane & 3) * 8;
    const int qmax_w = qb * 128 + wq * 32 + 31;
    volatile LAS unsigned* flags = (volatile LAS unsigned*)(lds + FLAGS);
    bool wdone = false, have = false;
    auto step = [&](u32x4 (&kreg)[2], u32x4 (&vreg)[2], u64& mw, int it) -> bool {
        const int ti = 2 * it + grp, t = nt - 1 - ti;
        LAS unsigned char* sbuf = lds + (it & 1) * BUFB;
        *(LAS u32x4*)(sbuf + kdst) = kreg[0]; *(LAS u32x4*)(sbuf + vdst) = vreg[0]; *(LAS u32x4*)(sbuf + TILEB + kdst) = kreg[1]; *(LAS u32x4*)(sbuf + TILEB + vdst) = vreg[1];
        const LAS unsigned char* buf = sbuf + grp * TILEB;
        if (lane == 0) flags[(it & 1) * 8 + wid] = wdone ? 1u : 0u;
        __syncthreads();
        {
            unsigned all = 1u;
#pragma unroll
            for (int w = 0; w < 8; ++w) all &= flags[(it & 1) * 8 + w];
            if (all) return true;
        }
        const u64 mcur = mw;
        __builtin_amdgcn_sched_barrier(0);
        loadt(kreg, vreg, mw, it + 2);
        __builtin_amdgcn_sched_barrier(0);
        if (!wdone && 64 * t <= qmax_w) {
            {
                const float bt = -slope2 * 64.0f * (float)ti;
                const unsigned b0 = bf16_rne_bits(bt); const float rem1 = bt - __uint_as_float(b0 << 16);
                const unsigned b1 = bf16_rne_bits(rem1); const float rem2 = rem1 - __uint_as_float(b1 << 16);
                const unsigned b2 = bf16_rne_bits(rem2);
                if (hi == 0) { ka0.y = b0 | (b1 << 16); ka0.z = b2; ka1.y = ka0.y; ka1.z = b2; }
            }
            f32x16 c0, c1;
            c0 = __builtin_amdgcn_mfma_f32_32x32x16_bf16(__builtin_bit_cast(bf16x8, ka0), __builtin_bit_cast(bf16x8, qa), negm, 0, 0, 0);
            c1 = __builtin_amdgcn_mfma_f32_32x32x16_bf16(__builtin_bit_cast(bf16x8, ka1), __builtin_bit_cast(bf16x8, qa), negm, 0, 0, 0);
#pragma unroll
            for (int ks = 0; ks < 4; ++ks) {
                const bf16x8 a0 = *(const LAS bf16x8*)(buf + kfb + ks * 2048), a1 = *(const LAS bf16x8*)(buf + kfb + ks * 2048 + 512);
                c0 = __builtin_amdgcn_mfma_f32_32x32x16_bf16(a0, qf[ks], c0, 0, 0, 0);
                c1 = __builtin_amdgcn_mfma_f32_32x32x16_bf16(a1, qf[ks], c1, 0, 0, 0);
            }
            const int mlo = (int)((unsigned)mcur >> (4 * hi)), mhi = (int)((unsigned)(mcur >> 32) >> (4 * hi));
#pragma unroll
            for (int r = 0; r < 16; ++r) { const int bpos = (r & 3) + 8 * (r >> 2);
                const unsigned s0 = (unsigned)__builtin_amdgcn_sbfe(mlo, bpos, 1), s1 = (unsigned)__builtin_amdgcn_sbfe(mhi, bpos, 1);
                c0[r] = __uint_as_float((__float_as_uint(c0[r]) & s0) | (__float_as_uint(NEG) & ~s0));
                c1[r] = __uint_as_float((__float_as_uint(c1[r]) & s1) | (__float_as_uint(NEG) & ~s1)); }
            float mx = fmaxf(c0[0], c1[0]);
#pragma unroll
            for (int r = 1; r < 16; ++r) mx = fmaxf(fmaxf(mx, c0[r]), c1[r]);
            mx = max_halves(mx);
            const bool need = (mx > 0.f) || (!have && mx > -1.0e29f);
            if (__any(need)) {
                const float dl = need ? mx : 0.f, f = have ? __builtin_amdgcn_exp2f(-dl) : 1.0f;
                m_run += dl; l_run *= f;
#pragma unroll
                for (int r = 0; r < 16; ++r) { c0[r] -= dl; c1[r] -= dl; negm[r] = -m_run; o[0][r] *= f; o[1][r] *= f; }
            }
            float ps = 0.f;
#pragma unroll
            for (int r = 0; r < 16; ++r) { c0[r] = __builtin_amdgcn_exp2f(c0[r]); c1[r] = __builtin_amdgcn_exp2f(c1[r]); ps += c0[r] + c1[r]; }
            l_run += ps;
            bf16x8 pf[4];
#pragma unroll
            for (int s = 0; s < 4; ++s) { u32x4 w;
#pragma unroll
                for (int e = 0; e < 4; ++e) { const int r = (s & 1) * 8 + 2 * e; w[e] = (s < 2) ? pg8::cvt_pk_bf16(c0[r], c0[r + 1]) : pg8::cvt_pk_bf16(c1[r], c1[r + 1]); }
                pf[s] = __builtin_bit_cast(bf16x8, w); }
#pragma unroll
            for (int d = 0; d < 2; ++d)
#pragma unroll
                for (int s = 0; s < 4; ++s) {
                    const s16x4 lo4 = vtr(buf + vfb + d * 4096 + (16 * s) * 64), hi4 = vtr(buf + vfb + d * 4096 + (16 * s + 8) * 64);
                    const bf16x8 vf = (bf16x8){lo4[0], lo4[1], lo4[2], lo4[3], hi4[0], hi4[1], hi4[2], hi4[3]};
                    o[d] = __builtin_amdgcn_mfma_f32_32x32x16_bf16(vf, pf[s], o[d], 0, 0, 0);
                }
            const float ub = smax + slope2 * 63.0f - slope2 * 64.0f * (float)(ti + 2);
            const float lt = sum_halves(l_run);
            have = lt > 0.f;
            wdone = __all(have && (ub - m_run < -40.0f)) != 0;
        }
        return false;
    };
    for (int it = 0; it < nt / 2; it += 2) {
        if (step(kregA, vregA, mwA, it)) break;
        if (it + 1 < nt / 2) { if (step(kregB, vregB, mwB, it + 1)) break; }
    }
    __syncthreads();
    { LAS float* mg = (LAS float*)(lds + MERGE) + (wq * 64 + lane) * 36;
      if (grp == 1) { mg[0] = m_run; mg[1] = l_run;
#pragma unroll
          for (int r = 0; r < 16; ++r) { mg[2 + r] = o[0][r]; mg[18 + r] = o[1][r]; } }
      __syncthreads();
      if (grp == 0) {
          const float mB = mg[0], lB = mg[1];
          const float ltA = sum_halves(l_run), ltB = sum_halves(lB);
          const float mm = (ltA > 0.f && ltB > 0.f) ? fmaxf(m_run, mB) : (ltA > 0.f ? m_run : mB);
          const float fA = ltA > 0.f ? __builtin_amdgcn_exp2f(m_run - mm) : 0.f, fB = ltB > 0.f ? __builtin_amdgcn_exp2f(mB - mm) : 0.f;
          l_run = l_run * fA + lB * fB;
#pragma unroll
          for (int r = 0; r < 16; ++r) { o[0][r] = o[0][r] * fA + mg[2 + r] * fB; o[1][r] = o[1][r] * fA + mg[18 + r] * fB; } } }
    if (grp == 0) {
    const float l_tot = sum_halves(l_run), inv = 1.0f / l_tot;
    bf16* orow = O + (size_t)(wq * 32 + r32) * LD; const bf16* zrow = Z + (size_t)(wq * 32 + r32) * LD;
    u32x2 zall[2][4];
#pragma unroll
    for (int d = 0; d < 2; ++d)
#pragma unroll
        for (int rg = 0; rg < 4; ++rg) zall[d][rg] = *(const u32x2*)(zrow + d * 32 + 8 * rg + 4 * hi);
    asm volatile("" ::: "memory");
#pragma unroll
    for (int d = 0; d < 2; ++d)
#pragma unroll
        for (int rg = 0; rg < 4; ++rg) { const int d0 = d * 32 + 8 * rg + 4 * hi;
            const u32x2 zw = zall[d][rg];
            u32x2 ow; ow.x = pk2(o[d][4 * rg] * inv * siluf_(bflo(zw.x)), o[d][4 * rg + 1] * inv * siluf_(bfhi(zw.x))); ow.y = pk2(o[d][4 * rg + 2] * inv * siluf_(bflo(zw.y)), o[d][4 * rg + 3] * inv * siluf_(bfhi(zw.y)));
            *(u32x2*)(orow + d0) = ow; }
    }
    __syncthreads();
}

__device__ __forceinline__ void flash_unit_m(LAS unsigned char* lds, const bf16* Q, const bf16* K, const bf16* V, bf16* O, const bf16* Z, const float* gq) {
    constexpr int D = 128, KS = 8, DB = 4, KBYTES = D * 128, BUFB = 2 * KBYTES, LDQ = 512, LDKV = 1024;
    const int tid = opaque_tid(), lane = tid & 63, wid = __builtin_amdgcn_readfirstlane(tid >> 6), r32 = lane & 31, hi = lane >> 5;
    {
        u32x4 kreg[4][2], vreg[4][2];
        const bf16* ksrc = K + (size_t)lane * LDKV + wid * 8;
        const bf16* vsrc = V + (size_t)(16 * (wid & 3) + (lane >> 2)) * LDKV + (wid >> 2) * 32 + (lane & 3) * 8;
#pragma unroll
        for (int t = 0; t < 4; ++t)
#pragma unroll
            for (int i = 0; i < 2; ++i) { kreg[t][i] = *(const u32x4*)(ksrc + (size_t)t * 64 * LDKV + i * 64); vreg[t][i] = *(const u32x4*)(vsrc + (size_t)t * 64 * LDKV + i * 64); }
        const int kdst = wid * 1024 + lane * 16, vdst = KBYTES + (wid >> 2) * 4096 + (16 * (wid & 3) + (lane >> 2)) * 64 + (lane & 3) * 16;
#pragma unroll
        for (int t = 0; t < 4; ++t)
#pragma unroll
            for (int i = 0; i < 2; ++i) { *(LAS u32x4*)(lds + t * BUFB + kdst + i * 8192) = kreg[t][i]; *(LAS u32x4*)(lds + t * BUFB + vdst + i * 8192) = vreg[t][i]; }
    }
    bf16x8 qf[KS];
    {
        const bf16* qp = Q + (size_t)(wid * 32 + r32) * LDQ + 8 * hi; u32x4 raw[KS]; float ss = 0.f;
#pragma unroll
        for (int ks = 0; ks < KS; ++ks) { raw[ks] = *(const u32x4*)(qp + 16 * ks);
#pragma unroll
            for (int e = 0; e < 4; ++e) { const float a = bflo(raw[ks][e]), b = bfhi(raw[ks][e]); ss += a * a + b * b; } }
        ss = sum_halves(ss);
        const float r = 0.08838834764831845f * LOG2E / sqrtf(ss * (1.0f / 128.0f) + RMS_EPS);
#pragma unroll
        for (int ks = 0; ks < KS; ++ks) { const f32x4 g0 = *(const f32x4*)(gq + 16 * ks + 8 * hi), g1 = *(const f32x4*)(gq + 16 * ks + 8 * hi + 4); u32x4 w;
            w.x = pg8::cvt_pk_bf16(bflo(raw[ks].x) * r * g0.x, bfhi(raw[ks].x) * r * g0.y); w.y = pg8::cvt_pk_bf16(bflo(raw[ks].y) * r * g0.z, bfhi(raw[ks].y) * r * g0.w);
            w.z = pg8::cvt_pk_bf16(bflo(raw[ks].z) * r * g1.x, bfhi(raw[ks].z) * r * g1.y); w.w = pg8::cvt_pk_bf16(bflo(raw[ks].w) * r * g1.z, bfhi(raw[ks].w) * r * g1.w);
            qf[ks] = __builtin_bit_cast(bf16x8, w); }
    }
    f32x16 o[DB];
#pragma unroll
    for (int d = 0; d < DB; ++d)
#pragma unroll
        for (int r = 0; r < 16; ++r) o[d][r] = 0.f;
    float m_run = -1.0e30f, l_run = 0.f;
    const int kfb = hi * 1024 + r32 * 16;
    const int vfb = KBYTES + (4 * hi + ((lane & 15) >> 2)) * 64 + ((lane >> 4) & 1) * 32 + (lane & 3) * 8;
    __syncthreads();
#pragma unroll 1
    for (int t = 0; t < 4; ++t) {
        const LAS unsigned char* buf = lds + t * BUFB;
        f32x16 c0, c1;
#pragma unroll
        for (int r = 0; r < 16; ++r) { c0[r] = 0.f; c1[r] = 0.f; }
#pragma unroll
        for (int ks = 0; ks < KS; ++ks) {
            const bf16x8 a0 = *(const LAS bf16x8*)(buf + kfb + ks * 2048), a1 = *(const LAS bf16x8*)(buf + kfb + ks * 2048 + 512);
            c0 = __builtin_amdgcn_mfma_f32_32x32x16_bf16(a0, qf[ks], c0, 0, 0, 0);
            c1 = __builtin_amdgcn_mfma_f32_32x32x16_bf16(a1, qf[ks], c1, 0, 0, 0);
        }
        float mx = fmaxf(c0[0], c1[0]);
#pragma unroll
        for (int r = 1; r < 16; ++r) mx = fmaxf(fmaxf(mx, c0[r]), c1[r]);
        mx = max_halves(mx);
        const float m_new = fmaxf(m_run, mx), alpha = __builtin_amdgcn_exp2f(m_run - m_new);
        m_run = m_new;
        float ps = 0.f;
#pragma unroll
        for (int r = 0; r < 16; ++r) { c0[r] = __builtin_amdgcn_exp2f(c0[r] - m_new); c1[r] = __builtin_amdgcn_exp2f(c1[r] - m_new); ps += c0[r] + c1[r]; }
        l_run = l_run * alpha + ps;
#pragma unroll
        for (int d = 0; d < DB; ++d)
#pragma unroll
            for (int r = 0; r < 16; ++r) o[d][r] *= alpha;
        bf16x8 pf[4];
#pragma unroll
        for (int s = 0; s < 4; ++s) { u32x4 w;
#pragma unroll
            for (int e = 0; e < 4; ++e) { const int r = (s & 1) * 8 + 2 * e; w[e] = (s < 2) ? pg8::cvt_pk_bf16(c0[r], c0[r + 1]) : pg8::cvt_pk_bf16(c1[r], c1[r + 1]); }
            pf[s] = __builtin_bit_cast(bf16x8, w); }
#pragma unroll
        for (int d = 0; d < DB; ++d)
#pragma unroll
            for (int s = 0; s < 4; ++s) {
                const s16x4 lo4 = vtr(buf + vfb + d * 4096 + (16 * s) * 64), hi4 = vtr(buf + vfb + d * 4096 + (16 * s + 8) * 64);
                const bf16x8 vf = (bf16x8){lo4[0], lo4[1], lo4[2], lo4[3], hi4[0], hi4[1], hi4[2], hi4[3]};
                o[d] = __builtin_amdgcn_mfma_f32_32x32x16_bf16(vf, pf[s], o[d], 0, 0, 0);
            }
    }
    const float inv = 1.0f / sum_halves(l_run);
    bf16* orow = O + (size_t)(wid * 32 + r32) * LDQ; const bf16* zrow = Z + (size_t)(wid * 32 + r32) * LDQ;
    u32x2 zall[DB][4];
#pragma unroll
    for (int d = 0; d < DB; ++d)
#pragma unroll
        for (int rg = 0; rg < 4; ++rg) zall[d][rg] = *(const u32x2*)(zrow + d * 32 + 8 * rg + 4 * hi);
    asm volatile("" ::: "memory");
#pragma unroll
    for (int d = 0; d < DB; ++d)
#pragma unroll
        for (int rg = 0; rg < 4; ++rg) { const int d0 = d * 32 + 8 * rg + 4 * hi;
            const u32x2 zw = zall[d][rg];
            u32x2 ow; ow.x = pk2(o[d][4 * rg] * inv * siluf_(bflo(zw.x)), o[d][4 * rg + 1] * inv * siluf_(bfhi(zw.x))); ow.y = pk2(o[d][4 * rg + 2] * inv * siluf_(bflo(zw.y)), o[d][4 * rg + 3] * inv * siluf_(bfhi(zw.y)));
            *(u32x2*)(orow + d0) = ow; }
    __syncthreads();
}

#define RLX_AGENT __ATOMIC_RELAXED, __HIP_MEMORY_SCOPE_AGENT
constexpr size_t WS_CTL = 45 * MiB, CTL_ZERO_BYTES = 16384;
constexpr int LDS_BARST = 131072 + 8192;
#define XB_TMO      128
#define XB_XCNT(j)  (256  + 64 * (j))
#define XB_XSUB(j)  (1280 + 64 * (j))
#define XB_XGEN(j)  (2304 + 64 * (j))
#define XB_TOP      3328
#define XB_TOPGEN   3392
#define XCD_BAR_WORDS 3456
#define XB_SPIN_CAP (1u << 18)

__device__ __forceinline__ unsigned xb_ld(unsigned* p)              { return __hip_atomic_load(p, __ATOMIC_RELAXED, __HIP_MEMORY_SCOPE_AGENT); }
__device__ __forceinline__ unsigned xb_add(unsigned* p, unsigned v) { return __hip_atomic_fetch_add(p, v, __ATOMIC_RELAXED, __HIP_MEMORY_SCOPE_AGENT); }
__device__ __forceinline__ unsigned xb_xcc_id() { return (unsigned)__builtin_amdgcn_s_getreg((3 << 11) | 20) & 0xFu; }
#define XB_SPIN(cond, bar) do { unsigned _sp = 0; while (cond) { __builtin_amdgcn_s_sleep(1); \
    if ((++_sp & 255u) == 0u) { if (xb_ld(&(bar)[XB_TMO])) break; if (_sp > XB_SPIN_CAP) { atomicAdd(&(bar)[XB_TMO], 1u); break; } } } } while (0)

struct XcdBarrier {
    unsigned* bar; unsigned x;
    volatile LAS unsigned* st;
};
__device__ __forceinline__ XcdBarrier xcd_barrier_post(unsigned* bar, volatile LAS unsigned* st) {
    XcdBarrier b; b.bar = bar; b.x = xb_xcc_id(); b.st = st;
    if (threadIdx.x == 0) (void)xb_add(&bar[XB_XCNT(b.x)], 1u);
    return b;
}
__device__ __forceinline__ void xcd_barrier_complete(unsigned* bar, unsigned x, unsigned& nloc, unsigned& nx) {
    const unsigned G = gridDim.x * gridDim.y * gridDim.z;
    unsigned sum, cnt, mine, sp = 0u;
    for (;;) {
        sum = 0u; cnt = 0u; mine = 0u;
#pragma unroll
        for (unsigned j = 0; j < 16; ++j) { const unsigned c = xb_ld(&bar[XB_XCNT(j)]); sum += c; cnt += (c > 0u) ? 1u : 0u; mine = (j == x) ? c : mine; }
        if (sum == G) break;
        __builtin_amdgcn_s_sleep(1);
        if ((++sp & 255u) == 0u) { if (xb_ld(&bar[XB_TMO])) break; if (sp > XB_SPIN_CAP) { atomicAdd(&bar[XB_TMO], 1u); break; } }
    }
    nloc = mine > 0u ? mine : 1u; nx = cnt > 0u ? cnt : 1u;
}

__device__ __forceinline__ void xcd_barrier(const XcdBarrier& b) {
    asm volatile("s_waitcnt vmcnt(0)" ::: "memory");
    __syncthreads();
    if (threadIdx.x == 0) {
        unsigned* bar = b.bar;
        __builtin_amdgcn_s_waitcnt(0);
        unsigned nloc = b.st[0], nx = b.st[1];
        if (nloc == 0u) { xcd_barrier_complete(bar, b.x, nloc, nx); b.st[0] = nloc; b.st[1] = nx; }
        const unsigned old = xb_add(&bar[XB_XSUB(b.x)], 1u);
        const unsigned gen = old / nloc;
        if (old + 1u == (gen + 1u) * nloc) {
            __builtin_amdgcn_fence(__ATOMIC_RELEASE, "agent");
            asm volatile("s_waitcnt vmcnt(0)" ::: "memory");
            const unsigned og = xb_add(&bar[XB_TOP], 1u);
            const unsigned tg = og / nx;
            if (og + 1u == (tg + 1u) * nx) xb_add(&bar[XB_TOPGEN], 1u);
            else XB_SPIN(xb_ld(&bar[XB_TOPGEN]) == tg, bar);
            __builtin_amdgcn_fence(__ATOMIC_ACQUIRE, "agent");
            xb_add(&bar[XB_XGEN(b.x)], 1u);
            asm volatile("s_waitcnt vmcnt(0)" ::: "memory");
        } else {
            XB_SPIN(xb_ld(&bar[XB_XGEN(b.x)]) == gen, bar);
            __builtin_amdgcn_fence(__ATOMIC_ACQUIRE, "agent");
            asm volatile("s_waitcnt vmcnt(0)" ::: "memory");
        }
    }
    __syncthreads();
}

__device__ __forceinline__ void phase1(const Params& p, LAS unsigned char* lds, int G) {
    unsigned char* ws = p.ws; const int c = (int)blockIdx.x;
    pg8::Gemm g{(const bf16*)(ws + WS_XB), (const bf16*)(ws + WS_WIN), T, NIN, DM, ((long)WS_MEMB - (long)WS_XB) / 2, ((long)WS_WMKV - (long)WS_WIN) / 2, 0};
    pg8::StaticOrder S; S.init(T, NIN, G, c, 1, MT, 1024);
    pg8::EpiProjA E{ws, (bf16*)p.out, (const float*)(ws + WS_RSTDX), p.q_norm_a, p.k_norm_a, (bf16*)(ws + WS_G01), (bf16*)p.out + (size_t)16 * MiB, p.b_gate};
    pg8::gemm_phase<pg8::EpiProjA, pg8::StaticOrder, true, true>(lds, g, S, E);
}
constexpr int QW_TOPK = 3600, QW_ATTN = 3664;
__device__ __forceinline__ unsigned queue_next(unsigned* ctr, LAS unsigned char* lds) {
    volatile LAS unsigned* slot = (volatile LAS unsigned*)(lds + 32768 + 256);
    if (threadIdx.x == 0) *slot = __hip_atomic_fetch_add(ctr, 1u, __ATOMIC_RELAXED, __HIP_MEMORY_SCOPE_AGENT);
    __syncthreads();
    const unsigned u = *slot;
    __syncthreads();
    return u;
}
__device__ __forceinline__ void phase2(const Params& p, LAS unsigned char* lds, int G) {
    unsigned char* ws = p.ws; const int c = (int)blockIdx.x;
    const int gtid = c * NTHR + opaque_tid(), gthreads = G * NTHR;
    headnorm<128>((bf16*)(ws + WS_MKV), 1024, MT, 4, p.k_norm_m, 1.0f, gtid, gthreads);
    conv_branch((const bf16*)p.out, p.conv_w, (bf16*)p.out, gtid, gthreads);
#if TPROBE >= 0
    if (blockIdx.x == 0 && threadIdx.x == 0) ((unsigned long long*)(p.ws + 46 * MiB))[10] = __builtin_amdgcn_s_memrealtime();
#endif
    unsigned* ctr = (unsigned*)(ws + 45 * MiB) + 3600;
    const unsigned nunits = NB * (SEQ / 16);
    for (;;) {
        const unsigned u = queue_next(ctr, lds + 98304);
        if (u >= nunits) break;
        if (!SKIP_TOPK) topk_unit2(lds, (const bf16*)(ws + WS_QI), (const bf16*)(ws + WS_KIWI), (const float*)(ws + WS_KIWI + 2 * MiB), (u64*)(ws + WS_MASK), (int)(u & 3u), 255 - (int)(u >> 2));
    }
}
__device__ __forceinline__ void phase3(const Params& p, LAS unsigned char* lds, int G) {
    unsigned char* ws = p.ws;
    float gq = 0.f, gk = 0.f;
    for (int i = 0; i < 64; ++i) { gq = fmaxf(gq, fabsf(p.q_norm_a[i])); gk = fmaxf(gk, fabsf(p.k_norm_a[i])); }
    const float smax = 64.0f * 0.125f * LOG2E * gq * gk * 1.02f + 0.5f;
    unsigned* ctr = (unsigned*)(ws + 45 * MiB) + QW_ATTN;
    for (;;) {
        const unsigned u = queue_next(ctr, lds);
        if (u >= 864u) break;
        unsigned ur = u;
        if (u >= 352u && u < 608u) ur = u + 256u; else if (u >= 608u) ur = u - 256u;
        if (ur < 96u) {
            const int h = 7 - (int)(ur >> 5), qb = 31 - (int)((ur & 31u) >> 2), b = (int)(ur & 3u);
            const float slope2 = exp2f(-(float)(h + 1)) * LOG2E;
            const size_t row0 = (size_t)b * SEQ + qb * 128;
            bf16* q = (bf16*)(ws + WS_QA) + row0 * 512 + h * 64;
            if (!SKIP_FA) flash_unit_c(lds, q, (const bf16*)(ws + WS_KA) + (size_t)b * SEQ * 512 + h * 64, (const bf16*)(ws + WS_VA) + (size_t)b * SEQ * 512 + h * 64,
                                       q, (const bf16*)(ws + WS_ZA) + row0 * 512 + h * 64, qb, (const u64*)(ws + WS_MASK) + (size_t)b * 64 * SEQ + (row0 - (size_t)b * SEQ), slope2, smax);
        } else if (ur < 608u) {
            const unsigned uu = ur - 96u;
            const int h = 7 - (int)(uu >> 6), qb = 15 - (int)((uu & 63u) >> 2), b = (int)(uu & 3u);
            if (!(h >= 5 && qb >= 12)) {
            const float slope2 = exp2f(-(float)(h + 1)) * LOG2E;
            const size_t row0 = (size_t)b * SEQ + qb * 256;
            bf16* q = (bf16*)(ws + WS_QA) + row0 * 512 + h * 64;
            if (!SKIP_FA) flash_unit_a(lds, q, (const bf16*)(ws + WS_KA) + (size_t)b * SEQ * 512 + h * 64, (const bf16*)(ws + WS_VA) + (size_t)b * SEQ * 512 + h * 64,
                                       q, (const bf16*)(ws + WS_ZA) + row0 * 512 + h * 64, qb, (const u64*)(ws + WS_MASK) + (size_t)b * 64 * SEQ + (row0 - (size_t)b * SEQ), slope2, smax);
            }
        } else {
            const int v = (int)ur - 608, b2 = v >> 6, hm = (v >> 4) & 3, qb = v & 15; const size_t row0 = (size_t)b2 * SEQ + qb * 256;
            bf16* q = (bf16*)(ws + WS_QM) + row0 * 512 + hm * 128;
            const bf16* kv = (const bf16*)(ws + WS_MKV) + (size_t)b2 * MEML * 1024 + hm * 128;
            if (!SKIP_FM) flash_unit_m(lds, q, kv, kv + 512, q, (const bf16*)(ws + WS_ZM) + row0 * 512 + hm * 128, p.q_norm_m);
        }
    }
}
__device__ __forceinline__ void phase4(const Params&, LAS unsigned char*, int) {}
__device__ __forceinline__ void phase5(const Params& p, LAS unsigned char* lds, int G) {
    unsigned char* ws = p.ws; const int c = (int)blockIdx.x;
    const long sA = (long)(WS_QM - WS_QA) / 2;
    pg8::Gemm g{(const bf16*)(ws + WS_QA), (const bf16*)(ws + WS_WOA), T, 1024, 512, sA, (long)(WS_WOM - WS_WOA) / 2, ((const char*)p.out - (const char*)(ws + WS_QA)) / 2 - 2 * sA};
    pg8::StaticOrder S; S.init(T, 1024, G, c, 3);
    pg8::EpiMerge E{(const bf16*)(ws + WS_G01), (const bf16*)p.out + (size_t)16 * MiB, (bf16*)(ws + WS_MERGED)};
    pg8::gemm_phase<pg8::EpiMerge, pg8::StaticOrder, true, true>(lds, g, S, E);
}
__device__ __forceinline__ void phase6(const Params& p, LAS unsigned char* lds, int G) {
    unsigned char* ws = p.ws; const int c = (int)blockIdx.x;
    pg8::Gemm g{(const bf16*)(ws + WS_MERGED), (const bf16*)(ws + WS_WO), T, 1024, DM, 0, 0, 0};
    pg8::StaticOrder S; S.init(T, 1024, G, c);
    pg8::EpiResF32 E{p.x, p.out, 1024};
    pg8::gemm_phase<pg8::EpiResF32, pg8::StaticOrder, false, true>(lds, g, S, E);
}

template <int PH> __device__ __forceinline__ void run_phase(const Params& p, LAS unsigned char* lds, int G) {
    if (PH == 0) { const int bx = blockIdx.x; const int vcu = (G % 8 == 0) ? (bx % 8) * (G / 8) + bx / 8 : bx; phase0(p, lds, vcu, G); }
    if (PH == 1) phase1(p, lds, G);
    if (PH == 2) phase2(p, lds, G);
    if (PH == 3) phase3(p, lds, G);
    if (PH == 4) phase4(p, lds, G);
    if (PH == 5) phase5(p, lds, G);
    if (PH == 6) phase6(p, lds, G);
}

template <int PH> __global__ void __launch_bounds__(NTHR, 2) phase_kernel(Params p) {
    extern __shared__ __attribute__((aligned(16))) unsigned char lds_raw[];
    run_phase<PH>(p, (LAS unsigned char*)lds_raw, (int)gridDim.x);
}
#if FUSED
__global__ void __launch_bounds__(NTHR, 2) mega_kernel(Params p) {
    extern __shared__ __attribute__((aligned(16))) unsigned char lds_raw[];
    cg::grid_group grid = cg::this_grid();
    LAS unsigned char* lds = (LAS unsigned char*)lds_raw; const int G = (int)gridDim.x;
    if (p.ws == nullptr) grid.sync();
    volatile LAS unsigned* bst = (volatile LAS unsigned*)(lds + LDS_BARST);
    if (threadIdx.x < 2) bst[threadIdx.x] = 0u;
    __syncthreads();
    XcdBarrier bar = xcd_barrier_post((unsigned*)(p.ws + WS_CTL), bst);
#define GSYNC() xcd_barrier(bar)
#if TPROBE >= 0
    unsigned long long* ts = (unsigned long long*)(p.ws + 46 * MiB);
#define STAMP(k) do { if (blockIdx.x == 0 && threadIdx.x == 0) ts[k] = __builtin_amdgcn_s_memrealtime(); } while (0)
    if (blockIdx.x == 0 && threadIdx.x == 0) { ts[12] = 0; ts[13] = 0; ts[14] = 0; ts[15] = ~0ull; }
    GSYNC();
#else
#define STAMP(k) do {} while (0)
#endif
    STAMP(0);
    run_phase<0>(p, lds, G); GSYNC(); STAMP(1);
    run_phase<1>(p, lds, G); GSYNC(); STAMP(2);
#if TPROBE >= 0
    unsigned long long tb0 = __builtin_amdgcn_s_memrealtime();
    run_phase<2>(p, lds, G);
    if (threadIdx.x == 0) { const unsigned long long dt = __builtin_amdgcn_s_memrealtime() - tb0; atomicMax(&ts[14], dt); atomicMin(&ts[15], dt); }
    GSYNC(); STAMP(3);
#else
    run_phase<2>(p, lds, G); GSYNC(); STAMP(3);
#endif
    run_phase<3>(p, lds, G); GSYNC(); STAMP(4);
    STAMP(5);
    run_phase<5>(p, lds, G); GSYNC(); STAMP(6);
    run_phase<6>(p, lds, G);
#if TPROBE >= 0
    GSYNC(); STAMP(7);
    GSYNC(); STAMP(8);
    GSYNC();
    {
        float us;
        if (TPROBE <= 6) us = (float)(ts[TPROBE + 1] - ts[TPROBE]) * 0.01f;
        else if (TPROBE == 7) us = (float)(ts[7] - ts[0]) * 0.01f * 0.1f;
        else if (TPROBE == 8) us = 100.f;
        else if (TPROBE == 14) us = (float)ts[14] * 0.01f;
        else if (TPROBE == 15) us = (float)ts[15] * 0.01f;
        else if (TPROBE == 12) us = (float)ts[12] * 0.01f;
        else if (TPROBE == 13) us = (float)ts[13] * 0.01f;
        else if (TPROBE == 10) us = (float)(ts[10] - ts[2]) * 0.01f;
        else us = (float)(ts[8] - ts[7]) * 0.01f * 10.f;
        const float a = sqrtf(us * 1e-5f);
        for (long i = (long)blockIdx.x * NTHR + threadIdx.x; i < (long)T * DM; i += (long)G * NTHR) p.out[i] += (i & 1) ? a : -a;
    }
#endif
}
#endif

template <int PH> static void launch_phase(const Params& p, int grid, hipStream_t stream) {
    static bool attr = false;
    if (!attr) { (void)hipFuncSetAttribute((const void*)phase_kernel<PH>, hipFuncAttributeMaxDynamicSharedMemorySize, LDS_BYTES); attr = true; }
    hipLaunchKernelGGL(phase_kernel<PH>, dim3(grid), dim3(NTHR), LDS_BYTES, stream, p);
}

extern "C" void kernel_launch(void* const* d_in, const int* in_sizes, int n_in, void* d_out, int out_size, void* d_ws, size_t ws_size, hipStream_t stream) {
    static int grid = 0;
    if (grid == 0) {
        int dev = 0, cus = 0;
        if (hipGetDevice(&dev) != hipSuccess || hipDeviceGetAttribute(&cus, hipDeviceAttributeMultiprocessorCount, dev) != hipSuccess) { fprintf(stderr, "kernel_launch: device query failed\n"); grid = -1; return; }
        if (n_in != 16 || out_size != T * DM || ws_size < 256 * MiB) { fprintf(stderr, "kernel_launch: unexpected shapes (n_in %d out %d ws %zu)\n", n_in, out_size, ws_size); grid = -1; return; }
#if FUSED
        int per_cu = 0;
        (void)hipFuncSetAttribute((const void*)mega_kernel, hipFuncAttributeMaxDynamicSharedMemorySize, LDS_BYTES);
        if (hipOccupancyMaxActiveBlocksPerMultiprocessor(&per_cu, (const void*)mega_kernel, NTHR, LDS_BYTES) != hipSuccess || per_cu < 1) { fprintf(stderr, "kernel_launch: occupancy query says %d\n", per_cu); grid = -1; return; }
        (void)hipGetLastError();
#endif
        grid = cus;
    }
    if (grid < 0) return;
    Params p{};
    p.x = (const float*)d_in[0]; p.mem = (const float*)d_in[1]; p.norm_g = (const float*)d_in[2]; p.mem_norm_g = (const float*)d_in[3]; p.w_in = (const float*)d_in[4]; p.b_gate = (const float*)d_in[5];
    p.w_mem_kv = (const float*)d_in[6]; p.q_norm_a = (const float*)d_in[7]; p.k_norm_a = (const float*)d_in[8]; p.q_norm_m = (const float*)d_in[9]; p.k_norm_m = (const float*)d_in[10]; p.conv_w = (const float*)d_in[11];
    p.w_out_a = (const float*)d_in[12]; p.w_out_b = (const float*)d_in[13]; p.w_out_m = (const float*)d_in[14]; p.w_o = (const float*)d_in[15];
    p.out = (float*)d_out; p.ws = (unsigned char*)d_ws;
#if FUSED
    (void)hipMemsetAsync((unsigned char*)d_ws + WS_CTL, 0, CTL_ZERO_BYTES, stream);
    void* args[] = {&p};
    hipError_t e = hipLaunchCooperativeKernel((const void*)mega_kernel, dim3(grid), dim3(NTHR), args, LDS_BYTES, stream);
    if (e != hipSuccess) fprintf(stderr, "cooperative launch failed: %s (grid %d)\n", hipGetErrorString(e), grid);
#else
    launch_phase<0>(p, grid, stream); launch_phase<1>(p, grid, stream); launch_phase<2>(p, grid, stream); launch_phase<3>(p, grid, stream);
    launch_phase<4>(p, grid, stream); launch_phase<5>(p, grid, stream); launch_phase<6>(p, grid, stream);
#endif
}
```

```cpp
#include <hip/hip_runtime.h>
#include <hip/hip_cooperative_groups.h>
#include <cstdio>
#include <cstdint>
namespace cg = cooperative_groups;
__device__ __forceinline__ int opaque_tid() { int t = (int)threadIdx.x; asm volatile("" : "+v"(t)); return t; }

#ifndef FUSED
#define FUSED 1
#endif
#ifndef TPROBE
#define TPROBE -1
#endif
#ifndef SKIP_TOPK
#define SKIP_TOPK 0
#endif
#ifndef SKIP_FA
#define SKIP_FA 0
#endif
#ifndef SKIP_FM
#define SKIP_FM 0
#endif

namespace pg8 {
#define PG8_LAS __attribute__((address_space(3)))
typedef unsigned short bf16_t;
typedef short bf16x8 __attribute__((ext_vector_type(8)));
typedef float f32x4 __attribute__((ext_vector_type(4)));
typedef unsigned u32x4 __attribute__((ext_vector_type(4)));
constexpr int BM = 256, BK = 64, HALF = 128, HTB = HALF * BK * 2  , STAGE_BYTES = 8 * HTB, NXCD = 8, WGM = 8;

__host__ __device__ __forceinline__ int lds_byte(int r, int c) { const int st = (r >> 4) * 2 + (c >> 5), rr = r & 15, cc = c & 31, ob = rr * 64 + cc * 2; return st * 1024 + (ob ^ (((ob >> 9) & 1) << 5)); }
__host__ __device__ __forceinline__ void stage_rc(int b, int& R, int& C) { const int st = b / 1024, sb = b % 1024, swz = sb ^ (((sb >> 9) & 1) << 5); R = (st >> 1) * 16 + swz / 64; C = (st & 1) * 32 + (swz % 64) / 2; }
__host__ __device__ __forceinline__ int perm32(int rho) { const int n = rho >> 4, i = rho & 15; return 8 * (i >> 2) + 4 * n + (i & 3); }

struct Unit { int pm, pn, br; };
struct Gemm { const bf16_t* A; const bf16_t* Bt; int M, N, K; long strideA, strideB, extraA2;
    __device__ __forceinline__ const bf16_t* a(int br) const { return A + (long)br * strideA + (br == 2 ? extraA2 : 0L); }
    __device__ __forceinline__ const bf16_t* b(int br) const { return Bt + (long)br * strideB; } };

__host__ __device__ __forceinline__ void tile_of(int L, int nM, int nN, int& pm, int& pn) {
    const int nwg = nM * nN; int wgid = L; { const int q = nwg / NXCD, r = nwg % NXCD, xcd = wgid % NXCD, off = wgid / NXCD; wgid = (xcd < r ? xcd * (q + 1) : r * (q + 1) + (xcd - r) * q) + off; }
    const int nig = WGM * nN, gid = wgid / nig, fm = gid * WGM, gsz = (nM - fm) < WGM ? (nM - fm) : WGM;
    pm = fm + ((wgid % nig) % gsz); pn = (wgid % nig) / gsz;
}
struct StaticOrder {
    int nM, nN, nwg, G, c, nsub, nM2, nN2;
    __host__ __device__ void init(int M, int N, int G_, int c_, int nsub_ = 1, int M2 = 0, int N2 = 0) { nM = M / BM; nN = N / BM; nwg = nM * nN; G = G_; c = c_; nsub = nsub_; nM2 = M2 / BM; nN2 = N2 / BM; }
    __host__ __device__ bool next(int i, Unit& u) const {
        const int ti = i / nsub; const long L = (long)ti * G + c; if (L >= nwg + nM2 * nN2) return false;
        if (L < nwg) { tile_of((int)L, nM, nN, u.pm, u.pn); u.br = i - ti * nsub; }
        else { tile_of((int)L - nwg, nM2, nN2, u.pm, u.pn); u.br = 1; }
        return true;
    }
    __device__ __forceinline__ void a_ready(const Unit&) const {}
    __device__ __forceinline__ void done(const Unit&) const {}
};

typedef float f32x2_t __attribute__((ext_vector_type(2))); typedef __bf16 bf16x2_t __attribute__((ext_vector_type(2)));
__device__ __forceinline__ unsigned cvt_pk_bf16(float lo, float hi) { f32x2_t v = {lo, hi}; bf16x2_t b = __builtin_convertvector(v, bf16x2_t); return __builtin_bit_cast(unsigned, b); }
__device__ __forceinline__ float bf_lo(unsigned w) { return __uint_as_float(w << 16); }
__device__ __forceinline__ float bf_hi(unsigned w) { return __uint_as_float(w & 0xffff0000u); }


struct EpiProjA {
    static constexpr bool PERM = true, AFTER_DRAIN = false;
    unsigned char* ws; bf16_t* brb; const float* rstd; const float* gq; const float* gk; bf16_t* g01; bf16_t* g2; const float* bgate;
    __device__ __forceinline__ bool keep(const Unit&) const { return false; }
    __device__ __forceinline__ void operator()(f32x4 (&acc)[2][2][4][2], const Unit& u, int wr, int wc, int fr, int fq) const {
        bf16_t* base; int ldc, colt; const int pn = u.pn; const float* rs = rstd;
        if (u.br == 0 && pn >= 23) {
            const int pg = pn - 23; bf16_t* gb; int gld, gct;
            if (pg < 8) { gb = g01; gld = 2048; gct = pg * 256; } else { gb = g2; gld = 1024; gct = (pg - 8) * 256; }
            const int row0g = u.pm * BM + wr * 64 + fr, col0g = gct + wc * 32 + 8 * fq, bcol0 = pg * BM + wc * 32 + 8 * fq;
            f32x4 bv[2][2];
#pragma unroll
            for (int bj = 0; bj < 2; ++bj)
#pragma unroll
                for (int n = 0; n < 2; ++n) bv[bj][n] = *(const f32x4*)(bgate + bcol0 + bj * HALF + 4 * n);
#pragma unroll
            for (int ai = 0; ai < 2; ++ai)
#pragma unroll
                for (int m = 0; m < 4; ++m) { const int row = row0g + ai * HALF + m * 16; bf16_t* rowp = gb + (size_t)row * gld + col0g;
#pragma unroll
                    for (int bj = 0; bj < 2; ++bj) { f32x4 v0 = acc[ai][bj][m][0] + bv[bj][0], v1 = acc[ai][bj][m][1] + bv[bj][1];
#pragma unroll
                        for (int e = 0; e < 4; ++e) { v0[e] = __builtin_amdgcn_rcpf(1.0f + __builtin_amdgcn_exp2f(-1.4426950408889634f * v0[e])); v1[e] = __builtin_amdgcn_rcpf(1.0f + __builtin_amdgcn_exp2f(-1.4426950408889634f * v1[e])); }
                        u32x4 w; w.x = cvt_pk_bf16(v0[0], v0[1]); w.y = cvt_pk_bf16(v0[2], v0[3]); w.z = cvt_pk_bf16(v1[0], v1[1]); w.w = cvt_pk_bf16(v1[2], v1[3]);
                        *(u32x4*)(rowp + bj * HALF) = w; } }
            return; }
        if (u.br == 0 && pn < 4) {
            bf16_t* dst = (bf16_t*)(ws + ((size_t)(80 + 16 * (pn >> 1)) << 20)); const float* gn = (pn < 2) ? gq : gk; const float osc = (pn < 2) ? 0.125f * 1.4426950408889634f : 1.0f;
            f32x4 gv[2][2];
#pragma unroll
            for (int bj = 0; bj < 2; ++bj)
#pragma unroll
                for (int n = 0; n < 2; ++n) gv[bj][n] = *(const f32x4*)(gn + 32 * bj + 8 * fq + 4 * n);
            const int row0n = u.pm * BM + wr * 64 + fr, hcol = ((pn & 1) * 4 + wc) * 64 + 8 * fq;
#pragma unroll
            for (int ai = 0; ai < 2; ++ai)
#pragma unroll
                for (int m = 0; m < 4; ++m) { const int row = row0n + ai * HALF + m * 16; const float sc = 1.0f;
                    f32x4 v[2][2]; float ss = 0.f;
#pragma unroll
                    for (int bj = 0; bj < 2; ++bj)
#pragma unroll
                        for (int n = 0; n < 2; ++n) { v[bj][n] = acc[ai][bj][m][n] * sc; ss += (v[bj][n][0] * v[bj][n][0] + v[bj][n][1] * v[bj][n][1]) + (v[bj][n][2] * v[bj][n][2] + v[bj][n][3] * v[bj][n][3]); }
                    ss += __shfl_xor(ss, 16); ss += __shfl_xor(ss, 32);
                    const float r = osc / sqrtf(ss * (1.0f / 64.0f) + 1e-6f);
#pragma unroll
                    for (int bj = 0; bj < 2; ++bj) { const f32x4 a = v[bj][0] * gv[bj][0] * r, b = v[bj][1] * gv[bj][1] * r;
                        u32x4 w; w.x = cvt_pk_bf16(a[0], a[1]); w.y = cvt_pk_bf16(a[2], a[3]); w.z = cvt_pk_bf16(b[0], b[1]); w.w = cvt_pk_bf16(b[2], b[3]);
                        *(u32x4*)(dst + (size_t)row * 512 + hcol + 32 * bj) = w; } }
            return; }
        if (u.br == 1) { base = (bf16_t*)(ws + ((size_t)53 << 19)); ldc = 1024; colt = pn * 256; rs = rstd + 16384; }
        else if (pn < 10) { base = (bf16_t*)(ws + ((size_t)(80 + 16 * (pn >> 1)) << 20)); ldc = 512; colt = (pn & 1) * 256; }
        else if (pn == 10) {
            bf16_t* kic = (bf16_t*)(ws + ((size_t)37 << 20)); float* wic = (float*)(ws + ((size_t)39 << 20));
            const int row0k = u.pm * BM + wr * 64 + fr;
#pragma unroll
            for (int ai = 0; ai < 2; ++ai)
#pragma unroll
                for (int m = 0; m < 4; ++m) { const int row = row0k + ai * HALF + m * 16; const float sc = 1.0f;
                    const int col = wc * 32 + 8 * fq;
                    const f32x4 v0 = acc[ai][0][m][0] * sc, v1 = acc[ai][0][m][1] * sc;
                    if (col < 64) { u32x4 w; w.x = cvt_pk_bf16(v0[0], v0[1]); w.y = cvt_pk_bf16(v0[2], v0[3]); w.z = cvt_pk_bf16(v1[0], v1[1]); w.w = cvt_pk_bf16(v1[2], v1[3]); *(u32x4*)(kic + ((size_t)((row >> 5) * 4 + (col >> 4)) * 64 + ((col >> 3) & 1) * 32 + (row & 31)) * 8) = w; }
                    else if (col == 64) { const float is = 0.125f * 0.35355339059327373f; *(f32x4*)(wic + (size_t)row * 8) = v0 * is; *(f32x4*)(wic + (size_t)row * 8 + 4) = v1 * is; } }
            return; }
        else if (pn < 19) {
            const int tl = pn - 11; bf16_t* dst = brb + (tl < 4 ? (size_t)0 : (size_t)16384 * 512);
            const int row0b = u.pm * BM + wr * 64 + fr, jc = 128 * (tl & 3) + wc * 32 + 8 * fq;
#pragma unroll
            for (int ai = 0; ai < 2; ++ai)
#pragma unroll
                for (int m = 0; m < 4; ++m) { const int row = row0b + ai * HALF + m * 16; const float sc = 1.0f;
                    f32x4 a0 = acc[ai][0][m][0] * sc, a1 = acc[ai][0][m][1] * sc, b0 = acc[ai][1][m][0] * sc, b1 = acc[ai][1][m][1] * sc;
                    if (tl < 4) {
#pragma unroll
                        for (int e = 0; e < 4; ++e) { b0[e] = b0[e] * __builtin_amdgcn_rcpf(1.0f + __builtin_amdgcn_exp2f(-1.4426950408889634f * b0[e])); b1[e] = b1[e] * __builtin_amdgcn_rcpf(1.0f + __builtin_amdgcn_exp2f(-1.4426950408889634f * b1[e])); } }
                    a0 = a0 * b0; a1 = a1 * b1;
                    u32x4 w; w.x = cvt_pk_bf16(a0[0], a0[1]); w.y = cvt_pk_bf16(a0[2], a0[3]); w.z = cvt_pk_bf16(a1[0], a1[1]); w.w = cvt_pk_bf16(a1[2], a1[3]);
                    *(u32x4*)(dst + (size_t)row * 512 + jc) = w; }
            return; }
        else { base = (bf16_t*)(ws + ((size_t)(160 + 16 * ((pn - 19) >> 1)) << 20)); ldc = 512; colt = ((pn - 19) & 1) * 256; }
        const int row0 = u.pm * BM + wr * 64 + fr, col0 = colt + wc * 32 + 8 * fq;
#pragma unroll
        for (int ai = 0; ai < 2; ++ai)
#pragma unroll
            for (int m = 0; m < 4; ++m) { const int row = row0 + ai * HALF + m * 16; const float sc = 1.0f; bf16_t* rowp = base + (size_t)row * ldc + col0;
#pragma unroll
                for (int bj = 0; bj < 2; ++bj) { const f32x4 v0 = acc[ai][bj][m][0] * sc, v1 = acc[ai][bj][m][1] * sc;
                    u32x4 w; w.x = cvt_pk_bf16(v0[0], v0[1]); w.y = cvt_pk_bf16(v0[2], v0[3]); w.z = cvt_pk_bf16(v1[0], v1[1]); w.w = cvt_pk_bf16(v1[2], v1[3]);
                    *(u32x4*)(rowp + bj * HALF) = w; } }
    }
};
struct EpiScale {
    static constexpr bool PERM = true, AFTER_DRAIN = false;
    bf16_t* O; int ldc; const float* rstd;
    __device__ __forceinline__ bool keep(const Unit&) const { return false; }
    __device__ __forceinline__ void operator()(f32x4 (&acc)[2][2][4][2], const Unit& u, int wr, int wc, int fr, int fq) const {
        const int row0 = u.pm * BM + wr * 64 + fr, col0 = u.pn * BM + wc * 32 + 8 * fq;
#pragma unroll
        for (int ai = 0; ai < 2; ++ai)
#pragma unroll
            for (int m = 0; m < 4; ++m) { const int row = row0 + ai * HALF + m * 16; const float sc = 1.0f; bf16_t* rowp = O + (size_t)row * ldc + col0;
#pragma unroll
                for (int bj = 0; bj < 2; ++bj) { const f32x4 v0 = acc[ai][bj][m][0] * sc, v1 = acc[ai][bj][m][1] * sc;
                    u32x4 w; w.x = cvt_pk_bf16(v0[0], v0[1]); w.y = cvt_pk_bf16(v0[2], v0[3]); w.z = cvt_pk_bf16(v1[0], v1[1]); w.w = cvt_pk_bf16(v1[2], v1[3]);
                    *(u32x4*)(rowp + bj * HALF) = w; } }
    }
};
__device__ __forceinline__ float sigmoidf_(float x) { return __builtin_amdgcn_rcpf(1.0f + __builtin_amdgcn_exp2f(-1.4426950408889634f * x)); }
struct EpiMerge {
    static constexpr bool PERM = true, AFTER_DRAIN = false;
    const bf16_t* g01; const bf16_t* g2; bf16_t* O;
    __device__ __forceinline__ bool keep(const Unit& u) const { return u.br != 2; }
    __device__ __forceinline__ void operator()(f32x4 (&acc)[2][2][4][2], const Unit& u, int wr, int wc, int fr, int fq) const {
        const int row0 = u.pm * BM + wr * 64 + fr, col0 = u.pn * BM + wc * 32 + 8 * fq; const int br = u.br;
        const bf16_t* nb = g01; int nld = 2048; const bf16_t* db = g2; int dld = 1024;
        if (br == 1) { nb = g2; nld = 1024; db = g01 + 1024; dld = 2048; }
        int dcm = ~0;
        if (br == 2) { nb = g01 + 1024; db = nb; dld = 0; dcm = 0; }
#pragma unroll
        for (int ai = 0; ai < 2; ++ai) {
            u32x4 num[4][2], den[4][2];
#pragma unroll
            for (int m = 0; m < 4; ++m)
#pragma unroll
                for (int bj = 0; bj < 2; ++bj) { const int row = row0 + ai * HALF + m * 16, col = col0 + bj * HALF;
                    num[m][bj] = *(const u32x4*)(nb + (size_t)row * nld + col);
                    den[m][bj] = *(const u32x4*)(db + (size_t)row * dld + (col & dcm)); }
#pragma unroll
            for (int m = 0; m < 4; ++m)
#pragma unroll
                for (int bj = 0; bj < 2; ++bj) { const int row = row0 + ai * HALF + m * 16, col = col0 + bj * HALF;
                    float f[8];
#pragma unroll
                    for (int e = 0; e < 4; ++e) { const unsigned nw = num[m][bj][e], dw = den[m][bj][e];
                        f[2 * e] = (br == 2) ? bf_lo(nw) : bf_lo(nw) * __builtin_amdgcn_rcpf(bf_lo(dw)); f[2 * e + 1] = (br == 2) ? bf_hi(nw) : bf_hi(nw) * __builtin_amdgcn_rcpf(bf_hi(dw)); }
                    f32x4 v0 = acc[ai][bj][m][0], v1 = acc[ai][bj][m][1];
                    v0[0] *= f[0]; v0[1] *= f[1]; v0[2] *= f[2]; v0[3] *= f[3]; v1[0] *= f[4]; v1[1] *= f[5]; v1[2] *= f[6]; v1[3] *= f[7];
                    acc[ai][bj][m][0] = v0; acc[ai][bj][m][1] = v1;
                    if (br == 2) { u32x4 w; w.x = cvt_pk_bf16(v0[0], v0[1]); w.y = cvt_pk_bf16(v0[2], v0[3]); w.z = cvt_pk_bf16(v1[0], v1[1]); w.w = cvt_pk_bf16(v1[2], v1[3]);
                        *(u32x4*)(O + (size_t)row * 1024 + col) = w; } }
            asm volatile("" ::: "memory");
        }
    }
};
struct EpiResF32 {
    static constexpr bool PERM = true, AFTER_DRAIN = false;
    const bf16_t* xb; const float* rms; float* out; int ldc;
    __device__ __forceinline__ bool keep(const Unit&) const { return false; }
    __device__ __forceinline__ void operator()(f32x4 (&acc)[2][2][4][2], const Unit& u, int wr, int wc, int fr, int fq) const {
        const int row0 = u.pm * BM + wr * 64 + fr, col0 = u.pn * BM + wc * 32 + 8 * fq;
        float rn[2][4];
#pragma unroll
        for (int ai = 0; ai < 2; ++ai)
#pragma unroll
            for (int m = 0; m < 4; ++m) rn[ai][m] = rms[row0 + ai * HALF + m * 16];
#pragma unroll
        for (int ai = 0; ai < 2; ++ai) {
            u32x4 bs[4][2];
#pragma unroll
            for (int m = 0; m < 4; ++m)
#pragma unroll
                for (int bj = 0; bj < 2; ++bj) bs[m][bj] = *(const u32x4*)(xb + (size_t)(row0 + ai * HALF + m * 16) * ldc + col0 + bj * HALF);
            asm volatile("" ::: "memory");
#pragma unroll
            for (int m = 0; m < 4; ++m) { const float r = rn[ai][m];
#pragma unroll
                for (int bj = 0; bj < 2; ++bj) { const u32x4 w = bs[m][bj]; const f32x4 a0 = acc[ai][bj][m][0], a1 = acc[ai][bj][m][1]; float* op = out + (size_t)(row0 + ai * HALF + m * 16) * ldc + col0 + bj * HALF;
                    f32x4 o0, o1;
                    o0.x = __uint_as_float(w.x << 16) * r + a0.x; o0.y = __uint_as_float(w.x & 0xffff0000u) * r + a0.y; o0.z = __uint_as_float(w.y << 16) * r + a0.z; o0.w = __uint_as_float(w.y & 0xffff0000u) * r + a0.w;
                    o1.x = __uint_as_float(w.z << 16) * r + a1.x; o1.y = __uint_as_float(w.z & 0xffff0000u) * r + a1.y; o1.z = __uint_as_float(w.w << 16) * r + a1.z; o1.w = __uint_as_float(w.w & 0xffff0000u) * r + a1.w;
                    *(f32x4*)op = o0; *(f32x4*)(op + 4) = o1; } }
            asm volatile("" ::: "memory");
        }
    }
};

template <class Epi, class Sched, bool ALIGN_EPI = false, bool SP2 = false>
__device__ __forceinline__ void gemm_phase(PG8_LAS unsigned char* lds, const Gemm g, const Sched& S, const Epi& E) {
    const int tid = opaque_tid(), wid = __builtin_amdgcn_readfirstlane(tid >> 6), lane = tid & 63, wr = wid >> 2, wc = wid & 3, fr = lane & 15, fq = lane >> 4;
    const int K = g.K, nt = K / BK;
    unsigned voffA[2], voffB[2];
#pragma unroll
    for (int i = 0; i < 2; ++i) { int R, C; stage_rc(tid * 16 + i * 8192, R, C); const int Rb = Epi::PERM ? ((R & ~31) + perm32(R & 31)) : R;
        voffA[i] = (unsigned)(R * K + C) * 2u; voffB[i] = (unsigned)(Rb * K + C) * 2u; }
    const size_t kstep = (size_t)(BK * 2);
    const size_t hstep = (size_t)HALF * K * 2;
    const size_t tstep = 2 * hstep;
    const unsigned ldsw = (unsigned)wid * 1024u;
    const int aoff = lds_byte(wr * 64 + fr, fq * 8), boff = lds_byte(wc * 32 + fr, fq * 8);
#define PG8_SA(b, h) (((b) * 2 + (h)) * HTB)
#define PG8_SB(b, h) ((4 + (b) * 2 + (h)) * HTB)
#define PG8_STAGE(bufoff, gbase, voff) do { _Pragma("unroll") for (int _i = 0; _i < 2; ++_i) \
        __builtin_amdgcn_global_load_lds((const unsigned*)((const char*)(gbase) + (voff)[_i]), (PG8_LAS unsigned*)(lds + (bufoff) + ldsw + _i * 8192), 16, 0, 0); } while (0)
#define PG8_LDA(dst, b, h) do { _Pragma("unroll") for (int m = 0; m < 4; ++m) _Pragma("unroll") for (int k = 0; k < 2; ++k) dst[m][k] = *(const PG8_LAS bf16x8*)(lds + PG8_SA(b, h) + aoff + m * 2048 + k * 1024); } while (0)
#define PG8_LDB(dst, b, h) do { _Pragma("unroll") for (int n = 0; n < 2; ++n) _Pragma("unroll") for (int k = 0; k < 2; ++k) dst[n][k] = *(const PG8_LAS bf16x8*)(lds + PG8_SB(b, h) + boff + n * 2048 + k * 1024); } while (0)
#define PG8_MMA(ai, bj, At, Bt) do { __builtin_amdgcn_s_setprio(1); _Pragma("unroll") for (int m = 0; m < 4; ++m) _Pragma("unroll") for (int n = 0; n < 2; ++n) _Pragma("unroll") for (int k = 0; k < 2; ++k) \
        acc[ai][bj][m][n] = __builtin_amdgcn_mfma_f32_16x16x32_bf16(Bt[n][k], At[m][k], acc[ai][bj][m][n], 0, 0, 0); __builtin_amdgcn_s_setprio(0); } while (0)
#define PG8_WAIT_V(n) asm volatile("s_waitcnt vmcnt(" #n ")" ::: "memory")
#define PG8_WAIT_L(n) asm volatile("s_waitcnt lgkmcnt(" #n ")" ::: "memory")
#define PG8_BAR __builtin_amdgcn_s_barrier()
#define PG8_SCHED __builtin_amdgcn_sched_barrier(0)
    Unit cur, nxt; int ui = 0;
    if (!S.next(0, cur)) return;
    f32x4 acc[2][2][4][2];
#pragma unroll
    for (int a = 0; a < 2; ++a)
#pragma unroll
        for (int b = 0; b < 2; ++b)
#pragma unroll
            for (int m = 0; m < 4; ++m)
#pragma unroll
                for (int n = 0; n < 2; ++n) acc[a][b][m][n] = (f32x4){0.f, 0.f, 0.f, 0.f};
    bf16x8 At[4][2], B0[2][2], B1[2][2];
    const char* cA = (const char*)g.a(cur.br) + (size_t)cur.pm * tstep; const char* cB = (const char*)g.b(cur.br) + (size_t)cur.pn * tstep;
    S.a_ready(cur);
    if constexpr (SP2) {
        PG8_STAGE(PG8_SB(0, 0), cB, voffB); PG8_STAGE(PG8_SB(0, 1), cB + hstep, voffB); PG8_STAGE(PG8_SA(0, 0), cA, voffA); PG8_STAGE(PG8_SA(0, 1), cA + hstep, voffA);
        if (wr == 1) PG8_BAR;
        PG8_WAIT_V(2); PG8_BAR;
        PG8_STAGE(PG8_SB(1, 0), cB + kstep, voffB); PG8_STAGE(PG8_SA(1, 0), cA + kstep, voffA); PG8_STAGE(PG8_SB(1, 1), cB + hstep + kstep, voffB);
        PG8_WAIT_V(6); PG8_BAR;
    } else {
        PG8_STAGE(PG8_SB(0, 0), cB, voffB); PG8_STAGE(PG8_SA(0, 0), cA, voffA); PG8_STAGE(PG8_SB(0, 1), cB + hstep, voffB); PG8_STAGE(PG8_SA(0, 1), cA + hstep, voffA);
        if (wr == 1) PG8_BAR;
        PG8_WAIT_V(4); PG8_BAR;
        PG8_STAGE(PG8_SB(1, 0), cB + kstep, voffB); PG8_STAGE(PG8_SA(1, 0), cA + kstep, voffA); PG8_STAGE(PG8_SB(1, 1), cB + hstep + kstep, voffB);
        PG8_WAIT_V(6); PG8_BAR;
    }
    for (;;) {
        const bool has_next = S.next(ui + 1, nxt);
        const char* nA = has_next ? (const char*)g.a(nxt.br) + (size_t)nxt.pm * tstep : cA; const char* nB = has_next ? (const char*)g.b(nxt.br) + (size_t)nxt.pn * tstep : cB;
        for (int t = 0; t < nt; t += 2) {
            const bool last = (t == nt - 2);
            const char* a1 = cA + (size_t)(t + 1) * kstep;
            const char* a2 = last ? nA : cA + (size_t)(t + 2) * kstep; const char* b2 = last ? nB : cB + (size_t)(t + 2) * kstep;
            const char* a3 = a2 + kstep; const char* b3 = b2 + kstep;
            if (last && has_next) S.a_ready(nxt);
            if constexpr (SP2) {
            PG8_LDB(B0, 0, 0); PG8_LDB(B1, 0, 1); PG8_SCHED; PG8_LDA(At, 0, 0); PG8_STAGE(PG8_SA(1, 1), a1 + hstep, voffA);
            PG8_WAIT_V(8); PG8_WAIT_L(0); PG8_BAR; PG8_MMA(0, 0, At, B0); PG8_MMA(0, 1, At, B1); PG8_BAR; PG8_SCHED;
            PG8_LDA(At, 0, 1); PG8_STAGE(PG8_SB(0, 0), b2, voffB); PG8_STAGE(PG8_SB(0, 1), b2 + hstep, voffB); PG8_STAGE(PG8_SA(0, 0), a2, voffA);
            PG8_WAIT_V(8); PG8_WAIT_L(0); PG8_BAR; PG8_MMA(1, 0, At, B0); PG8_MMA(1, 1, At, B1); PG8_BAR; PG8_SCHED;
            PG8_LDB(B0, 1, 0); PG8_LDB(B1, 1, 1); PG8_SCHED; PG8_LDA(At, 1, 0); PG8_STAGE(PG8_SA(0, 1), a2 + hstep, voffA);
            PG8_WAIT_V(8); PG8_WAIT_L(0); PG8_BAR; PG8_MMA(0, 0, At, B0); PG8_MMA(0, 1, At, B1); PG8_BAR; PG8_SCHED;
            PG8_LDA(At, 1, 1); PG8_STAGE(PG8_SB(1, 0), b3, voffB); PG8_STAGE(PG8_SB(1, 1), b3 + hstep, voffB); PG8_STAGE(PG8_SA(1, 0), a3, voffA);
            PG8_WAIT_V(8); PG8_WAIT_L(0); PG8_BAR; PG8_MMA(1, 0, At, B0); PG8_MMA(1, 1, At, B1); PG8_BAR; PG8_SCHED;
            } else {
            PG8_LDB(B0, 0, 0); PG8_SCHED; PG8_LDA(At, 0, 0); PG8_STAGE(PG8_SA(1, 1), a1 + hstep, voffA);
            PG8_WAIT_L(8); PG8_BAR; PG8_WAIT_L(0); PG8_MMA(0, 0, At, B0); PG8_BAR; PG8_SCHED;
            PG8_LDB(B1, 0, 1); PG8_STAGE(PG8_SB(0, 0), b2, voffB);
            PG8_BAR; PG8_WAIT_L(0); PG8_MMA(0, 1, At, B1); PG8_BAR;
            PG8_LDA(At, 0, 1); PG8_STAGE(PG8_SA(0, 0), a2, voffA);
            PG8_BAR; PG8_WAIT_L(0); PG8_MMA(1, 0, At, B0); PG8_BAR; PG8_SCHED;
            PG8_STAGE(PG8_SB(0, 1), b2 + hstep, voffB);
            PG8_WAIT_V(6); PG8_BAR; PG8_MMA(1, 1, At, B1); PG8_BAR;
            PG8_LDB(B0, 1, 0); PG8_SCHED; PG8_LDA(At, 1, 0); PG8_STAGE(PG8_SA(0, 1), a2 + hstep, voffA);
            PG8_WAIT_L(8); PG8_BAR; PG8_WAIT_L(0); PG8_MMA(0, 0, At, B0); PG8_BAR; PG8_SCHED;
            PG8_LDB(B1, 1, 1); PG8_STAGE(PG8_SB(1, 0), b3, voffB);
            PG8_BAR; PG8_WAIT_L(0); PG8_MMA(0, 1, At, B1); PG8_BAR;
            PG8_LDA(At, 1, 1); PG8_STAGE(PG8_SA(1, 0), a3, voffA);
            PG8_BAR; PG8_WAIT_L(0); PG8_MMA(1, 0, At, B0); PG8_BAR; PG8_SCHED;
            PG8_STAGE(PG8_SB(1, 1), b3 + hstep, voffB);
            PG8_WAIT_V(6); PG8_BAR; PG8_MMA(1, 1, At, B1); PG8_BAR;
            }
        }
        if constexpr (ALIGN_EPI) { if (wr == 0) PG8_BAR; }
        if constexpr (!Epi::AFTER_DRAIN) { E(acc, cur, wr, wc, fr, fq); S.done(cur); }
        if (!has_next) break;
        if (!E.keep(cur)) {
#pragma unroll
        for (int a = 0; a < 2; ++a)
#pragma unroll
            for (int b = 0; b < 2; ++b)
#pragma unroll
                for (int m = 0; m < 4; ++m)
#pragma unroll
                    for (int n = 0; n < 2; ++n) acc[a][b][m][n] = (f32x4){0.f, 0.f, 0.f, 0.f};
        }
        cur = nxt; cA = nA; cB = nB; ++ui;
        if constexpr (ALIGN_EPI) { if (wr == 1) PG8_BAR; }
    }
    PG8_WAIT_V(0);
    if constexpr (!ALIGN_EPI) { if (wr == 0) PG8_BAR; }
    PG8_BAR;
    if constexpr (Epi::AFTER_DRAIN) { E.fused(acc, cur, wr, wc, fr, fq, lds, wid, lane); S.done(cur); }
#undef PG8_SA
#undef PG8_SB
#undef PG8_STAGE
#undef PG8_LDA
#undef PG8_LDB
#undef PG8_MMA
#undef PG8_WAIT_V
#undef PG8_WAIT_L
#undef PG8_BAR
#undef PG8_SCHED
}
}

#define LAS __attribute__((address_space(3)))
typedef unsigned short bf16;
typedef short bf16x8 __attribute__((ext_vector_type(8)));
typedef short s16x4 __attribute__((ext_vector_type(4)));
typedef float f32x4 __attribute__((ext_vector_type(4)));
typedef float f32x16 __attribute__((ext_vector_type(16)));
typedef unsigned u32x4 __attribute__((ext_vector_type(4)));
typedef unsigned u32x2 __attribute__((ext_vector_type(2)));
typedef unsigned long long u64;

constexpr int NB = 4, SEQ = 4096, DM = 1024, T = NB * SEQ, MEML = 256, MT = NB * MEML;
constexpr int NIN_SRC = 8776, N1A = 5888, N1B = 3072, NIN = N1A + N1B;
constexpr int GAP0 = 2632, GAPLEN = 184;
constexpr float RMS_EPS = 1e-6f, LOG2E = 1.4426950408889634f;
constexpr int NWAVES = 8, NTHR = 512;
constexpr int LDS_BYTES = 147456;

constexpr size_t MiB = (size_t)1 << 20;
constexpr size_t WS_WIN = 0, WS_WMKV = 35 * MiB / 2, WS_WOA = 39 * MiB / 2, WS_WOM = 41 * MiB / 2, WS_WOB = 43 * MiB / 2, WS_WO = 45 * MiB / 2, WS_MEMB = 49 * MiB / 2, WS_MKV = 53 * MiB / 2;
constexpr size_t WS_RSTDX = 57 * MiB / 2, WS_RSTDM = WS_RSTDX + 65536;
constexpr size_t WS_MASK = 29 * MiB, WS_KIWI = 37 * MiB, WS_XB = 48 * MiB;
constexpr size_t WS_QA = 80 * MiB, WS_KA = 96 * MiB, WS_VA = 112 * MiB, WS_ZA = 128 * MiB, WS_QI = 144 * MiB, WS_QM = 160 * MiB, WS_ZM = 176 * MiB, WS_XBR = 240 * MiB;
static_assert(WS_WOB - WS_WOM == WS_WOM - WS_WOA, "uniform stride of the three out-projection weights");
constexpr size_t WS_G01 = 192 * MiB  , WS_MERGED = WS_ZA  ;
static_assert((size_t)NIN * DM * 2 == 35 * MiB / 2, "w_in copy size");

struct Params {
    const float *x, *mem, *norm_g, *mem_norm_g, *w_in, *b_gate, *w_mem_kv, *q_norm_a, *k_norm_a, *q_norm_m, *k_norm_m, *conv_w, *w_out_a, *w_out_b, *w_out_m, *w_o;
    float* out; unsigned char* ws;
};

__device__ __forceinline__ unsigned f2bf(float f) { unsigned u = __builtin_bit_cast(unsigned, f); return (u + 0x7fffu + ((u >> 16) & 1u)) >> 16; }
__device__ __forceinline__ unsigned pk2(float lo, float hi) { return f2bf(lo) | (f2bf(hi) << 16); }
__device__ __forceinline__ float bflo(unsigned w) { return __uint_as_float(w << 16); }
__device__ __forceinline__ float bfhi(unsigned w) { return __uint_as_float(w & 0xffff0000u); }
__device__ __forceinline__ float bf2f(bf16 h) { return __uint_as_float((unsigned)h << 16); }
__device__ __forceinline__ float wave_sum(float v) {
#pragma unroll
    for (int o = 1; o < 64; o <<= 1) v += __shfl_xor(v, o);
    return v;
}
__device__ __forceinline__ float siluf_(float z) { return z * __builtin_amdgcn_rcpf(1.0f + __builtin_amdgcn_exp2f(-LOG2E * z)); }
__device__ __forceinline__ float max_halves(float v) { const auto rr = __builtin_amdgcn_permlane32_swap(__float_as_uint(v), __float_as_uint(v), false, false); return fmaxf(__uint_as_float(rr[0]), __uint_as_float(rr[1])); }
__device__ __forceinline__ float sum_halves(float v) { const auto rr = __builtin_amdgcn_permlane32_swap(__float_as_uint(v), __float_as_uint(v), false, false); return __uint_as_float(rr[0]) + __uint_as_float(rr[1]); }

__device__ __forceinline__ void p0_transpose_item(const float* W, int K, int Nsrc, int Ndst, const float* gain, int gap0, int gaplen, bf16* WT, LAS float* scr, int item, int lane, bool headperm = false) {
    const int nblk = Ndst / 32, kb = item / nblk, nb = item % nblk, k0 = 64 * kb, n0 = 32 * nb;
    int nd = n0 + (lane & 7) * 4; const bool valid = (nd < gap0) || (nd >= gap0 + gaplen);
    if (headperm && nd < 1024) nd = (nd & ~255) + ((nd >> 5) & 3) * 64 + ((nd >> 7) & 1) * 32 + (nd & 31);
    int ns = nd < gap0 ? nd : nd - gaplen;
    if (headperm && nd >= 2816 && nd < 4864) {
        const int tl = (nd - 2816) >> 8, ct = (nd - 2816) & 255, j = 128 * (tl & 3) + (ct & 127), which = ct >> 7;
        ns = (tl < 4 ? (which ? 4168 : 2632) : (which ? 3656 : 3144)) + j; }
    f32x4 v[8]; float gk[8];
#pragma unroll
    for (int i = 0; i < 8; ++i) { const int kk = 8 * i + (lane >> 3); v[i] = (f32x4){0.f, 0.f, 0.f, 0.f}; gk[i] = 1.0f; if (valid) { v[i] = *(const f32x4*)(W + (size_t)(k0 + kk) * Nsrc + ns); if (gain) gk[i] = gain[k0 + kk]; } }
#pragma unroll
    for (int i = 0; i < 8; ++i) v[i] = v[i] * gk[i];
#pragma unroll
    for (int i = 0; i < 8; ++i) { const int kk = 8 * i + (lane >> 3); LAS float* d = scr + kk * 33 + (lane & 7) * 4; d[0] = v[i][0]; d[1] = v[i][1]; d[2] = v[i][2]; d[3] = v[i][3]; }
    asm volatile("s_waitcnt lgkmcnt(0)" ::: "memory");
    const int c = lane & 7;
#pragma unroll
    for (int j = 0; j < 4; ++j) { const int n = (lane >> 3) + 8 * j; const LAS float* sp = scr + (8 * c) * 33 + n;
        u32x4 o; o.x = pk2(sp[0 * 33], sp[1 * 33]); o.y = pk2(sp[2 * 33], sp[3 * 33]); o.z = pk2(sp[4 * 33], sp[5 * 33]); o.w = pk2(sp[6 * 33], sp[7 * 33]);
        *(u32x4*)(WT + (size_t)(n0 + n) * K + k0 + 8 * c) = o; }
    asm volatile("s_waitcnt lgkmcnt(0)" ::: "memory");
}
__device__ __forceinline__ void rows4_to_bf16(const float* xrow, bf16* orow, float* rstd_out, int lane) {
    f32x4 v[4][4]; float s[4];
#pragma unroll
    for (int r = 0; r < 4; ++r)
#pragma unroll
        for (int j = 0; j < 4; ++j) v[r][j] = *((const f32x4*)(xrow + (size_t)r * DM) + lane + 64 * j);
#pragma unroll
    for (int r = 0; r < 4; ++r) { float a = 0.f;
#pragma unroll
        for (int j = 0; j < 4; ++j) a += (v[r][j].x * v[r][j].x + v[r][j].y * v[r][j].y) + (v[r][j].z * v[r][j].z + v[r][j].w * v[r][j].w);
        s[r] = a; }
#pragma unroll
    for (int o = 1; o < 64; o <<= 1) { s[0] += __shfl_xor(s[0], o); s[1] += __shfl_xor(s[1], o); s[2] += __shfl_xor(s[2], o); s[3] += __shfl_xor(s[3], o); }
#pragma unroll
    for (int r = 0; r < 4; ++r) { const float rs = 1.0f / sqrtf(s[r] * (1.0f / DM) + RMS_EPS); u32x2* o8 = (u32x2*)(orow + (size_t)r * DM) + lane;
#pragma unroll
        for (int j = 0; j < 4; ++j) { u32x2 w; w.x = pk2(v[r][j].x * rs, v[r][j].y * rs); w.y = pk2(v[r][j].z * rs, v[r][j].w * rs); o8[64 * j] = w; }
        if (lane == r) rstd_out[r] = sqrtf(s[r] * (1.0f / DM) + RMS_EPS); }
}
__device__ __forceinline__ void phase0(const Params& p, LAS unsigned char* lds, int vcu, int G) {
    const int tid = opaque_tid(), lane = tid & 63, wave = tid >> 6;
    LAS float* scr = (LAS float*)(lds + wave * 16384);
    const int gw = vcu * NWAVES + wave, NGW = G * NWAVES;
    unsigned char* ws = p.ws;
    for (int m4 = gw; m4 < (T + MT) / 4; m4 += NGW) { const int m = 4 * m4;
        if (m < T) rows4_to_bf16(p.x + (size_t)m * DM, (bf16*)(ws + WS_XB) + (size_t)m * DM, (float*)(ws + WS_RSTDX) + m, lane);
        else { const int mm = m - T; rows4_to_bf16(p.mem + (size_t)mm * DM, (bf16*)(ws + WS_MEMB) + (size_t)mm * DM, (float*)(ws + WS_RSTDM) + mm, lane); } }
    constexpr int I_IN = (DM / 64) * (NIN / 32), I_MKV = (DM / 64) * (1024 / 32), I_OX = (512 / 64) * (1024 / 32), I_O = (DM / 64) * (1024 / 32);
    (void)I_OX; (void)I_O;
    constexpr int NITEMS = I_IN + I_MKV;
    for (int it = gw; it < NITEMS; it += NGW) {
        int r = it;
        if (r < I_IN) { p0_transpose_item(p.w_in, DM, NIN_SRC, NIN, p.norm_g, GAP0, GAPLEN, (bf16*)(ws + WS_WIN), scr, r, lane, true); continue; } r -= I_IN;
        p0_transpose_item(p.w_mem_kv, DM, 1024, 1024, p.mem_norm_g, 1 << 30, 0, (bf16*)(ws + WS_WMKV), scr, r, lane);
    }
}
__device__ __forceinline__ void p0_late_weights(const Params& p, LAS unsigned char* lds, int gw, int NGW) {
    const int tid = opaque_tid(), lane = tid & 63, wave = tid >> 6;
    LAS float* scr = (LAS float*)(lds + wave * 16384);
    unsigned char* ws = p.ws;
    constexpr int I_OX = (512 / 64) * (1024 / 32), I_O = (DM / 64) * (1024 / 32);
    for (int it = gw; it < 3 * I_OX + I_O; it += NGW) {
        int r = it;
        if (r < I_OX) { p0_transpose_item(p.w_out_a, 512, 1024, 1024, nullptr, 1 << 30, 0, (bf16*)(ws + WS_WOA), scr, r, lane); continue; } r -= I_OX;
        if (r < I_OX) { p0_transpose_item(p.w_out_b, 512, 1024, 1024, nullptr, 1 << 30, 0, (bf16*)(ws + WS_WOB), scr, r, lane); continue; } r -= I_OX;
        if (r < I_OX) { p0_transpose_item(p.w_out_m, 512, 1024, 1024, nullptr, 1 << 30, 0, (bf16*)(ws + WS_WOM), scr, r, lane); continue; } r -= I_OX;
        p0_transpose_item(p.w_o, DM, 1024, 1024, nullptr, 1 << 30, 0, (bf16*)(ws + WS_WO), scr, r, lane);
    }
}

template <int HD>
__device__ __forceinline__ void headnorm(bf16* X, int ld, int R, int NH, const float* gain, float oscale, int gtid, int gthreads) {
    constexpr int TPH = HD / 8;
    const long total = (long)R * NH * TPH;
    for (long i = gtid; i < total; i += gthreads) {
        const int part = (int)(i % TPH); const long rh = i / TPH; const int head = (int)(rh % NH); const long row = rh / NH;
        bf16* ptr = X + row * ld + head * HD + part * 8;
        const u32x4 w = *(const u32x4*)ptr; float f[8];
#pragma unroll
        for (int e = 0; e < 4; ++e) { f[2 * e] = bflo(w[e]); f[2 * e + 1] = bfhi(w[e]); }
        float s = 0.f;
#pragma unroll
        for (int e = 0; e < 8; ++e) s += f[e] * f[e];
#pragma unroll
        for (int o = 1; o < TPH; o <<= 1) s += __shfl_xor(s, o);
        const float r = oscale / sqrtf(s * (1.0f / HD) + RMS_EPS);
        const f32x4 g0 = *(const f32x4*)(gain + part * 8), g1 = *(const f32x4*)(gain + part * 8 + 4);
        u32x4 o; o.x = pk2(f[0] * r * g0.x, f[1] * r * g0.y); o.y = pk2(f[2] * r * g0.z, f[3] * r * g0.w); o.z = pk2(f[4] * r * g1.x, f[5] * r * g1.y); o.w = pk2(f[6] * r * g1.z, f[7] * r * g1.w);
        *(u32x4*)ptr = o;
    }
}
__device__ __forceinline__ void conv_branch(const bf16* BR, const float* cw, bf16* XO, int gtid, int gthreads) {
    const long total = (long)T * 64; const bf16* U = BR + (size_t)T * 512;
    for (long i = gtid; i < total; i += gthreads) {
        const int c8 = (int)(i & 63) * 8; const long row = i >> 6; const int tl = (int)(row & (SEQ - 1));
        float y[8];
#pragma unroll
        for (int e = 0; e < 8; ++e) y[e] = 0.f;
#pragma unroll
        for (int k = 0; k < 3; ++k) {
            const int back = 2 - k;
            if (tl - back >= 0) {
                const u32x4 uw = *(const u32x4*)(U + (row - back) * 512 + c8);
                const f32x4 w0 = *(const f32x4*)(cw + k * 512 + c8), w1 = *(const f32x4*)(cw + k * 512 + c8 + 4);
                const float wk[8] = {w0.x, w0.y, w0.z, w0.w, w1.x, w1.y, w1.z, w1.w};
#pragma unroll
                for (int e = 0; e < 4; ++e) { y[2 * e] += wk[2 * e] * bflo(uw[e]); y[2 * e + 1] += wk[2 * e + 1] * bfhi(uw[e]); }
            }
        }
        const u32x4 vw = *(const u32x4*)(BR + row * 512 + c8);
        u32x4 o;
#pragma unroll
        for (int e = 0; e < 4; ++e) o[e] = pk2(bflo(vw[e]) * y[2 * e], bfhi(vw[e]) * y[2 * e + 1]);
        *(u32x4*)(XO + row * 512 + c8) = o;
    }
}

__device__ __forceinline__ unsigned umin_(unsigned a, unsigned b) { return a < b ? a : b; }
__device__ __forceinline__ unsigned umax_(unsigned a, unsigned b) { return a > b ? a : b; }
typedef unsigned short u16x2 __attribute__((ext_vector_type(2)));
typedef short i16x2 __attribute__((ext_vector_type(2)));
__device__ __forceinline__ u16x2 as_u16x2(unsigned x) { return __builtin_bit_cast(u16x2, x); }
__device__ __forceinline__ unsigned as_u32(u16x2 x) { return __builtin_bit_cast(unsigned, x); }
__device__ __forceinline__ u16x2 pkmin(u16x2 a, u16x2 b) { return __builtin_elementwise_min(a, b); }
__device__ __forceinline__ u16x2 pkmax(u16x2 a, u16x2 b) { return __builtin_elementwise_max(a, b); }
__device__ __forceinline__ int wave_sum_dpp(int v) {
    v += __builtin_amdgcn_update_dpp(0, v, 0xB1, 0xF, 0xF, true); v += __builtin_amdgcn_update_dpp(0, v, 0x4E, 0xF, 0xF, true);
    v += __builtin_amdgcn_update_dpp(0, v, 0x124, 0xF, 0xF, true); v += __builtin_amdgcn_update_dpp(0, v, 0x128, 0xF, 0xF, true);
    return (__builtin_amdgcn_readlane(v, 0) + __builtin_amdgcn_readlane(v, 16)) + (__builtin_amdgcn_readlane(v, 32) + __builtin_amdgcn_readlane(v, 48));
}
__device__ __forceinline__ unsigned wave_umin_dpp(unsigned v) {
    v = umin_(v, (unsigned)__builtin_amdgcn_update_dpp(0, (int)v, 0xB1, 0xF, 0xF, true)); v = umin_(v, (unsigned)__builtin_amdgcn_update_dpp(0, (int)v, 0x4E, 0xF, 0xF, true));
    v = umin_(v, (unsigned)__builtin_amdgcn_update_dpp(0, (int)v, 0x124, 0xF, 0xF, true)); v = umin_(v, (unsigned)__builtin_amdgcn_update_dpp(0, (int)v, 0x128, 0xF, 0xF, true));
    return umin_(umin_((unsigned)__builtin_amdgcn_readlane((int)v, 0), (unsigned)__builtin_amdgcn_readlane((int)v, 16)), umin_((unsigned)__builtin_amdgcn_readlane((int)v, 32), (unsigned)__builtin_amdgcn_readlane((int)v, 48)));
}
__device__ __forceinline__ unsigned wave_umax_dpp(unsigned v) {
    v = umax_(v, (unsigned)__builtin_amdgcn_update_dpp(0, (int)v, 0xB1, 0xF, 0xF, true)); v = umax_(v, (unsigned)__builtin_amdgcn_update_dpp(0, (int)v, 0x4E, 0xF, 0xF, true));
    v = umax_(v, (unsigned)__builtin_amdgcn_update_dpp(0, (int)v, 0x124, 0xF, 0xF, true)); v = umax_(v, (unsigned)__builtin_amdgcn_update_dpp(0, (int)v, 0x128, 0xF, 0xF, true));
    return umax_(umax_((unsigned)__builtin_amdgcn_readlane((int)v, 0), (unsigned)__builtin_amdgcn_readlane((int)v, 16)), umax_((unsigned)__builtin_amdgcn_readlane((int)v, 32), (unsigned)__builtin_amdgcn_readlane((int)v, 48)));
}
__device__ __forceinline__ int count_ge16(const unsigned (&v)[32], unsigned cand, int nc) {
    const unsigned c2 = cand | (cand << 16), c1 = (cand - 1u) | ((cand - 1u) << 16);
    unsigned a0 = 0u, a1 = 0u;
#pragma unroll
    for (int c8 = 0; c8 < 4; ++c8) {
        if (c8 < nc) {
#pragma unroll
            for (int ii = 0; ii < 8; ii += 2) {
                const u16x2 x0 = as_u16x2(v[8 * c8 + ii]), x1 = as_u16x2(v[8 * c8 + ii + 1]);
                a0 = __builtin_amdgcn_sad_u16(as_u32(pkmin(x0, as_u16x2(c2))), as_u32(pkmin(x0, as_u16x2(c1))), a0);
                a1 = __builtin_amdgcn_sad_u16(as_u32(pkmin(x1, as_u16x2(c2))), as_u32(pkmin(x1, as_u16x2(c1))), a1);
            }
        }
    }
    return wave_sum_dpp((int)(a0 + a1));
}
__device__ __forceinline__ void nat_words(u64 lo, u64 hi, u64& w0, u64& w1) { w0 = (lo & 0xffffffffull) | (hi << 32); w1 = (lo >> 32) | (hi & 0xffffffff00000000ull); }

template <int I> __device__ __forceinline__ void deposit_words(u64 lob, u64 hib, unsigned& wlo, unsigned& whi) {
    const unsigned l0 = (unsigned)lob, l1 = (unsigned)(lob >> 32), h0 = (unsigned)hib, h1 = (unsigned)(hib >> 32);
    asm volatile("s_nop 1" :: "s"(l0), "s"(l1), "s"(h0), "s"(h1));
    asm volatile("v_writelane_b32 %0, %1, %2" : "+v"(wlo) : "s"(l0), "n"(2 * I));
    asm volatile("v_writelane_b32 %0, %1, %2" : "+v"(whi) : "s"(h0), "n"(2 * I));
    asm volatile("v_writelane_b32 %0, %1, %2" : "+v"(wlo) : "s"(l1), "n"(2 * I + 1));
    asm volatile("v_writelane_b32 %0, %1, %2" : "+v"(whi) : "s"(h1), "n"(2 * I + 1));
}
template <int I> __device__ __forceinline__ void emit_simple(const unsigned (&v)[32], unsigned tau, unsigned tau_hi, unsigned& wlo, unsigned& whi) {
    const unsigned x = v[I];
    deposit_words<I>(__ballot((x & 0xffffu) >= tau), __ballot(x >= tau_hi), wlo, whi);
}
template <int I> __device__ __forceinline__ void emit_ties(const unsigned (&v)[32], unsigned tau, unsigned tau_hi, int& need, unsigned& wlo, unsigned& whi) {
    const unsigned x = v[I]; const unsigned xl = x & 0xffffu, xh = x & 0xffff0000u;
    u64 glo = __ballot(xl > tau), ghi = __ballot(xh > tau_hi); const u64 elo = __ballot(xl == tau), ehi = __ballot(xh == tau_hi);
    if ((elo | ehi) != 0ull) {
        u64 g0, g1, e0, e1; nat_words(glo, ghi, g0, g1); nat_words(elo, ehi, e0, e1);
#pragma unroll
        for (int h2 = 0; h2 < 2; ++h2) { u64 e = h2 ? e1 : e0; u64 take = 0ull;
            const int pc = __popcll(e);
            if (pc <= need) { take = e; need -= pc; } else { while (need > 0) { const u64 low = e & (0ull - e); take |= low; e ^= low; --need; } }
            if (h2) g1 |= take; else g0 |= take; }
        glo = (g0 & 0xffffffffull) | (g1 << 32); ghi = (g0 >> 32) | (g1 & 0xffffffff00000000ull);
    }
    deposit_words<I>(glo, ghi, wlo, whi);
}
#define REP8(F, B, ...) F<B + 0>(__VA_ARGS__); F<B + 1>(__VA_ARGS__); F<B + 2>(__VA_ARGS__); F<B + 3>(__VA_ARGS__); F<B + 4>(__VA_ARGS__); F<B + 5>(__VA_ARGS__); F<B + 6>(__VA_ARGS__); F<B + 7>(__VA_ARGS__)
typedef _Float16 f16x8 __attribute__((ext_vector_type(8)));
typedef _Float16 f16x2 __attribute__((ext_vector_type(2)));
struct TopkQ { bf16x8 af[2][4]; f32x4 wa, wb; };
__device__ __forceinline__ void topk_load_q(TopkQ& q, const bf16* QI, const float* WIC, unsigned u) {
    const int tid = opaque_tid(), lane = tid & 63, wid = __builtin_amdgcn_readfirstlane(tid >> 6), r32 = lane & 31, hi = lane >> 5;
    const int b = (int)(u & 3u), tb16 = 255 - (int)(u >> 2), t0 = tb16 * 16 + (wid >> 2) * 8; const size_t rowb = (size_t)b * SEQ;
    const int rho = r32, qq = 2 * ((rho >> 2) & 1) + (rho >> 4), head = (rho & 3) + 4 * ((rho >> 3) & 1);
#pragma unroll
    for (int m = 0; m < 2; ++m) { const bf16* pq = QI + (rowb + t0 + 4 * m + qq) * 512 + head * 64 + 8 * hi;
#pragma unroll
        for (int ks = 0; ks < 4; ++ks) q.af[m][ks] = *(const bf16x8*)(pq + 16 * ks); }
    const int rw = r32 & 7;
    q.wa = *(const f32x4*)(WIC + (rowb + t0 + rw) * 8); q.wb = *(const f32x4*)(WIC + (rowb + t0 + rw) * 8 + 4);
}
__device__ __forceinline__ void topk_unit2(LAS unsigned char* lds, const bf16* QI, const bf16* KIWI  , const float* WIC  , u64* MASK, unsigned ucur, const bf16* BR, const float* cw,
                                           TopkQ& tq, unsigned* qctr, unsigned nunits, unsigned& u_next, bf16* MK, const float* gkm) {
    const int tid = opaque_tid(), lane = tid & 63, wid = __builtin_amdgcn_readfirstlane(tid >> 6), r32 = lane & 31, hi = lane >> 5;
    const int b = (int)(ucur & 3u), tb16 = 255 - (int)(ucur >> 2);
    unsigned nxt_ticket = 0u;
    if (threadIdx.x == 0) nxt_ticket = __hip_atomic_fetch_add(qctr + (opaque_tid() >> 9), 1u, __ATOMIC_RELAXED, __HIP_MEMORY_SCOPE_AGENT);
    const int grp = wid >> 2, w4 = wid & 3;
    const int t0 = tb16 * 16 + grp * 8; const size_t rowb = (size_t)b * SEQ;
    LAS unsigned* SC = (LAS unsigned*)lds + grp * (8 * 2048);
    const int nt2 = ((t0 + 8 + 127) >> 7) << 1;
    bf16x8 af[2][4]; f16x8 a2[2][2];
    {
#pragma unroll
        for (int m = 0; m < 2; ++m)
#pragma unroll
            for (int ks = 0; ks < 4; ++ks) af[m][ks] = tq.af[m][ks];
        f32x4 wa = tq.wa, wb = tq.wb;
        if (r32 >= 8) { wa = (f32x4){0.f, 0.f, 0.f, 0.f}; wb = wa; }
#pragma unroll
        for (int m = 0; m < 2; ++m)
#pragma unroll
            for (int sx = 0; sx < 2; ++sx) { const bool on = (r32 == 4 * m + 2 * hi + sx);
                f16x8 w8; w8[0] = (_Float16)(on ? wa[0] : 0.f); w8[1] = (_Float16)(on ? wa[1] : 0.f); w8[2] = (_Float16)(on ? wa[2] : 0.f); w8[3] = (_Float16)(on ? wa[3] : 0.f);
                w8[4] = (_Float16)(on ? wb[0] : 0.f); w8[5] = (_Float16)(on ? wb[1] : 0.f); w8[6] = (_Float16)(on ? wb[2] : 0.f); w8[7] = (_Float16)(on ? wb[3] : 0.f); a2[m][sx] = w8; }
    }
    {
        bf16x8 bA[2][4], bB[2][4];
        const bf16* kbase = KIWI + rowb * 64 + lane * 8;
        auto loadb = [&](bf16x8 (&bb)[2][4], int j2) { const int jj = j2 < nt2 ? j2 : nt2 - 1;
#pragma unroll
            for (int tt = 0; tt < 2; ++tt)
#pragma unroll
                for (int ks = 0; ks < 4; ++ks) bb[tt][ks] = *(const bf16x8*)(kbase + (size_t)((2 * jj + tt) * 4 + ks) * 512); };
        auto compute = [&](const bf16x8 (&bb)[2][4], int j2) {
            f32x16 c2[2];
#pragma unroll
            for (int tt = 0; tt < 2; ++tt) {
                f32x16 acc2;
#pragma unroll
                for (int r = 0; r < 16; ++r) acc2[r] = 0.f;
#pragma unroll
                for (int m = 0; m < 2; ++m) {
                    f32x16 c1;
#pragma unroll
                    for (int r = 0; r < 16; ++r) c1[r] = 0.f;
#pragma unroll
                    for (int ks = 0; ks < 4; ++ks) c1 = __builtin_amdgcn_mfma_f32_32x32x16_bf16(af[m][ks], bb[tt][ks], c1, 0, 0, 0);
#pragma unroll
                    for (int sx = 0; sx < 2; ++sx) { f16x8 pf;
#pragma unroll
                        for (int e = 0; e < 4; ++e) { f16x2 h2 = __builtin_bit_cast(f16x2, __builtin_amdgcn_cvt_pkrtz(c1[8 * sx + 2 * e], c1[8 * sx + 2 * e + 1]));
                            h2 = __builtin_elementwise_max(h2, (f16x2){(_Float16)0.f, (_Float16)0.f}); pf[2 * e] = h2[0]; pf[2 * e + 1] = h2[1]; }
                        acc2 = __builtin_amdgcn_mfma_f32_32x32x16_f16(a2[m][sx], pf, acc2, 0, 0, 0); }
                }
                c2[tt] = acc2;
            }
            const int key0 = 64 * j2 + r32;
            const bool diag = (64 * j2 + 63 > t0);
#pragma unroll
            for (int e = 0; e < 4; ++e) {
                const int q = 4 * hi + e;
                const unsigned x = __builtin_bit_cast(unsigned, __builtin_amdgcn_cvt_pkrtz(c2[0][e], c2[1][e]));
                const i16x2 sg = __builtin_bit_cast(i16x2, x) >> 15;
                unsigned k = x ^ (__builtin_bit_cast(unsigned, sg) | 0x80008000u);
                if (diag) { const int t = t0 + q; if (key0 > t) k &= 0xffff0000u; if (key0 + 32 > t) k &= 0x0000ffffu; }
                SC[q * 2048 + j2 * 32 + r32] = k;
            } };
        loadb(bA, w4); __builtin_amdgcn_sched_barrier(0);
        for (int j2 = w4; j2 < nt2; j2 += 8) {
            loadb(bB, j2 + 4); __builtin_amdgcn_sched_barrier(0);
            compute(bA, j2); __builtin_amdgcn_sched_barrier(0);
            loadb(bA, j2 + 8); __builtin_amdgcn_sched_barrier(0);
            if (j2 + 4 < nt2) compute(bB, j2 + 4);
            __builtin_amdgcn_sched_barrier(0);
        }
    }
    { volatile LAS unsigned* slot = (volatile LAS unsigned*)(lds + 131072 + 256);
      if (threadIdx.x == 0) *slot = nxt_ticket;
      __syncthreads();
      u_next = *slot; }
    if (u_next < nunits) topk_load_q(tq, QI, WIC, u_next);
    u32x4 cu[2][3], cv[2];
    { const bf16* U = BR + (size_t)T * 512; const int c8 = (tid & 63) * 8;
#pragma unroll
      for (int it2 = 0; it2 < 2; ++it2) { const int tl = tb16 * 16 + (tid >> 6) + 8 * it2; const size_t row = (size_t)b * SEQ + tl;
#pragma unroll
          for (int k = 0; k < 3; ++k) { const int back = 2 - k; const size_t rr = (tl - back >= 0) ? row - back : row;
              cu[it2][k] = *(const u32x4*)(U + rr * 512 + c8); }
          cv[it2] = *(const u32x4*)(BR + row * 512 + c8); } }
    u32x4 mkw = {0u, 0u, 0u, 0u}; bf16* mkp = MK;
    if (wid == 0) { const unsigned i = ucur * 64u + (unsigned)lane; const unsigned part = i & 15u, rh = i >> 4; mkp = MK + (size_t)(rh >> 2) * 1024 + (rh & 3u) * 128 + part * 8; mkw = *(const u32x4*)mkp; }
    __builtin_amdgcn_sched_barrier(0);
#pragma unroll 1
    for (int qi = 0; qi < 2; ++qi) {
        const int q = 2 * w4 + qi, t = t0 + q, n = t + 1;
        unsigned wlo = 0u, whi = 0u;
        if (n <= 256) {
            const int lo = 64 * lane; u64 w;
            if (lo + 63 <= t) w = ~0ull; else if (lo > t) w = 0ull; else w = (1ull << (t - lo + 1)) - 1ull;
            wlo = (unsigned)w; whi = (unsigned)(w >> 32);
        } else {
            const int nw = (n + 127) >> 7, nc = (nw + 7) >> 3;
            unsigned v[32];
#pragma unroll
            for (int i = 0; i < 32; ++i) v[i] = 0u;
#pragma unroll
            for (int c8 = 0; c8 < 4; ++c8) {
                if (c8 < nc) {
#pragma unroll
                    for (int ii = 0; ii < 8; ++ii) { const int i = 8 * c8 + ii; if (i < nw) v[i] = SC[q * 2048 + 64 * i + lane]; }
                }
            }
            u16x2 ta = as_u16x2(0u), tb = as_u16x2(0u);
#pragma unroll
            for (int c8 = 0; c8 < 4; ++c8) {
                if (c8 < nc) {
#pragma unroll
                    for (int ii = 0; ii < 8; ++ii) { const u16x2 x = as_u16x2(v[8 * c8 + ii]); tb = pkmin(pkmax(x, tb), ta); ta = pkmax(ta, x); }
                }
            }
            const unsigned L = wave_umin_dpp(umin_(tb[0], tb[1])), U = wave_umax_dpp(umax_(tb[0], tb[1]));
            unsigned lo = L, hi = U + 1u; int clo = -1, chi = -1, cge = 0; unsigned tau = L; bool done = false;
            const unsigned cand0 = (unsigned)wave_sum_dpp((int)((unsigned)tb[0] + (unsigned)tb[1])) >> 7;
            for (int iter = 0; hi - lo > 1u; ++iter) {
                unsigned cand = lo + ((hi - lo) >> 1);
                if (iter == 0) cand = cand0 <= lo ? lo + 1u : (cand0 >= hi ? hi - 1u : cand0);
                if (clo >= 0 && chi >= 0 && (iter & 1) == 0) {
                    const float frac = ((float)(clo - 256) + 0.5f) / (float)(clo - chi);
                    cand = lo + (unsigned)(frac * (float)(hi - lo));
                    cand = cand <= lo ? lo + 1u : (cand >= hi ? hi - 1u : cand);
                }
                const int cnt = count_ge16(v, cand, nc);
                if (cnt >= 256) { lo = cand; clo = cnt; if (cnt == 256) { done = true; break; } } else { hi = cand; chi = cnt; }
            }
            tau = lo; cge = done ? 256 : (clo >= 0 ? clo : count_ge16(v, tau, nc));
            const unsigned tau_hi = tau << 16;
            if (cge == 256) {
                if (0 < nc) { REP8(emit_simple, 0, v, tau, tau_hi, wlo, whi); }
                if (1 < nc) { REP8(emit_simple, 8, v, tau, tau_hi, wlo, whi); }
                if (2 < nc) { REP8(emit_simple, 16, v, tau, tau_hi, wlo, whi); }
                if (3 < nc) { REP8(emit_simple, 24, v, tau, tau_hi, wlo, whi); }
            } else {
                int need = 256 - ((hi == tau + 1u && chi >= 0) ? chi : ((tau == 0xffffu) ? 0 : count_ge16(v, tau + 1u, nc)));
                if (0 < nc) { REP8(emit_ties, 0, v, tau, tau_hi, need, wlo, whi); }
                if (1 < nc) { REP8(emit_ties, 8, v, tau, tau_hi, need, wlo, whi); }
                if (2 < nc) { REP8(emit_ties, 16, v, tau, tau_hi, need, wlo, whi); }
                if (3 < nc) { REP8(emit_ties, 24, v, tau, tau_hi, need, wlo, whi); }
            }
        }
        u32x2 w2; w2.x = wlo; w2.y = whi;
        *(u32x2*)(MASK + ((size_t)(b * 64 + lane) * SEQ + t)) = w2;
    }
    { const int c8 = (tid & 63) * 8; f32x4 wk[3][2];
#pragma unroll
      for (int k = 0; k < 3; ++k) { wk[k][0] = *(const f32x4*)(cw + k * 512 + c8); wk[k][1] = *(const f32x4*)(cw + k * 512 + c8 + 4); }
#pragma unroll
      for (int it2 = 0; it2 < 2; ++it2) { const int tl = tb16 * 16 + (tid >> 6) + 8 * it2; const size_t row = (size_t)b * SEQ + tl;
          float y[8];
#pragma unroll
          for (int e = 0; e < 8; ++e) y[e] = 0.f;
#pragma unroll
          for (int k = 0; k < 3; ++k) { const float on = (tl - (2 - k) >= 0) ? 1.0f : 0.0f; const u32x4 uw = cu[it2][k];
#pragma unroll
              for (int e = 0; e < 4; ++e) { y[2 * e] += on * wk[k][e >> 1][(2 * e) & 3] * bflo(uw[e]); y[2 * e + 1] += on * wk[k][e >> 1][(2 * e + 1) & 3] * bfhi(uw[e]); } }
          const u32x4 vw = cv[it2]; u32x4 o;
#pragma unroll
          for (int e = 0; e < 4; ++e) o[e] = pk2(bflo(vw[e]) * y[2 * e], bfhi(vw[e]) * y[2 * e + 1]);
          *(u32x4*)((bf16*)BR + row * 512 + c8) = o; } }
    if (wid == 0) { float f[8]; float ss = 0.f;
#pragma unroll
        for (int e = 0; e < 4; ++e) { f[2 * e] = bflo(mkw[e]); f[2 * e + 1] = bfhi(mkw[e]); }
#pragma unroll
        for (int e = 0; e < 8; ++e) ss += f[e] * f[e];
#pragma unroll
        for (int o2 = 1; o2 < 16; o2 <<= 1) ss += __shfl_xor(ss, o2);
        const float r = 1.0f / sqrtf(ss * (1.0f / 128.0f) + RMS_EPS); const int part = lane & 15;
        const f32x4 g0 = *(const f32x4*)(gkm + part * 8), g1 = *(const f32x4*)(gkm + part * 8 + 4);
        u32x4 o; o.x = pk2(f[0] * r * g0.x, f[1] * r * g0.y); o.y = pk2(f[2] * r * g0.z, f[3] * r * g0.w); o.z = pk2(f[4] * r * g1.x, f[5] * r * g1.y); o.w = pk2(f[6] * r * g1.z, f[7] * r * g1.w);
        *(u32x4*)mkp = o; }
    __syncthreads();
}

__device__ __forceinline__ s16x4 vtr(const LAS unsigned char* p) { typedef short v4i16_t __attribute__((ext_vector_type(4))); return __builtin_bit_cast(s16x4, __builtin_amdgcn_ds_read_tr16_b64_v4i16((LAS v4i16_t*)p)); }
__device__ __forceinline__ int crow(int r, int hi) { return (r & 3) + 8 * (r >> 2) + 4 * hi; }
template <int DB> __device__ __forceinline__ void attn_store_gated(const f32x16 (&o)[DB], float inv, const bf16* zrow, bf16* orow, int hi) {
    u32x4 zall[DB][2];
#pragma unroll
    for (int d = 0; d < DB; ++d)
#pragma unroll
        for (int p2 = 0; p2 < 2; ++p2) zall[d][p2] = *(const u32x4*)(zrow + d * 32 + 16 * p2 + 8 * hi);
    asm volatile("" ::: "memory");
#pragma unroll
    for (int d = 0; d < DB; ++d)
#pragma unroll
        for (int p2 = 0; p2 < 2; ++p2) {
            float x[8];
#pragma unroll
            for (int e = 0; e < 4; ++e) { const auto rr = __builtin_amdgcn_permlane32_swap(__float_as_uint(o[d][8 * p2 + e]), __float_as_uint(o[d][8 * p2 + 4 + e]), false, false);
                x[e] = __uint_as_float(rr[0]); x[4 + e] = __uint_as_float(rr[1]); }
            const u32x4 zw = zall[d][p2]; u32x4 ow;
            ow.x = pk2(x[0] * inv * siluf_(bflo(zw.x)), x[1] * inv * siluf_(bfhi(zw.x))); ow.y = pk2(x[2] * inv * siluf_(bflo(zw.y)), x[3] * inv * siluf_(bfhi(zw.y)));
            ow.z = pk2(x[4] * inv * siluf_(bflo(zw.z)), x[5] * inv * siluf_(bfhi(zw.z))); ow.w = pk2(x[6] * inv * siluf_(bflo(zw.w)), x[7] * inv * siluf_(bfhi(zw.w)));
            *(u32x4*)(orow + d * 32 + 16 * p2 + 8 * hi) = ow; }
}
__device__ __forceinline__ void ld16_async(u32x4& d, const void* p) { asm volatile("global_load_dwordx4 %0, %1, off" : "=v"(d) : "v"(p) : "memory"); }
__device__ __forceinline__ void ld16q_async(bf16x8& d, const void* p) { asm volatile("global_load_dwordx4 %0, %1, off" : "=v"(d) : "v"(p) : "memory"); }
__device__ __forceinline__ void ld8_async(u64& d, const void* p) { asm volatile("global_load_dwordx2 %0, %1, off" : "=v"(d) : "v"(p) : "memory"); }
__device__ __forceinline__ unsigned bf16_rne_bits(float f) { return f2bf(f); }
__device__ __forceinline__ void flash_unit_a(LAS unsigned char* lds, const bf16* Q, const bf16* K, const bf16* V, bf16* O, const bf16* Z, int qb, const u64* mask, float slope2, float smax  ) {
    constexpr int LD = 512, KBYTES = 8192, BUFB = 16384, FLAGS = 32768;
    const int tid = opaque_tid(), lane = tid & 63, wid = __builtin_amdgcn_readfirstlane(tid >> 6), r32 = lane & 31, hi = lane >> 5;
    const float NEG = -1.0e30f;
    const int nt = 4 * (qb + 1);
    bf16x8 qf[4];
    { const bf16* qp = Q + (size_t)(wid * 32 + r32) * LD + 8 * hi;
#pragma unroll
      for (int ks = 0; ks < 4; ++ks) ld16q_async(qf[ks], qp + 16 * ks); }
    u32x4 ka0 = {0u, 0u, 0u, 0u}, ka1 = {0u, 0u, 0u, 0u}, qa = {0u, 0u, 0u, 0u};
    if (hi == 0) {
        const float r0 = slope2 * (float)r32, r1 = slope2 * (float)(r32 + 32);
        const unsigned h0 = bf16_rne_bits(r0), h1 = bf16_rne_bits(r1);
        ka0.x = h0 | (bf16_rne_bits(r0 - __uint_as_float(h0 << 16)) << 16); ka1.x = h1 | (bf16_rne_bits(r1 - __uint_as_float(h1 << 16)) << 16);
        qa.x = 0x3f803f80u;
    }
    const unsigned onesw = ((r32 & ~4) == 0) ? 0x3f803f80u : 0u;
    const bf16x8 vones = __builtin_bit_cast(bf16x8, (u32x4){onesw, onesw, onesw, onesw});
    f32x16 o2;
#pragma unroll
    for (int r = 0; r < 16; ++r) o2[r] = 0.f;
    const float d64 = slope2 * 64.0f;
    const bool nomax_ok = smax <= 30.0f;
    bool allhave = false;
    f32x16 o[2];
#pragma unroll
    for (int d = 0; d < 2; ++d)
#pragma unroll
        for (int r = 0; r < 16; ++r) o[d][r] = 0.f;
    f32x16 negm;
#pragma unroll
    for (int r = 0; r < 16; ++r) negm[r] = 0.f;
    float m_run = 0.f;
    u32x4 kregA, vregA, kregB, vregB; u64 mwA, mwB;
    const bf16* ksrc = K + (size_t)lane * LD + wid * 8;
    const bf16* vsrc = V + (size_t)(16 * (wid & 3) + (lane >> 2)) * LD + (wid >> 2) * 32 + (lane & 3) * 8;
    const int kdst = wid * 1024 + lane * 16, vdst = KBYTES + (wid >> 2) * 4096 + (16 * (wid & 3) + (lane >> 2)) * 64 + (lane & 3) * 16;
    const u64* mrow = mask + (wid * 32 + r32);
    auto loadt = [&](u32x4& kr, u32x4& vr, u64& mwr, int t) { const int tt = t > 0 ? t : 0;
        ld16_async(kr, ksrc + (size_t)tt * 64 * LD); ld16_async(vr, vsrc + (size_t)tt * 64 * LD); ld8_async(mwr, mrow + (size_t)tt * SEQ); };
    loadt(kregA, vregA, mwA, nt - 1); loadt(kregB, vregB, mwB, nt - 2); __builtin_amdgcn_sched_barrier(0);
    const int kfb = hi * 1024 + r32 * 16;
    const int vfb = KBYTES + (4 * hi + ((lane & 15) >> 2)) * 64 + ((lane >> 4) & 1) * 32 + (lane & 3) * 8;
    const int qmax_w = qb * 256 + wid * 32 + 31;
    volatile LAS unsigned char* flagb = (volatile LAS unsigned char*)(lds + FLAGS);
    bool wdone = false, have = false;
    auto step = [&](u32x4& kreg, u32x4& vreg, u64& mw, int it) -> bool {
        const int t = nt - 1 - it;
        LAS unsigned char* buf = lds + (it & 1) * BUFB;
        asm volatile("s_waitcnt vmcnt(3)" ::: "memory");
        u64 mcur; asm volatile("v_mov_b64 %0, %1" : "=v"(mcur) : "v"(mw));
        *(LAS u32x4*)(buf + kdst) = kreg; *(LAS u32x4*)(buf + vdst) = vreg;
        if (it > 0) {
            if (!wdone) {
                const float l = o2[0];
                have = l > 0.f;
                const float ub = smax + slope2 * 63.0f - d64 * (float)it;
                wdone = __all(have && (ub - m_run - (float)(__builtin_amdgcn_frexp_expf(l) - 1) < -40.0f)) != 0;
                allhave = __all(have) != 0;
            }
#pragma unroll
            for (int r = 0; r < 16; ++r) negm[r] -= d64;
        }
        if (lane == 0) flagb[(it & 1) * 8 + wid] = wdone ? (unsigned char)1 : (unsigned char)0;
        __syncthreads();
        if (*(volatile LAS u64*)(lds + FLAGS + (it & 1) * 8) == 0x0101010101010101ull) return true;
        __builtin_amdgcn_sched_barrier(0);
        loadt(kreg, vreg, mw, t - 2);
        __builtin_amdgcn_sched_barrier(0);
        if (!wdone && 64 * t <= qmax_w) {
            f32x16 c0, c1;
            c0 = __builtin_amdgcn_mfma_f32_32x32x16_bf16(__builtin_bit_cast(bf16x8, ka0), __builtin_bit_cast(bf16x8, qa), negm, 0, 0, 0);
            c1 = __builtin_amdgcn_mfma_f32_32x32x16_bf16(__builtin_bit_cast(bf16x8, ka1), __builtin_bit_cast(bf16x8, qa), negm, 0, 0, 0);
#pragma unroll
            for (int ks = 0; ks < 4; ++ks) {
                const bf16x8 a0 = *(const LAS bf16x8*)(buf + kfb + ks * 2048), a1 = *(const LAS bf16x8*)(buf + kfb + ks * 2048 + 512);
                c0 = __builtin_amdgcn_mfma_f32_32x32x16_bf16(a0, qf[ks], c0, 0, 0, 0);
                c1 = __builtin_amdgcn_mfma_f32_32x32x16_bf16(a1, qf[ks], c1, 0, 0, 0);
            }
            s16x4 vlo[2][4], vhi[2][4];
#pragma unroll
            for (int d = 0; d < 2; ++d)
#pragma unroll
                for (int s2 = 0; s2 < 4; ++s2) { vlo[d][s2] = vtr(buf + vfb + d * 4096 + (16 * s2) * 64); vhi[d][s2] = vtr(buf + vfb + d * 4096 + (16 * s2 + 8) * 64); }
            __builtin_amdgcn_sched_barrier(0);
            const int mlo = (int)((unsigned)mcur >> (4 * hi)), mhi = (int)((unsigned)(mcur >> 32) >> (4 * hi));
#pragma unroll
            for (int r = 0; r < 16; ++r) { const int bpos = (r & 3) + 8 * (r >> 2);
                const unsigned s0 = (unsigned)__builtin_amdgcn_sbfe(mlo, bpos, 1), s1 = (unsigned)__builtin_amdgcn_sbfe(mhi, bpos, 1);
                c0[r] = __uint_as_float((__float_as_uint(c0[r]) & s0) | (__float_as_uint(NEG) & ~s0));
                c1[r] = __uint_as_float((__float_as_uint(c1[r]) & s1) | (__float_as_uint(NEG) & ~s1)); }
            if (!(allhave && nomax_ok)) {
                float mx = fmaxf(c0[0], c1[0]);
#pragma unroll
                for (int r = 1; r < 16; ++r) mx = fmaxf(fmaxf(mx, c0[r]), c1[r]);
                mx = max_halves(mx);
                const bool need = (mx > 0.f) || (!have && mx > -1.0e29f);
                if (__any(need)) {
                    const float dl = need ? mx : 0.f, f = have ? __builtin_amdgcn_exp2f(-dl) : 1.0f;
                    m_run += dl; o2[0] *= f;
#pragma unroll
                    for (int r = 0; r < 16; ++r) { c0[r] -= dl; c1[r] -= dl; negm[r] -= dl; o[0][r] *= f; o[1][r] *= f; }
                }
            }
#pragma unroll
            for (int r = 0; r < 16; ++r) { c0[r] = __builtin_amdgcn_exp2f(c0[r]); c1[r] = __builtin_amdgcn_exp2f(c1[r]); }
            bf16x8 pf[4];
#pragma unroll
            for (int s = 0; s < 4; ++s) { u32x4 w;
#pragma unroll
                for (int e = 0; e < 4; ++e) { const int r = (s & 1) * 8 + 2 * e; w[e] = (s < 2) ? pg8::cvt_pk_bf16(c0[r], c0[r + 1]) : pg8::cvt_pk_bf16(c1[r], c1[r + 1]); }
                pf[s] = __builtin_bit_cast(bf16x8, w); }
#pragma unroll
            for (int d = 0; d < 2; ++d)
#pragma unroll
                for (int s = 0; s < 4; ++s) {
                    const s16x4 lo4 = vlo[d][s], hi4 = vhi[d][s];
                    const bf16x8 vf = (bf16x8){lo4[0], lo4[1], lo4[2], lo4[3], hi4[0], hi4[1], hi4[2], hi4[3]};
                    o[d] = __builtin_amdgcn_mfma_f32_32x32x16_bf16(vf, pf[s], o[d], 0, 0, 0);
                }
#pragma unroll
            for (int s = 0; s < 4; ++s) o2 = __builtin_amdgcn_mfma_f32_32x32x16_bf16(vones, pf[s], o2, 0, 0, 0);
        }
        return false;
    };
    for (int it = 0; it < nt; it += 2) {
        if (step(kregA, vregA, mwA, it)) break;
        if (step(kregB, vregB, mwB, it + 1)) break;
    }
    asm volatile("s_waitcnt vmcnt(0)" :: "v"(kregA), "v"(vregA), "v"(kregB), "v"(vregB), "v"(mwA), "v"(mwB) : "memory");
    const float l_tot = o2[0], inv = 1.0f / l_tot;
    bf16* orow = O + (size_t)(wid * 32 + r32) * LD; const bf16* zrow = Z + (size_t)(wid * 32 + r32) * LD;
    attn_store_gated<2>(o, inv, zrow, orow, hi);
    __syncthreads();
}
__device__ __forceinline__ void flash_unit_c(LAS unsigned char* lds, const bf16* Q, const bf16* K, const bf16* V, bf16* O, const bf16* Z, int qb, const u64* mask, float slope2, float smax  ) {
    constexpr int LD = 512, KBYTES = 8192, TILEB = 16384, BUFB = 32768, MERGE = 65536, FLAGS = 65536 + 36864;
    const int tid = opaque_tid(), lane = tid & 63, wid = __builtin_amdgcn_readfirstlane(tid >> 6), r32 = lane & 31, hi = lane >> 5;
    const float NEG = -1.0e30f;
    const int nt = 2 * (qb + 1);
    const int grp = wid >> 2, wq = wid & 3;
    bf16x8 qf[4];
    { const bf16* qp = Q + (size_t)(wq * 32 + r32) * LD + 8 * hi;
#pragma unroll
      for (int ks = 0; ks < 4; ++ks) ld16q_async(qf[ks], qp + 16 * ks); }
    u32x4 ka0 = {0u, 0u, 0u, 0u}, ka1 = {0u, 0u, 0u, 0u}, qa = {0u, 0u, 0u, 0u};
    if (hi == 0) {
        const float r0 = slope2 * (float)r32, r1 = slope2 * (float)(r32 + 32);
        const unsigned h0 = bf16_rne_bits(r0), h1 = bf16_rne_bits(r1);
        ka0.x = h0 | (bf16_rne_bits(r0 - __uint_as_float(h0 << 16)) << 16); ka1.x = h1 | (bf16_rne_bits(r1 - __uint_as_float(h1 << 16)) << 16);
        qa.x = 0x3f803f80u;
    }
    const unsigned onesw = ((r32 & ~4) == 0) ? 0x3f803f80u : 0u;
    const bf16x8 vones = __builtin_bit_cast(bf16x8, (u32x4){onesw, onesw, onesw, onesw});
    f32x16 o2;
#pragma unroll
    for (int r = 0; r < 16; ++r) o2[r] = 0.f;
    const float d64 = slope2 * 64.0f;
    const bool nomax_ok = smax <= 30.0f;
    bool allhave = false;
    f32x16 o[2];
#pragma unroll
    for (int d = 0; d < 2; ++d)
#pragma unroll
        for (int r = 0; r < 16; ++r) o[d][r] = 0.f;
    f32x16 negm;
#pragma unroll
    for (int r = 0; r < 16; ++r) negm[r] = -d64 * (float)grp;
    float m_run = 0.f;
    u32x4 kregA[2], vregA[2], kregB[2], vregB[2]; u64 mwA, mwB;
    const bf16* ksrc = K + (size_t)lane * LD + wid * 8;
    const bf16* vsrc = V + (size_t)(16 * (wid & 3) + (lane >> 2)) * LD + (wid >> 2) * 32 + (lane & 3) * 8;
    const int kdst = wid * 1024 + lane * 16, vdst = KBYTES + (wid >> 2) * 4096 + (16 * (wid & 3) + (lane >> 2)) * 64 + (lane & 3) * 16;
    const u64* mrow = mask + (wq * 32 + r32);
    auto loadt = [&](u32x4 (&kr)[2], u32x4 (&vr)[2], u64& mwr, int it) {
#pragma unroll
        for (int j = 0; j < 2; ++j) { int t = nt - 1 - 2 * it - j; t = t > 0 ? t : 0; ld16_async(kr[j], ksrc + (size_t)t * 64 * LD); ld16_async(vr[j], vsrc + (size_t)t * 64 * LD); }
        int tm = nt - 1 - 2 * it - grp; tm = tm > 0 ? tm : 0; ld8_async(mwr, mrow + (size_t)tm * SEQ); };
    loadt(kregA, vregA, mwA, 0); loadt(kregB, vregB, mwB, 1); __builtin_amdgcn_sched_barrier(0);
    const int kfb = hi * 1024 + r32 * 16;
    const int vfb = KBYTES + (4 * hi + ((lane & 15) >> 2)) * 64 + ((lane >> 4) & 1) * 32 + (lane & 3) * 8;
    const int qmax_w = qb * 128 + wq * 32 + 31;
    volatile LAS unsigned char* flagb = (volatile LAS unsigned char*)(lds + FLAGS);
    bool wdone = false, have = false;
    auto step = [&](u32x4 (&kreg)[2], u32x4 (&vreg)[2], u64& mw, int it) -> bool {
        const int ti = 2 * it + grp, t = nt - 1 - ti;
        LAS unsigned char* sbuf = lds + (it & 1) * BUFB;
        asm volatile("s_waitcnt vmcnt(5)" ::: "memory");
        u64 mcur; asm volatile("v_mov_b64 %0, %1" : "=v"(mcur) : "v"(mw));
        *(LAS u32x4*)(sbuf + kdst) = kreg[0]; *(LAS u32x4*)(sbuf + vdst) = vreg[0]; *(LAS u32x4*)(sbuf + TILEB + kdst) = kreg[1]; *(LAS u32x4*)(sbuf + TILEB + vdst) = vreg[1];
        const LAS unsigned char* buf = sbuf + grp * TILEB;
        if (it > 0) {
            if (!wdone) {
                const float l = o2[0];
                have = l > 0.f;
                const float ub = smax + slope2 * 63.0f - d64 * (float)ti;
                wdone = __all(have && (ub - m_run - (float)(__builtin_amdgcn_frexp_expf(l) - 1) < -40.0f)) != 0;
                allhave = __all(have) != 0;
            }
#pragma unroll
            for (int r = 0; r < 16; ++r) negm[r] -= 2.0f * d64;
        }
        if (lane == 0) flagb[(it & 1) * 8 + wid] = wdone ? (unsigned char)1 : (unsigned char)0;
        __syncthreads();
        if (*(volatile LAS u64*)(lds + FLAGS + (it & 1) * 8) == 0x0101010101010101ull) return true;
        __builtin_amdgcn_sched_barrier(0);
        loadt(kreg, vreg, mw, it + 2);
        __builtin_amdgcn_sched_barrier(0);
        if (!wdone && 64 * t <= qmax_w) {
            f32x16 c0, c1;
            c0 = __builtin_amdgcn_mfma_f32_32x32x16_bf16(__builtin_bit_cast(bf16x8, ka0), __builtin_bit_cast(bf16x8, qa), negm, 0, 0, 0);
            c1 = __builtin_amdgcn_mfma_f32_32x32x16_bf16(__builtin_bit_cast(bf16x8, ka1), __builtin_bit_cast(bf16x8, qa), negm, 0, 0, 0);
#pragma unroll
            for (int ks = 0; ks < 4; ++ks) {
                const bf16x8 a0 = *(const LAS bf16x8*)(buf + kfb + ks * 2048), a1 = *(const LAS bf16x8*)(buf + kfb + ks * 2048 + 512);
                c0 = __builtin_amdgcn_mfma_f32_32x32x16_bf16(a0, qf[ks], c0, 0, 0, 0);
                c1 = __builtin_amdgcn_mfma_f32_32x32x16_bf16(a1, qf[ks], c1, 0, 0, 0);
            }
            const int mlo = (int)((unsigned)mcur >> (4 * hi)), mhi = (int)((unsigned)(mcur >> 32) >> (4 * hi));
#pragma unroll
            for (int r = 0; r < 16; ++r) { const int bpos = (r & 3) + 8 * (r >> 2);
                const unsigned s0 = (unsigned)__builtin_amdgcn_sbfe(mlo, bpos, 1), s1 = (unsigned)__builtin_amdgcn_sbfe(mhi, bpos, 1);
                c0[r] = __uint_as_float((__float_as_uint(c0[r]) & s0) | (__float_as_uint(NEG) & ~s0));
                c1[r] = __uint_as_float((__float_as_uint(c1[r]) & s1) | (__float_as_uint(NEG) & ~s1)); }
            if (!(allhave && nomax_ok)) {
                float mx = fmaxf(c0[0], c1[0]);
#pragma unroll
                for (int r = 1; r < 16; ++r) mx = fmaxf(fmaxf(mx, c0[r]), c1[r]);
                mx = max_halves(mx);
                const bool need = (mx > 0.f) || (!have && mx > -1.0e29f);
                if (__any(need)) {
                    const float dl = need ? mx : 0.f, fs = have ? __builtin_amdgcn_exp2f(-dl) : 1.0f;
                    m_run += dl; o2[0] *= fs;
#pragma unroll
                    for (int r = 0; r < 16; ++r) { c0[r] -= dl; c1[r] -= dl; negm[r] -= dl; o[0][r] *= fs; o[1][r] *= fs; }
                }
            }
#pragma unroll
            for (int r = 0; r < 16; ++r) { c0[r] = __builtin_amdgcn_exp2f(c0[r]); c1[r] = __builtin_amdgcn_exp2f(c1[r]); }
            bf16x8 pf[4];
#pragma unroll
            for (int s = 0; s < 4; ++s) { u32x4 w;
#pragma unroll
                for (int e = 0; e < 4; ++e) { const int r = (s & 1) * 8 + 2 * e; w[e] = (s < 2) ? pg8::cvt_pk_bf16(c0[r], c0[r + 1]) : pg8::cvt_pk_bf16(c1[r], c1[r + 1]); }
                pf[s] = __builtin_bit_cast(bf16x8, w); }
#pragma unroll
            for (int d = 0; d < 2; ++d)
#pragma unroll
                for (int s = 0; s < 4; ++s) {
                    const s16x4 lo4 = vtr(buf + vfb + d * 4096 + (16 * s) * 64), hi4 = vtr(buf + vfb + d * 4096 + (16 * s + 8) * 64);
                    const bf16x8 vf = (bf16x8){lo4[0], lo4[1], lo4[2], lo4[3], hi4[0], hi4[1], hi4[2], hi4[3]};
                    o[d] = __builtin_amdgcn_mfma_f32_32x32x16_bf16(vf, pf[s], o[d], 0, 0, 0);
                }
#pragma unroll
            for (int s = 0; s < 4; ++s) o2 = __builtin_amdgcn_mfma_f32_32x32x16_bf16(vones, pf[s], o2, 0, 0, 0);
        }
        return false;
    };
    for (int it = 0; it < nt / 2; it += 2) {
        if (step(kregA, vregA, mwA, it)) break;
        if (it + 1 < nt / 2) { if (step(kregB, vregB, mwB, it + 1)) break; }
    }
    asm volatile("s_waitcnt vmcnt(0)" :: "v"(kregA[0]), "v"(kregA[1]), "v"(vregA[0]), "v"(vregA[1]), "v"(kregB[0]), "v"(kregB[1]), "v"(vregB[0]), "v"(vregB[1]), "v"(mwA), "v"(mwB) : "memory");
    float l_run = o2[0];
    __syncthreads();
    { LAS float* mg = (LAS float*)(lds + MERGE) + (wq * 64 + lane) * 36;
      if (grp == 1) { mg[0] = m_run; mg[1] = l_run;
#pragma unroll
          for (int r = 0; r < 16; ++r) { mg[2 + r] = o[0][r]; mg[18 + r] = o[1][r]; } }
      __syncthreads();
      if (grp == 0) {
          const float mB = mg[0], lB = mg[1];
          const float ltA = l_run, ltB = lB;
          const float mm = (ltA > 0.f && ltB > 0.f) ? fmaxf(m_run, mB) : (ltA > 0.f ? m_run : mB);
          const float fA = ltA > 0.f ? __builtin_amdgcn_exp2f(m_run - mm) : 0.f, fB = ltB > 0.f ? __builtin_amdgcn_exp2f(mB - mm) : 0.f;
          l_run = l_run * fA + lB * fB;
#pragma unroll
          for (int r = 0; r < 16; ++r) { o[0][r] = o[0][r] * fA + mg[2 + r] * fB; o[1][r] = o[1][r] * fA + mg[18 + r] * fB; } } }
    if (grp == 0) {
    const float l_tot = l_run, inv = 1.0f / l_tot;
    bf16* orow = O + (size_t)(wq * 32 + r32) * LD; const bf16* zrow = Z + (size_t)(wq * 32 + r32) * LD;
    attn_store_gated<2>(o, inv, zrow, orow, hi);
    }
    __syncthreads();
}

template <bool NOMAX> __device__ __forceinline__ void flash_unit_m(LAS unsigned char* lds, const bf16* Q, const bf16* K, const bf16* V, bf16* O, const bf16* Z, const float* gq, float smax  , int nqb  ) {
    constexpr int D = 128, KS = 8, DB = 4, KBYTES = D * 128, BUFB = 2 * KBYTES, LDQ = 512, LDKV = 1024;
    const int tid = opaque_tid(), lane = tid & 63, wid = __builtin_amdgcn_readfirstlane(tid >> 6), r32 = lane & 31, hi = lane >> 5;
    {
        u32x4 kreg[4][2], vreg[4][2];
        const bf16* ksrc = K + (size_t)lane * LDKV + wid * 8;
        const bf16* vsrc = V + (size_t)(16 * (wid & 3) + (lane >> 2)) * LDKV + (wid >> 2) * 32 + (lane & 3) * 8;
#pragma unroll
        for (int t = 0; t < 4; ++t)
#pragma unroll
            for (int i = 0; i < 2; ++i) { kreg[t][i] = *(const u32x4*)(ksrc + (size_t)t * 64 * LDKV + i * 64); vreg[t][i] = *(const u32x4*)(vsrc + (size_t)t * 64 * LDKV + i * 64); }
        const int kdst = wid * 1024 + lane * 16, vdst = KBYTES + (wid >> 2) * 4096 + (16 * (wid & 3) + (lane >> 2)) * 64 + (lane & 3) * 16;
#pragma unroll
        for (int t = 0; t < 4; ++t)
#pragma unroll
            for (int i = 0; i < 2; ++i) { *(LAS u32x4*)(lds + t * BUFB + kdst + i * 8192) = kreg[t][i]; *(LAS u32x4*)(lds + t * BUFB + vdst + i * 8192) = vreg[t][i]; }
    }
    const int kfb = hi * 1024 + r32 * 16;
    const int vfb = KBYTES + (4 * hi + ((lane & 15) >> 2)) * 64 + ((lane >> 4) & 1) * 32 + (lane & 3) * 8;
    __syncthreads();
#pragma unroll 1
    for (int qq = 0; qq < nqb; ++qq) {
    bf16x8 qf[KS];
    {
        const bf16* qp = Q + (size_t)(qq * 256 + wid * 32 + r32) * LDQ + 8 * hi; u32x4 raw[KS]; float ss = 0.f;
#pragma unroll
        for (int ks = 0; ks < KS; ++ks) { raw[ks] = *(const u32x4*)(qp + 16 * ks);
#pragma unroll
            for (int e = 0; e < 4; ++e) { const float a = bflo(raw[ks][e]), b = bfhi(raw[ks][e]); ss += a * a + b * b; } }
        ss = sum_halves(ss);
        const float r = 0.08838834764831845f * LOG2E / sqrtf(ss * (1.0f / 128.0f) + RMS_EPS);
#pragma unroll
        for (int ks = 0; ks < KS; ++ks) { const f32x4 g0 = *(const f32x4*)(gq + 16 * ks + 8 * hi), g1 = *(const f32x4*)(gq + 16 * ks + 8 * hi + 4); u32x4 w;
            w.x = pg8::cvt_pk_bf16(bflo(raw[ks].x) * r * g0.x, bfhi(raw[ks].x) * r * g0.y); w.y = pg8::cvt_pk_bf16(bflo(raw[ks].y) * r * g0.z, bfhi(raw[ks].y) * r * g0.w);
            w.z = pg8::cvt_pk_bf16(bflo(raw[ks].z) * r * g1.x, bfhi(raw[ks].z) * r * g1.y); w.w = pg8::cvt_pk_bf16(bflo(raw[ks].w) * r * g1.z, bfhi(raw[ks].w) * r * g1.w);
            qf[ks] = __builtin_bit_cast(bf16x8, w); }
    }
    f32x16 o[DB];
#pragma unroll
    for (int d = 0; d < DB; ++d)
#pragma unroll
        for (int r = 0; r < 16; ++r) o[d][r] = 0.f;
    constexpr bool nomax = NOMAX;
    float m_run = nomax ? 0.f : -1.0e30f, l_run = 0.f;
#pragma unroll 1
    for (int t = 0; t < 4; ++t) {
        const LAS unsigned char* buf = lds + t * BUFB;
        f32x16 c0, c1;
#pragma unroll
        for (int r = 0; r < 16; ++r) { c0[r] = 0.f; c1[r] = 0.f; }
#pragma unroll
        for (int ks = 0; ks < KS; ++ks) {
            const bf16x8 a0 = *(const LAS bf16x8*)(buf + kfb + ks * 2048), a1 = *(const LAS bf16x8*)(buf + kfb + ks * 2048 + 512);
            c0 = __builtin_amdgcn_mfma_f32_32x32x16_bf16(a0, qf[ks], c0, 0, 0, 0);
            c1 = __builtin_amdgcn_mfma_f32_32x32x16_bf16(a1, qf[ks], c1, 0, 0, 0);
        }
        if (!nomax) {
            float mx = fmaxf(c0[0], c1[0]);
#pragma unroll
            for (int r = 1; r < 16; ++r) mx = fmaxf(fmaxf(mx, c0[r]), c1[r]);
            mx = max_halves(mx);
            const float m_new = fmaxf(m_run, mx), alpha = __builtin_amdgcn_exp2f(m_run - m_new);
            m_run = m_new; l_run *= alpha;
#pragma unroll
            for (int r = 0; r < 16; ++r) { c0[r] -= m_new; c1[r] -= m_new; }
#pragma unroll
            for (int d = 0; d < DB; ++d)
#pragma unroll
                for (int r = 0; r < 16; ++r) o[d][r] *= alpha;
        }
#pragma unroll
        for (int r = 0; r < 16; ++r) { c0[r] = __builtin_amdgcn_exp2f(c0[r]); c1[r] = __builtin_amdgcn_exp2f(c1[r]); l_run += c0[r] + c1[r]; }
        bf16x8 pf[4];
#pragma unroll
        for (int s = 0; s < 4; ++s) { u32x4 w;
#pragma unroll
            for (int e = 0; e < 4; ++e) { const int r = (s & 1) * 8 + 2 * e; w[e] = (s < 2) ? pg8::cvt_pk_bf16(c0[r], c0[r + 1]) : pg8::cvt_pk_bf16(c1[r], c1[r + 1]); }
            pf[s] = __builtin_bit_cast(bf16x8, w); }
#pragma unroll
        for (int d = 0; d < DB; ++d)
#pragma unroll
            for (int s = 0; s < 4; ++s) {
                const s16x4 lo4 = vtr(buf + vfb + d * 4096 + (16 * s) * 64), hi4 = vtr(buf + vfb + d * 4096 + (16 * s + 8) * 64);
                const bf16x8 vf = (bf16x8){lo4[0], lo4[1], lo4[2], lo4[3], hi4[0], hi4[1], hi4[2], hi4[3]};
                o[d] = __builtin_amdgcn_mfma_f32_32x32x16_bf16(vf, pf[s], o[d], 0, 0, 0);
            }
    }
    const float inv = 1.0f / sum_halves(l_run);
    bf16* orow = O + (size_t)(qq * 256 + wid * 32 + r32) * LDQ; const bf16* zrow = Z + (size_t)(qq * 256 + wid * 32 + r32) * LDQ;
    attn_store_gated<DB>(o, inv, zrow, orow, hi);
    }
    __syncthreads();
}

#define RLX_AGENT __ATOMIC_RELAXED, __HIP_MEMORY_SCOPE_AGENT
constexpr size_t WS_CTL = 45 * MiB, CTL_ZERO_BYTES = 16384;
constexpr int LDS_BARST = 131072 + 8192;
#define XB_TMO      128
#define XB_XCNT(j)  (256  + 64 * (j))
#define XB_XSUB(j)  (1280 + 64 * (j))
#define XB_XGEN(j)  (2304 + 64 * (j))
#define XB_TOP      3328
#define XB_TOPGEN   3392
#define XCD_BAR_WORDS 3456
#define XB_SPIN_CAP (1u << 18)

__device__ __forceinline__ unsigned xb_ld(unsigned* p)              { return __hip_atomic_load(p, __ATOMIC_RELAXED, __HIP_MEMORY_SCOPE_AGENT); }
__device__ __forceinline__ unsigned xb_add(unsigned* p, unsigned v) { return __hip_atomic_fetch_add(p, v, __ATOMIC_RELAXED, __HIP_MEMORY_SCOPE_AGENT); }
__device__ __forceinline__ unsigned xb_xcc_id() { return (unsigned)__builtin_amdgcn_s_getreg((3 << 11) | 20) & 0xFu; }
#define XB_SPIN(cond, bar) do { unsigned _sp = 0; while (cond) { __builtin_amdgcn_s_sleep(1); \
    if ((++_sp & 255u) == 0u) { if (xb_ld(&(bar)[XB_TMO])) break; if (_sp > XB_SPIN_CAP) { atomicAdd(&(bar)[XB_TMO], 1u); break; } } } } while (0)

struct XcdBarrier {
    unsigned* bar; unsigned x;
    volatile LAS unsigned* st;
};
__device__ __forceinline__ XcdBarrier xcd_barrier_post(unsigned* bar, volatile LAS unsigned* st) {
    XcdBarrier b; b.bar = bar; b.x = xb_xcc_id(); b.st = st;
    if (threadIdx.x == 0) (void)xb_add(&bar[XB_XCNT(b.x)], 1u);
    return b;
}
__device__ __forceinline__ void xcd_barrier_complete(unsigned* bar, unsigned x, unsigned& nloc, unsigned& nx) {
    const unsigned G = gridDim.x * gridDim.y * gridDim.z;
    unsigned sum, cnt, mine, sp = 0u;
    for (;;) {
        sum = 0u; cnt = 0u; mine = 0u;
#pragma unroll
        for (unsigned j = 0; j < 16; ++j) { const unsigned c = xb_ld(&bar[XB_XCNT(j)]); sum += c; cnt += (c > 0u) ? 1u : 0u; mine = (j == x) ? c : mine; }
        if (sum == G) break;
        __builtin_amdgcn_s_sleep(1);
        if ((++sp & 255u) == 0u) { if (xb_ld(&bar[XB_TMO])) break; if (sp > XB_SPIN_CAP) { atomicAdd(&bar[XB_TMO], 1u); break; } }
    }
    nloc = mine > 0u ? mine : 1u; nx = cnt > 0u ? cnt : 1u;
}

__device__ __forceinline__ void xcd_barrier(const XcdBarrier& b) {
    asm volatile("s_waitcnt vmcnt(0)" ::: "memory");
    __syncthreads();
    if (threadIdx.x == 0) {
        unsigned* bar = b.bar;
        __builtin_amdgcn_s_waitcnt(0);
        unsigned nloc = b.st[0], nx = b.st[1];
        if (nloc == 0u) { xcd_barrier_complete(bar, b.x, nloc, nx); b.st[0] = nloc; b.st[1] = nx; }
        const unsigned old = xb_add(&bar[XB_XSUB(b.x)], 1u);
        const unsigned gen = old / nloc;
        if (old + 1u == (gen + 1u) * nloc) {
            __builtin_amdgcn_fence(__ATOMIC_RELEASE, "agent");
            asm volatile("s_waitcnt vmcnt(0)" ::: "memory");
            const unsigned og = xb_add(&bar[XB_TOP], 1u);
            const unsigned tg = og / nx;
            if (og + 1u == (tg + 1u) * nx) xb_add(&bar[XB_TOPGEN], 1u);
            else XB_SPIN(xb_ld(&bar[XB_TOPGEN]) == tg, bar);
            __builtin_amdgcn_fence(__ATOMIC_ACQUIRE, "agent");
            xb_add(&bar[XB_XGEN(b.x)], 1u);
            asm volatile("s_waitcnt vmcnt(0)" ::: "memory");
        } else {
            XB_SPIN(xb_ld(&bar[XB_XGEN(b.x)]) == gen, bar);
            __builtin_amdgcn_fence(__ATOMIC_ACQUIRE, "agent");
            asm volatile("s_waitcnt vmcnt(0)" ::: "memory");
        }
    }
    __syncthreads();
}

__device__ __forceinline__ void phase1(const Params& p, LAS unsigned char* lds, int G) {
    unsigned char* ws = p.ws; const int c = (int)blockIdx.x;
    pg8::Gemm g{(const bf16*)(ws + WS_XB), (const bf16*)(ws + WS_WIN), T, NIN, DM, ((long)WS_MEMB - (long)WS_XB) / 2, ((long)WS_WMKV - (long)WS_WIN) / 2, 0};
    pg8::StaticOrder S; S.init(T, NIN, G, c, 1, MT, 1024);
    pg8::EpiProjA E{ws, (bf16*)p.out, (const float*)(ws + WS_RSTDX), p.q_norm_a, p.k_norm_a, (bf16*)(ws + WS_G01), (bf16*)p.out + (size_t)16 * MiB, p.b_gate};
    pg8::gemm_phase<pg8::EpiProjA, pg8::StaticOrder, true, true>(lds, g, S, E);
    { const int U = S.nwg + S.nM2 * S.nN2, rounds = (U + G - 1) / G, nfull = U - (rounds - 1) * G;
      const int nsp = (nfull < G) ? G - nfull : G, si = (nfull < G) ? c - nfull : c;
      if (si >= 0) p0_late_weights(p, lds, si * NWAVES + (opaque_tid() >> 6), nsp * NWAVES); }
}
constexpr int QW_TOPK = 3600, QW_ATTN = 3664;
__device__ __forceinline__ unsigned queue_next(unsigned* ctr, LAS unsigned char* lds) {
    volatile LAS unsigned* slot = (volatile LAS unsigned*)(lds + 32768 + 256);
    if (threadIdx.x == 0) *slot = __hip_atomic_fetch_add(ctr, 1u, __ATOMIC_RELAXED, __HIP_MEMORY_SCOPE_AGENT);
    __syncthreads();
    const unsigned u = *slot;
    __syncthreads();
    return u;
}
__device__ __forceinline__ void phase2(const Params& p, LAS unsigned char* lds, int G) {
    unsigned char* ws = p.ws; const int c = (int)blockIdx.x;
    const int gtid = c * NTHR + opaque_tid(), gthreads = G * NTHR;
    (void)gtid; (void)gthreads;
#if TPROBE >= 0
    if (blockIdx.x == 0 && threadIdx.x == 0) ((unsigned long long*)(p.ws + 46 * MiB))[10] = __builtin_amdgcn_s_memrealtime();
#endif
    unsigned* ctr = (unsigned*)(ws + 45 * MiB) + 3600;
    const unsigned nunits = NB * (SEQ / 16);
    unsigned u = queue_next(ctr, lds + 98304);
    TopkQ tq;
    if (u < nunits) topk_load_q(tq, (const bf16*)(ws + WS_QI), (const float*)(ws + WS_KIWI + 2 * MiB), u);
    while (u < nunits) {
        unsigned un = nunits;
        topk_unit2(lds, (const bf16*)(ws + WS_QI), (const bf16*)(ws + WS_KIWI), (const float*)(ws + WS_KIWI + 2 * MiB), (u64*)(ws + WS_MASK), u, (const bf16*)p.out, p.conv_w, tq, ctr, nunits, un, (bf16*)(ws + WS_MKV), p.k_norm_m);
        u = un;
    }
}
__device__ __forceinline__ void phase3(const Params& p, LAS unsigned char* lds, int G) {
    unsigned char* ws = p.ws;
    const int gl = opaque_tid() & 63;
    const float gqa = fabsf(p.q_norm_a[gl]), gka = fabsf(p.k_norm_a[gl]);
    const float gqb = fmaxf(fabsf(p.q_norm_m[gl]), fabsf(p.q_norm_m[gl + 64])), gkb = fmaxf(fabsf(p.k_norm_m[gl]), fabsf(p.k_norm_m[gl + 64]));
    const float gq = __uint_as_float(wave_umax_dpp(__float_as_uint(gqa))), gk = __uint_as_float(wave_umax_dpp(__float_as_uint(gka)));
    const float smax = 64.0f * 0.125f * LOG2E * gq * gk * 1.02f + 0.5f;
    const float gqm = __uint_as_float(wave_umax_dpp(__float_as_uint(gqb))), gkm = __uint_as_float(wave_umax_dpp(__float_as_uint(gkb)));
    const float smax_m = 128.0f * 0.08838834764831845f * LOG2E * gqm * gkm * 1.02f + 0.5f;
    unsigned* ctr = (unsigned*)(ws + 45 * MiB) + QW_ATTN;
    for (;;) {
        const unsigned u = queue_next(ctr, lds);
        if (u >= 672u) break;
        unsigned ur = u;
        if (u < 64u) ur = u + 608u; else ur = u - 64u;
        if (ur < 96u) {
            const int h = 7 - (int)(ur >> 5), qb = 31 - (int)((ur & 31u) >> 2), b = (int)(ur & 3u);
            const float slope2 = exp2f(-(float)(h + 1)) * LOG2E;
            const size_t row0 = (size_t)b * SEQ + qb * 128;
            bf16* q = (bf16*)(ws + WS_QA) + row0 * 512 + h * 64;
            if (!SKIP_FA) flash_unit_c(lds, q, (const bf16*)(ws + WS_KA) + (size_t)b * SEQ * 512 + h * 64, (const bf16*)(ws + WS_VA) + (size_t)b * SEQ * 512 + h * 64,
                                       q, (const bf16*)(ws + WS_ZA) + row0 * 512 + h * 64, qb, (const u64*)(ws + WS_MASK) + (size_t)b * 64 * SEQ + (row0 - (size_t)b * SEQ), slope2, smax);
        } else if (ur < 608u) {
            const unsigned uu = ur - 96u;
            const int h = 7 - (int)(uu >> 6), qb = 15 - (int)((uu & 63u) >> 2), b = (int)(uu & 3u);
            if (!(h >= 5 && qb >= 12)) {
            const float slope2 = exp2f(-(float)(h + 1)) * LOG2E;
            const size_t row0 = (size_t)b * SEQ + qb * 256;
            bf16* q = (bf16*)(ws + WS_QA) + row0 * 512 + h * 64;
            if (!SKIP_FA) flash_unit_a(lds, q, (const bf16*)(ws + WS_KA) + (size_t)b * SEQ * 512 + h * 64, (const bf16*)(ws + WS_VA) + (size_t)b * SEQ * 512 + h * 64,
                                       q, (const bf16*)(ws + WS_ZA) + row0 * 512 + h * 64, qb, (const u64*)(ws + WS_MASK) + (size_t)b * 64 * SEQ + (row0 - (size_t)b * SEQ), slope2, smax);
            }
        } else {
            const int v = (int)ur - 608, b2 = v >> 4, hm = (v >> 2) & 3, qb = 4 * (v & 3); const size_t row0 = (size_t)b2 * SEQ + qb * 256;
            bf16* q = (bf16*)(ws + WS_QM) + row0 * 512 + hm * 128;
            const bf16* kv = (const bf16*)(ws + WS_MKV) + (size_t)b2 * MEML * 1024 + hm * 128;
            if (smax_m <= 30.0f) flash_unit_m<true>(lds, q, kv, kv + 512, q, (const bf16*)(ws + WS_ZM) + row0 * 512 + hm * 128, p.q_norm_m, smax_m, 4);
            else flash_unit_m<false>(lds, q, kv, kv + 512, q, (const bf16*)(ws + WS_ZM) + row0 * 512 + hm * 128, p.q_norm_m, smax_m, 4);
        }
    }
}
__device__ __forceinline__ void phase4(const Params&, LAS unsigned char*, int) {}
__device__ __forceinline__ void phase5(const Params& p, LAS unsigned char* lds, int G) {
    unsigned char* ws = p.ws; const int c = (int)blockIdx.x;
    const long sA = (long)(WS_QM - WS_QA) / 2;
    pg8::Gemm g{(const bf16*)(ws + WS_QA), (const bf16*)(ws + WS_WOA), T, 1024, 512, sA, (long)(WS_WOM - WS_WOA) / 2, ((const char*)p.out - (const char*)(ws + WS_QA)) / 2 - 2 * sA};
    pg8::StaticOrder S; S.init(T, 1024, G, c, 3);
    pg8::EpiMerge E{(const bf16*)(ws + WS_G01), (const bf16*)p.out + (size_t)16 * MiB, (bf16*)(ws + WS_MERGED)};
    pg8::gemm_phase<pg8::EpiMerge, pg8::StaticOrder, true, true>(lds, g, S, E);
}
__device__ __forceinline__ void phase6(const Params& p, LAS unsigned char* lds, int G) {
    unsigned char* ws = p.ws; const int c = (int)blockIdx.x;
    pg8::Gemm g{(const bf16*)(ws + WS_MERGED), (const bf16*)(ws + WS_WO), T, 1024, DM, 0, 0, 0};
    pg8::StaticOrder S; S.init(T, 1024, G, c);
    pg8::EpiResF32 E{(const bf16*)(ws + WS_XB), (const float*)(ws + WS_RSTDX), p.out, 1024};
    pg8::gemm_phase<pg8::EpiResF32, pg8::StaticOrder, false, true>(lds, g, S, E);
}

template <int PH> __device__ __forceinline__ void run_phase(const Params& p, LAS unsigned char* lds, int G) {
    if (PH == 0) { const int bx = blockIdx.x; const int vcu = (G % 8 == 0) ? (bx % 8) * (G / 8) + bx / 8 : bx; phase0(p, lds, vcu, G); }
    if (PH == 1) phase1(p, lds, G);
    if (PH == 2) phase2(p, lds, G);
    if (PH == 3) phase3(p, lds, G);
    if (PH == 4) phase4(p, lds, G);
    if (PH == 5) phase5(p, lds, G);
    if (PH == 6) phase6(p, lds, G);
}

template <int PH> __global__ void __launch_bounds__(NTHR, 2) phase_kernel(Params p) {
    extern __shared__ __attribute__((aligned(16))) unsigned char lds_raw[];
    run_phase<PH>(p, (LAS unsigned char*)lds_raw, (int)gridDim.x);
}
#if FUSED
__global__ void __launch_bounds__(NTHR, 2) mega_kernel(Params p) {
    extern __shared__ __attribute__((aligned(16))) unsigned char lds_raw[];
    cg::grid_group grid = cg::this_grid();
    LAS unsigned char* lds = (LAS unsigned char*)lds_raw; const int G = (int)gridDim.x;
    if (p.ws == nullptr) grid.sync();
    volatile LAS unsigned* bst = (volatile LAS unsigned*)(lds + LDS_BARST);
    if (threadIdx.x < 2) bst[threadIdx.x] = 0u;
    __syncthreads();
    XcdBarrier bar = xcd_barrier_post((unsigned*)(p.ws + WS_CTL), bst);
#define GSYNC() xcd_barrier(bar)
#if TPROBE >= 0
    unsigned long long* ts = (unsigned long long*)(p.ws + 46 * MiB);
#define STAMP(k) do { if (blockIdx.x == 0 && threadIdx.x == 0) ts[k] = __builtin_amdgcn_s_memrealtime(); } while (0)
    if (blockIdx.x == 0 && threadIdx.x == 0) { ts[12] = 0; ts[13] = 0; ts[14] = 0; ts[15] = ~0ull; }
    GSYNC();
#else
#define STAMP(k) do {} while (0)
#endif
    STAMP(0);
    run_phase<0>(p, lds, G); GSYNC(); STAMP(1);
    run_phase<1>(p, lds, G); GSYNC(); STAMP(2);
#if TPROBE >= 0
    unsigned long long tb0 = __builtin_amdgcn_s_memrealtime();
    run_phase<2>(p, lds, G);
    if (threadIdx.x == 0) { const unsigned long long dt = __builtin_amdgcn_s_memrealtime() - tb0; atomicMax(&ts[14], dt); atomicMin(&ts[15], dt); }
    GSYNC(); STAMP(3);
#else
    run_phase<2>(p, lds, G); GSYNC(); STAMP(3);
#endif
    run_phase<3>(p, lds, G); GSYNC(); STAMP(4);
    STAMP(5);
    run_phase<5>(p, lds, G); GSYNC(); STAMP(6);
    run_phase<6>(p, lds, G);
#if TPROBE >= 0
    GSYNC(); STAMP(7);
    GSYNC(); STAMP(8);
    GSYNC();
    {
        float us;
        if (TPROBE <= 6) us = (float)(ts[TPROBE + 1] - ts[TPROBE]) * 0.01f;
        else if (TPROBE == 7) us = (float)(ts[7] - ts[0]) * 0.01f * 0.1f;
        else if (TPROBE == 8) us = 100.f;
        else if (TPROBE == 14) us = (float)ts[14] * 0.01f;
        else if (TPROBE == 15) us = (float)ts[15] * 0.01f;
        else if (TPROBE == 12) us = (float)ts[12] * 0.01f;
        else if (TPROBE == 13) us = (float)ts[13] * 0.01f;
        else if (TPROBE == 10) us = (float)(ts[10] - ts[2]) * 0.01f;
        else us = (float)(ts[8] - ts[7]) * 0.01f * 10.f;
        const float a = sqrtf(us * 1e-5f);
        for (long i = (long)blockIdx.x * NTHR + threadIdx.x; i < (long)T * DM; i += (long)G * NTHR) p.out[i] += (i & 1) ? a : -a;
    }
#endif
}
#endif

template <int PH> static void launch_phase(const Params& p, int grid, hipStream_t stream) {
    static bool attr = false;
    if (!attr) { (void)hipFuncSetAttribute((const void*)phase_kernel<PH>, hipFuncAttributeMaxDynamicSharedMemorySize, LDS_BYTES); attr = true; }
    hipLaunchKernelGGL(phase_kernel<PH>, dim3(grid), dim3(NTHR), LDS_BYTES, stream, p);
}

extern "C" void kernel_launch(void* const* d_in, const int* in_sizes, int n_in, void* d_out, int out_size, void* d_ws, size_t ws_size, hipStream_t stream) {
    static int grid = 0;
    if (grid == 0) {
        int dev = 0, cus = 0;
        if (hipGetDevice(&dev) != hipSuccess || hipDeviceGetAttribute(&cus, hipDeviceAttributeMultiprocessorCount, dev) != hipSuccess) { fprintf(stderr, "kernel_launch: device query failed\n"); grid = -1; return; }
        if (n_in != 16 || out_size != T * DM || ws_size < 256 * MiB) { fprintf(stderr, "kernel_launch: unexpected shapes (n_in %d out %d ws %zu)\n", n_in, out_size, ws_size); grid = -1; return; }
#if FUSED
        int per_cu = 0;
        (void)hipFuncSetAttribute((const void*)mega_kernel, hipFuncAttributeMaxDynamicSharedMemorySize, LDS_BYTES);
        if (hipOccupancyMaxActiveBlocksPerMultiprocessor(&per_cu, (const void*)mega_kernel, NTHR, LDS_BYTES) != hipSuccess || per_cu < 1) { fprintf(stderr, "kernel_launch: occupancy query says %d\n", per_cu); grid = -1; return; }
        (void)hipGetLastError();
#endif
        grid = cus;
    }
    if (grid < 0) return;
    Params p{};
    p.x = (const float*)d_in[0]; p.mem = (const float*)d_in[1]; p.norm_g = (const float*)d_in[2]; p.mem_norm_g = (const float*)d_in[3]; p.w_in = (const float*)d_in[4]; p.b_gate = (const float*)d_in[5];
    p.w_mem_kv = (const float*)d_in[6]; p.q_norm_a = (const float*)d_in[7]; p.k_norm_a = (const float*)d_in[8]; p.q_norm_m = (const float*)d_in[9]; p.k_norm_m = (const float*)d_in[10]; p.conv_w = (const float*)d_in[11];
    p.w_out_a = (const float*)d_in[12]; p.w_out_b = (const float*)d_in[13]; p.w_out_m = (const float*)d_in[14]; p.w_o = (const float*)d_in[15];
    p.out = (float*)d_out; p.ws = (unsigned char*)d_ws;
#if FUSED
    (void)hipMemsetAsync((unsigned char*)d_ws + WS_CTL, 0, CTL_ZERO_BYTES, stream);
    void* args[] = {&p};
    hipError_t e = hipLaunchCooperativeKernel((const void*)mega_kernel, dim3(grid), dim3(NTHR), args, LDS_BYTES, stream);
    if (e != hipSuccess) fprintf(stderr, "cooperative launch failed: %s (grid %d)\n", hipGetErrorString(e), grid);
#else
    launch_phase<0>(p, grid, stream); launch_phase<1>(p, grid, stream); launch_phase<2>(p, grid, stream); launch_phase<3>(p, grid, stream);
    launch_phase<4>(p, grid, stream); launch_phase<5>(p, grid, stream); launch_phase<6>(p, grid, stream);
#endif
}
```
